# Optimizing an MI355X kernel written in HIP

```python
import math
import jax
import jax.numpy as jnp
from jax import lax
import numpy as np

D_MODEL = 2048
BATCH = 4
SEQ = 4096
DEPTH = 4

D_MIX = D_MODEL
S5_WIDTH = D_MIX // 4
S5_GROUP = 16
S5_GROUPS = S5_WIDTH // S5_GROUP
S5_STATE = 64
MLA_HEADS = 8
MLA_NOPE = 128
MLA_ROPE = 64
MLA_V = 128
MLA_Q_RANK = D_MODEL // 4
MLA_KV_RANK = D_MODEL // 8
MLA_WIDTH = MLA_HEADS * MLA_V
ROPE_THETA = 10000.0
Q_BLOCK = 128
MASK_VALUE = -1e30
HG_HEADS = 4
HG_DK = 128
HG_DV = (D_MIX - S5_WIDTH - MLA_WIDTH) // HG_HEADS
HG_WIDTH = HG_HEADS * HG_DV
HG_CHUNK = 64
D_FF = 5504
CONV_W = 3
EPS = 1e-6
IN_SIZES = (S5_WIDTH, MLA_Q_RANK, MLA_KV_RANK, MLA_ROPE,
            HG_HEADS * HG_DK, HG_HEADS * HG_DK, HG_WIDTH, HG_WIDTH)
IN_OFFSETS = tuple(int(v) for v in np.cumsum(IN_SIZES)[:-1])
D_IN = int(sum(IN_SIZES))

kernel_name = 'hybrid_s5_mla_hgrn2_block'


def rmsnorm(x, gain):
    xf = x.astype(jnp.float32)
    xf = xf * lax.rsqrt(jnp.mean(xf * xf, axis=-1, keepdims=True) + EPS)
    return (xf * gain.astype(jnp.float32)).astype(x.dtype)


def rope_tables(positions):
    inv_freq = 1.0 / (ROPE_THETA ** (jnp.arange(0, MLA_ROPE, 2, dtype=jnp.float32) / MLA_ROPE))
    ang = positions.astype(jnp.float32)[..., None] * inv_freq
    return jnp.cos(ang), jnp.sin(ang)


def apply_rope(x, cos, sin):
    half = x.shape[-1] // 2
    x1, x2 = x[..., :half], x[..., half:]
    cos = cos.astype(x.dtype)
    sin = sin.astype(x.dtype)
    return jnp.concatenate([x1 * cos - x2 * sin, x2 * cos + x1 * sin], axis=-1)


def s5_mixer(u, lam_re, lam_im, log_dt, b_re, b_im, c_re, c_im, d, w_glu):
    bsz, seq, _ = u.shape
    uf = u.astype(jnp.float32).reshape(bsz, seq, S5_GROUPS, S5_GROUP)
    lam = lax.complex(lam_re.astype(jnp.float32), lam_im.astype(jnp.float32))
    dt = jnp.exp(log_dt.astype(jnp.float32))[:, None]
    lam_bar = jnp.exp(lam * dt)
    b = lax.complex(b_re.astype(jnp.float32), b_im.astype(jnp.float32))
    b_bar = ((lam_bar - 1.0) / lam)[..., None] * b
    bu = jnp.einsum('gpc,bsgc->bsgp', b_bar, uf.astype(jnp.complex64))
    a = jnp.broadcast_to(lam_bar, bu.shape)

    def combine(left, right):
        a_l, b_l = left
        a_r, b_r = right
        return a_r * a_l, a_r * b_l + b_r

    _, h = lax.associative_scan(combine, (a, bu), axis=1)
    cm = lax.complex(c_re.astype(jnp.float32), c_im.astype(jnp.float32))
    y = (jnp.einsum('gcp,bsgp->bsgc', cm, h).real
         + d.astype(jnp.float32).reshape(S5_GROUPS, S5_GROUP) * uf)
    y = jax.nn.gelu(y.reshape(bsz, seq, S5_WIDTH))
    out = y * jax.nn.sigmoid(y @ w_glu.astype(jnp.float32))
    return out.astype(u.dtype)


def causal_attention_blocks(q_nope, q_rope, k_nope, k_rope, v):
    seq = q_nope.shape[1]
    scale = (MLA_NOPE + MLA_ROPE) ** -0.5
    outs = []
    for blk in range(seq // Q_BLOCK):
        q0, q1 = blk * Q_BLOCK, (blk + 1) * Q_BLOCK
        s = (jnp.einsum('bqhd,bkhd->bhqk', q_nope[:, q0:q1], k_nope[:, :q1])
             + jnp.einsum('bqhr,bkr->bhqk', q_rope[:, q0:q1], k_rope[:, :q1])).astype(jnp.float32) * scale
        causal = jnp.arange(q1)[None, :] <= jnp.arange(q0, q1)[:, None]
        p = jax.nn.softmax(jnp.where(causal, s, MASK_VALUE), axis=-1).astype(v.dtype)
        outs.append(jnp.einsum('bhqk,bkhd->bqhd', p, v[:, :q1]))
    return jnp.concatenate(outs, axis=1)


def mla_mixer(c_q, c_kv, k_rope_in, q_norm, w_uq, kv_norm, w_ukv, cos, sin):
    bsz, seq, _ = c_q.shape
    q = (rmsnorm(c_q, q_norm) @ w_uq).reshape(bsz, seq, MLA_HEADS, MLA_NOPE + MLA_ROPE)
    q_nope = q[..., :MLA_NOPE]
    q_rope = apply_rope(q[..., MLA_NOPE:], cos[:, :, None, :], sin[:, :, None, :])
    kv = (rmsnorm(c_kv, kv_norm) @ w_ukv).reshape(bsz, seq, MLA_HEADS, MLA_NOPE + MLA_V)
    k_nope, v = kv[..., :MLA_NOPE], kv[..., MLA_NOPE:]
    k_rope = apply_rope(k_rope_in, cos, sin)
    o = causal_attention_blocks(q_nope, q_rope, k_nope, k_rope, v)
    return o.reshape(bsz, seq, MLA_WIDTH)


def hgrn2_chunkwise(q, k, v, logf):
    bsz, seq, nh, dk = q.shape
    dv = v.shape[-1]
    n_chunks = seq // HG_CHUNK

    def to_chunks(t):
        return t.reshape(bsz, n_chunks, HG_CHUNK, nh, t.shape[-1]).transpose(1, 0, 3, 2, 4)

    mask = jnp.tril(jnp.ones((HG_CHUNK, HG_CHUNK), dtype=bool))[:, :, None]

    def step(state, inp):
        qc, kc, vc, gc = inp
        b = jnp.cumsum(gc, axis=2)
        o_inter = jnp.einsum('bhtk,bhkv->bhtv', qc * jnp.exp(b), state)
        diff = b[:, :, :, None, :] - b[:, :, None, :, :]
        decay = jnp.where(mask, jnp.exp(jnp.where(mask, diff, 0.0)), 0.0)
        attn = jnp.einsum('bhtk,bhsk,bhtsk->bhts', qc, kc, decay)
        o_intra = jnp.einsum('bhts,bhsv->bhtv', attn, vc)
        b_last = b[:, :, -1:, :]
        new_state = (jnp.exp(b_last[:, :, 0, :])[..., None] * state
                     + jnp.einsum('bhsk,bhsv->bhkv', kc * jnp.exp(b_last - b), vc))
        return new_state, o_inter + o_intra

    state0 = jnp.zeros((bsz, nh, dk, dv), jnp.float32)
    _, o = lax.scan(step, state0, (to_chunks(q), to_chunks(k), to_chunks(v), to_chunks(logf)))
    return o.transpose(1, 0, 3, 2, 4).reshape(bsz, seq, nh, dv)


def hgrn2_mixer(q_in, f_in, i_in, g_in, lb, out_norm):
    bsz, seq, _ = q_in.shape
    z = f_in.astype(jnp.float32)
    lb = lb.astype(jnp.float32)
    logf = jnp.log(lb + (1.0 - lb) * jax.nn.sigmoid(z))
    k = (1.0 - lb) * jax.nn.sigmoid(-z)
    q = jax.nn.silu(q_in.astype(jnp.float32))

    def heads(t):
        return t.reshape(bsz, seq, HG_HEADS, t.shape[-1] // HG_HEADS)

    o = hgrn2_chunkwise(heads(q), heads(k), heads(i_in.astype(jnp.float32)), heads(logf))
    o = rmsnorm(o, out_norm) * jax.nn.silu(heads(g_in.astype(jnp.float32)))
    return o.reshape(bsz, seq, HG_WIDTH).astype(q_in.dtype)


def causal_dwconv(u, w, b):
    seq = u.shape[1]
    taps = w.shape[0]
    up = jnp.pad(u, ((0, 0), (taps - 1, 0), (0, 0)))
    out = b
    for j in range(taps):
        out = out + up[:, j:j + seq] * w[j]
    return out


def conv_geglu_ffn(h, w_up, conv_w, conv_b, w_down):
    u = causal_dwconv(h @ w_up, conv_w, conv_b)
    gate, val = jnp.split(u, 2, axis=-1)
    return (jax.nn.gelu(gate, approximate=True) * val) @ w_down


def setup_inputs(seed: int = 0) -> dict:
    key = jax.random.key(seed)
    k = jax.random.split(key, 32)
    L = DEPTH

    def nrm(i, shape, scale=1.0):
        return scale * jax.random.normal(k[i], shape, jnp.float32)

    def gain(i, shape):
        return 1.0 + nrm(i, shape, 0.1)

    x = nrm(0, (BATCH, SEQ, D_MODEL))
    c = nrm(1, (BATCH, D_MODEL))
    offsets = jax.random.randint(k[2], (BATCH, 1), 0, 1024, dtype=jnp.int32)
    positions = offsets + jnp.arange(SEQ, dtype=jnp.int32)[None, :]
    w_in = nrm(3, (L, D_MODEL, D_IN), D_MODEL ** -0.5)
    s5_lambda_re = -0.5 + nrm(4, (L, S5_GROUPS, S5_STATE), 0.01)
    s5_lambda_im = math.pi * jnp.arange(S5_STATE, dtype=jnp.float32) + nrm(5, (L, S5_GROUPS, S5_STATE), 0.01)
    s5_log_dt = jax.random.uniform(k[6], (L, S5_GROUPS), jnp.float32, math.log(1e-3), math.log(1e-1))
    s5_b_re = nrm(7, (L, S5_GROUPS, S5_STATE, S5_GROUP), (2 * S5_GROUP) ** -0.5)
    s5_b_im = nrm(8, (L, S5_GROUPS, S5_STATE, S5_GROUP), (2 * S5_GROUP) ** -0.5)
    s5_c_re = nrm(9, (L, S5_GROUPS, S5_GROUP, S5_STATE), (2 * S5_STATE) ** -0.5)
    s5_c_im = nrm(10, (L, S5_GROUPS, S5_GROUP, S5_STATE), (2 * S5_STATE) ** -0.5)
    s5_d = nrm(11, (L, S5_WIDTH))
    s5_w_glu = nrm(12, (L, S5_WIDTH, S5_WIDTH), S5_WIDTH ** -0.5)
    mla_q_norm = gain(13, (L, MLA_Q_RANK))
    mla_w_uq = nrm(14, (L, MLA_Q_RANK, MLA_HEADS * (MLA_NOPE + MLA_ROPE)), MLA_Q_RANK ** -0.5)
    mla_kv_norm = gain(15, (L, MLA_KV_RANK))
    mla_w_ukv = nrm(16, (L, MLA_KV_RANK, MLA_HEADS * (MLA_NOPE + MLA_V)), MLA_KV_RANK ** -0.5)
    hg_lb_logits = nrm(17, (L, HG_HEADS * HG_DK), 0.5)
    hg_out_norm = gain(18, (L, HG_DV))
    w_out = nrm(19, (L, D_MIX, D_MODEL), D_MIX ** -0.5)
    mix_pre_norm = gain(20, (L, D_MODEL))
    mix_post_norm = gain(21, (L, D_MODEL))
    ffn_pre_norm = gain(22, (L, D_MODEL))
    ffn_post_norm = gain(23, (L, D_MODEL))
    ffn_w_up = nrm(24, (L, D_MODEL, 2 * D_FF), D_MODEL ** -0.5)
    ffn_conv_w = nrm(25, (L, CONV_W, 2 * D_FF), CONV_W ** -0.5)
    ffn_conv_b = nrm(26, (L, 2 * D_FF), 0.02)
    ffn_w_down = nrm(27, (L, D_FF, D_MODEL), D_FF ** -0.5)
    w_ada = nrm(28, (L, D_MODEL, 6 * D_MODEL), 0.5 * D_MODEL ** -0.5)
    b_ada = nrm(29, (L, 6 * D_MODEL), 0.02)
    return {'x': x, 'c': c, 'positions': positions, 'w_in': w_in,
            's5_lambda_re': s5_lambda_re, 's5_lambda_im': s5_lambda_im, 's5_log_dt': s5_log_dt,
            's5_b_re': s5_b_re, 's5_b_im': s5_b_im, 's5_c_re': s5_c_re, 's5_c_im': s5_c_im,
            's5_d': s5_d, 's5_w_glu': s5_w_glu,
            'mla_q_norm': mla_q_norm, 'mla_w_uq': mla_w_uq, 'mla_kv_norm': mla_kv_norm, 'mla_w_ukv': mla_w_ukv,
            'hg_lb_logits': hg_lb_logits, 'hg_out_norm': hg_out_norm, 'w_out': w_out,
            'mix_pre_norm': mix_pre_norm, 'mix_post_norm': mix_post_norm,
            'ffn_pre_norm': ffn_pre_norm, 'ffn_post_norm': ffn_post_norm,
            'ffn_w_up': ffn_w_up, 'ffn_conv_w': ffn_conv_w, 'ffn_conv_b': ffn_conv_b, 'ffn_w_down': ffn_w_down,
            'w_ada': w_ada, 'b_ada': b_ada}


def reference(x, c, positions, w_in, s5_lambda_re, s5_lambda_im, s5_log_dt, s5_b_re, s5_b_im,
              s5_c_re, s5_c_im, s5_d, s5_w_glu, mla_q_norm, mla_w_uq, mla_kv_norm, mla_w_ukv,
              hg_lb_logits, hg_out_norm, w_out, mix_pre_norm, mix_post_norm, ffn_pre_norm, ffn_post_norm,
              ffn_w_up, ffn_conv_w, ffn_conv_b, ffn_w_down, w_ada, b_ada):
    cos, sin = rope_tables(positions)
    probs = jax.nn.softmax(hg_lb_logits.astype(jnp.float32), axis=0)
    lower_bounds = jnp.cumsum(probs, axis=0) - probs[0:1]
    c_act = jax.nn.silu(c)
    for l in range(DEPTH):
        mod = c_act @ w_ada[l] + b_ada[l]
        sh1, sc1, g1, sh2, sc2, g2 = jnp.split(mod[:, None, :], 6, axis=-1)
        h = rmsnorm(x, mix_pre_norm[l]) * (1.0 + sc1) + sh1
        proj = h @ w_in[l]
        u_s5, c_q, c_kv, k_rope, hq, hf, hi, hg = jnp.split(proj, IN_OFFSETS, axis=-1)
        y_s5 = s5_mixer(u_s5, s5_lambda_re[l], s5_lambda_im[l], s5_log_dt[l], s5_b_re[l], s5_b_im[l],
                        s5_c_re[l], s5_c_im[l], s5_d[l], s5_w_glu[l])
        y_mla = mla_mixer(c_q, c_kv, k_rope, mla_q_norm[l], mla_w_uq[l], mla_kv_norm[l], mla_w_ukv[l], cos, sin)
        y_hg = hgrn2_mixer(hq, hf, hi, hg, lower_bounds[l], hg_out_norm[l])
        mixed = jnp.concatenate([y_s5, y_mla, y_hg], axis=-1) @ w_out[l]
        x = x + g1 * rmsnorm(mixed, mix_post_norm[l])
        h = rmsnorm(x, ffn_pre_norm[l]) * (1.0 + sc2) + sh2
        y = conv_geglu_ffn(h, ffn_w_up[l], ffn_conv_w[l], ffn_conv_b[l], ffn_w_down[l])
        x = x + g2 * rmsnorm(y, ffn_post_norm[l])
    return x
```

```cpp
#include <hip/hip_runtime.h>
#include <cstdio>
#include <cstdint>
namespace pg8 {
#define PG8_LAS __attribute__((address_space(3)))
typedef unsigned short bf16_t;
typedef short bf16x8 __attribute__((ext_vector_type(8)));
typedef float f32x4 __attribute__((ext_vector_type(4)));
typedef unsigned u32x4 __attribute__((ext_vector_type(4)));
constexpr int BM = 256, BK = 64, HALF = 128, HTB = HALF * BK * 2  , STAGE_BYTES = 8 * HTB, NXCD = 8, WGM = 8;

__host__ __device__ __forceinline__ int lds_byte(int r, int c) { const int st = (r >> 4) * 2 + (c >> 5), rr = r & 15, cc = c & 31, ob = rr * 64 + cc * 2; return st * 1024 + (ob ^ (((ob >> 9) & 1) << 5)); }
__host__ __device__ __forceinline__ void stage_rc(int b, int& R, int& C) { const int st = b / 1024, sb = b % 1024, swz = sb ^ (((sb >> 9) & 1) << 5); R = (st >> 1) * 16 + swz / 64; C = (st & 1) * 32 + (swz % 64) / 2; }
__host__ __device__ __forceinline__ int perm32(int rho) { const int n = rho >> 4, i = rho & 15; return 8 * (i >> 2) + 4 * n + (i & 3); }

__device__ __forceinline__ __amdgpu_buffer_rsrc_t wt_rsrc(const void* base, size_t nbytes) { return __builtin_amdgcn_make_buffer_rsrc((void*)base, 0, (int)nbytes, 0x00020000); }
__device__ __forceinline__ void st16_wt(__amdgpu_buffer_rsrc_t r, size_t byte_off, u32x4 v) { __builtin_amdgcn_raw_buffer_store_b128(v, r, (int)byte_off, 0, 16); }
struct Unit { int pm, pn; };
struct Gemm { const bf16_t* A; const bf16_t* Bt; int M, N, K; const bf16_t* A2 = nullptr; int pn_split = 1 << 30; };

struct StaticOrder {
    int nM, nN, nwg, G, c;
    __host__ __device__ void init(int M, int N, int G_, int c_) { nM = M / BM; nN = N / BM; nwg = nM * nN; G = G_; c = c_; }
    __host__ __device__ __forceinline__ bool next(int i, Unit& u) const {
        const long L = (long)i * G + c; if (L >= nwg) return false;
        int wgid = (int)L; { const int q = nwg / NXCD, r = nwg % NXCD, xcd = wgid % NXCD, off = wgid / NXCD; wgid = (xcd < r ? xcd * (q + 1) : r * (q + 1) + (xcd - r) * q) + off; }
        const int nig = WGM * nN, gid = wgid / nig, fm = gid * WGM, gsz = (nM - fm) < WGM ? (nM - fm) : WGM;
        u.pm = fm + ((wgid % nig) % gsz); u.pn = (wgid % nig) / gsz; return true;
    }
    __device__ __forceinline__ void a_ready(const Unit&) const {}
    __device__ __forceinline__ void done(const Unit&) const {}
};

__device__ __forceinline__ unsigned cvt_pk_bf16(float lo, float hi) { typedef float f2_ __attribute__((ext_vector_type(2))); typedef __bf16 b2_ __attribute__((ext_vector_type(2))); const b2_ r = __builtin_convertvector((f2_){lo, hi}, b2_); return __builtin_bit_cast(unsigned, r); }
typedef float f32x2 __attribute__((ext_vector_type(2)));
__device__ __forceinline__ f32x2 gelu_pk(f32x2 v) {
    const f32x2 av = __builtin_elementwise_abs(v), d = av * 0.2316418882f + 1.0f;
    f32x2 t; t.x = __builtin_amdgcn_rcpf(d.x); t.y = __builtin_amdgcn_rcpf(d.y);
    f32x2 q = t * 0.5307027145f + (-0.7265760135f); q = q * t + 0.7107068705f; q = q * t + (-0.142248368f); q = q * t + 0.127414796f; q = q * t;
    const f32x2 s = (v * v) * (-0.72134752044f);
    f32x2 e; e.x = __builtin_amdgcn_exp2f(s.x); e.y = __builtin_amdgcn_exp2f(s.y);
    const f32x2 m = v * (q * e), r = v - m;
    f32x2 o; o.x = v.x < 0.f ? m.x : r.x; o.y = v.y < 0.f ? m.y : r.y; return o;
}

template <int ACT  > struct EpiBf16 {
    static constexpr bool PERM = true, AFTER_DRAIN = false, PERMA = false; static_assert(ACT == 0 || ACT == 1, "EpiBf16: ACT is 0 (none) or 1 (gelu_pk)");
    bf16_t* O; int ldc; const float* bias; int split_cols; size_t split_stride; float scale0;
    __device__ __forceinline__ void operator()(const f32x4 (&acc)[2][2][4][2], const Unit& u, int wr, int wc, int fr, int fq) const {
        const int row0 = u.pm * BM + wr * 64 + fr; int colt = u.pn * BM; bf16_t* base = O;
        float sc = 1.f; if (split_cols) { const int t = colt / split_cols; base += (size_t)t * split_stride; colt -= t * split_cols; if (t == 0) sc = scale0; }
        const int col0 = colt + wc * 32 + 8 * fq, bcol0 = u.pn * BM + wc * 32 + 8 * fq;
        f32x4 bv[2][2];
#pragma unroll
        for (int bj = 0; bj < 2; ++bj)
#pragma unroll
            for (int n = 0; n < 2; ++n) bv[bj][n] = bias ? *(const f32x4*)(bias + bcol0 + bj * HALF + 4 * n) : (f32x4){0.f, 0.f, 0.f, 0.f};
#pragma unroll
        for (int ai = 0; ai < 2; ++ai)
#pragma unroll
            for (int m = 0; m < 4; ++m) { bf16_t* rowp = base + (size_t)(row0 + ai * HALF + m * 16) * ldc + col0;
#pragma unroll
                for (int bj = 0; bj < 2; ++bj) { f32x4 v0 = acc[ai][bj][m][0] + bv[bj][0], v1 = acc[ai][bj][m][1] + bv[bj][1];
                    if (ACT == 1) { f32x2 a = gelu_pk((f32x2){v0[0], v0[1]}), b = gelu_pk((f32x2){v0[2], v0[3]}), c = gelu_pk((f32x2){v1[0], v1[1]}), d = gelu_pk((f32x2){v1[2], v1[3]});
                        v0 = (f32x4){a.x, a.y, b.x, b.y}; v1 = (f32x4){c.x, c.y, d.x, d.y}; }
                    v0 = v0 * sc; v1 = v1 * sc; u32x4 w; w.x = cvt_pk_bf16(v0[0], v0[1]); w.y = cvt_pk_bf16(v0[2], v0[3]); w.z = cvt_pk_bf16(v1[0], v1[1]); w.w = cvt_pk_bf16(v1[2], v1[3]);
                    *(u32x4*)(rowp + bj * HALF) = w; } }
    }
};
struct EpiF32 {
    static constexpr bool PERM = false, AFTER_DRAIN = false, PERMA = false;
    float* C; int ldc; const float* bias;
    __device__ __forceinline__ void operator()(const f32x4 (&acc)[2][2][4][2], const Unit& u, int wr, int wc, int fr, int fq) const {
        const int row0 = u.pm * BM + wr * 64 + fr, col0 = u.pn * BM + wc * 32 + 4 * fq;
        f32x4 bv[2][2];
#pragma unroll
        for (int bj = 0; bj < 2; ++bj)
#pragma unroll
            for (int n = 0; n < 2; ++n) bv[bj][n] = bias ? *(const f32x4*)(bias + col0 + bj * HALF + n * 16) : (f32x4){0.f, 0.f, 0.f, 0.f};
#pragma unroll
        for (int ai = 0; ai < 2; ++ai)
#pragma unroll
            for (int m = 0; m < 4; ++m) { float* rowp = C + (size_t)(row0 + ai * HALF + m * 16) * ldc + col0;
#pragma unroll
                for (int bj = 0; bj < 2; ++bj)
#pragma unroll
                    for (int n = 0; n < 2; ++n) *(f32x4*)(rowp + bj * HALF + n * 16) = acc[ai][bj][m][n] + bv[bj][n]; }
    }
};
struct EpiGlu {
    static constexpr bool PERM = true, AFTER_DRAIN = false, PERMA = false;
    const bf16_t* Y; int ldy; bf16_t* O; int ldo;
    __device__ __forceinline__ void operator()(const f32x4 (&acc)[2][2][4][2], const Unit& u, int wr, int wc, int fr, int fq) const {
        const int row0 = u.pm * BM + wr * 64 + fr, col0 = u.pn * BM + wc * 32 + 8 * fq;
#pragma unroll
        for (int ai = 0; ai < 2; ++ai)
#pragma unroll
            for (int m = 0; m < 4; ++m) { const size_t row = (size_t)(row0 + ai * HALF + m * 16);
#pragma unroll
                for (int bj = 0; bj < 2; ++bj) { const int col = col0 + bj * HALF;
                    const u32x4 yv = *(const u32x4*)(Y + row * ldy + col); const unsigned yw[4] = {yv.x, yv.y, yv.z, yv.w};
                    const f32x4 v0 = acc[ai][bj][m][0], v1 = acc[ai][bj][m][1]; const float vv[8] = {v0[0], v0[1], v0[2], v0[3], v1[0], v1[1], v1[2], v1[3]};
                    float o[8];
#pragma unroll
                    for (int e = 0; e < 8; ++e) { const float y = __builtin_bit_cast(float, (yw[e >> 1] >> ((e & 1) * 16)) << 16); o[e] = y / (1.f + __expf(-vv[e])); }
                    u32x4 w; w.x = cvt_pk_bf16(o[0], o[1]); w.y = cvt_pk_bf16(o[2], o[3]); w.z = cvt_pk_bf16(o[4], o[5]); w.w = cvt_pk_bf16(o[6], o[7]);
                    *(u32x4*)(O + row * ldo + col) = w; } }
    }
};
struct EpiQ {
    static constexpr bool PERM = true, AFTER_DRAIN = false, PERMA = false;
    bf16_t* Q; const float* ssq; const float* cosT; const float* sinT;
    __device__ __forceinline__ void operator()(const f32x4 (&acc)[2][2][4][2], const Unit& u, int wr, int wc, int fr, int fq) const {
        const int row0 = u.pm * BM + wr * 64 + fr;
#pragma unroll
        for (int ai = 0; ai < 2; ++ai)
#pragma unroll
            for (int m = 0; m < 4; ++m) { const int row = row0 + ai * HALF + m * 16, b = row >> 12, s = row & 4095; const f32x4 sa = *(const f32x4*)(ssq + (size_t)row * 8), sb = *(const f32x4*)(ssq + (size_t)row * 8 + 4); const float r = __builtin_amdgcn_rsqf((((sa[0] + sa[1]) + (sa[2] + sa[3])) + ((sb[0] + sb[1]) + (sb[2] + sb[3]))) * (1.f / 512.f) + 1e-6f) * 0.10411754f;
                if (u.pn < 4) {
#pragma unroll
                    for (int bj = 0; bj < 2; ++bj) { const int h = 2 * u.pn + bj; const f32x4 v0 = acc[ai][bj][m][0] * r, v1 = acc[ai][bj][m][1] * r;
                        u32x4 w; w.x = cvt_pk_bf16(v0[0], v0[1]); w.y = cvt_pk_bf16(v0[2], v0[3]); w.z = cvt_pk_bf16(v1[0], v1[1]); w.w = cvt_pk_bf16(v1[2], v1[3]);
                        *(u32x4*)(Q + ((size_t)(b * 8 + h) * 4096 + s) * 192 + wc * 32 + 8 * fq) = w; }
                } else {
                    const int f0 = ((wc & 1) * 4 + fq) * 4; const f32x4 cs = *(const f32x4*)(cosT + (size_t)row * 32 + f0), sn = *(const f32x4*)(sinT + (size_t)row * 32 + f0);
#pragma unroll
                    for (int bj = 0; bj < 2; ++bj) { const int h = (u.pn - 4) * 4 + bj * 2 + (wc >> 1); const f32x4 x1 = acc[ai][bj][m][0] * r, x2 = acc[ai][bj][m][1] * r;
                        const f32x4 o1 = x1 * cs - x2 * sn, o2 = x2 * cs + x1 * sn;
                        bf16_t* qp = Q + ((size_t)(b * 8 + h) * 4096 + s) * 192 + 128 + f0;
                        typedef unsigned u32x2 __attribute__((ext_vector_type(2)));
                        *(u32x2*)qp = (u32x2){cvt_pk_bf16(o1[0], o1[1]), cvt_pk_bf16(o1[2], o1[3])};
                        *(u32x2*)(qp + 32) = (u32x2){cvt_pk_bf16(o2[0], o2[1]), cvt_pk_bf16(o2[2], o2[3])}; }
                } }
    }
};
struct EpiKV {
    static constexpr bool PERM = true, AFTER_DRAIN = false, PERMA = false;
    bf16_t* Kf; bf16_t* V; const float* ssq;
    __device__ __forceinline__ void operator()(const f32x4 (&acc)[2][2][4][2], const Unit& u, int wr, int wc, int fr, int fq) const {
        const int row0 = u.pm * BM + wr * 64 + fr, h = u.pn, d = wc * 32 + 8 * fq;
#pragma unroll
        for (int ai = 0; ai < 2; ++ai)
#pragma unroll
            for (int m = 0; m < 4; ++m) { const int row = row0 + ai * HALF + m * 16, b = row >> 12, s = row & 4095; const f32x4 sa = *(const f32x4*)(ssq + (size_t)row * 4); const float r = __builtin_amdgcn_rsqf(((sa[0] + sa[1]) + (sa[2] + sa[3])) * (1.f / 256.f) + 1e-6f);
#pragma unroll
                for (int bj = 0; bj < 2; ++bj) { const f32x4 v0 = acc[ai][bj][m][0] * r, v1 = acc[ai][bj][m][1] * r;
                    u32x4 w; w.x = cvt_pk_bf16(v0[0], v0[1]); w.y = cvt_pk_bf16(v0[2], v0[3]); w.z = cvt_pk_bf16(v1[0], v1[1]); w.w = cvt_pk_bf16(v1[2], v1[3]);
                    bf16_t* dst = bj ? V + ((size_t)(b * 8 + h) * 4096 + s) * 128 + d : Kf + ((size_t)(b * 8 + h) * 4096 + s) * 192 + d;
                    *(u32x4*)dst = w; } }
    }
};
__device__ __forceinline__ f32x4 dpp_shr1(f32x4 v) { f32x4 o;
#pragma unroll
    for (int i = 0; i < 4; ++i) { const float f_ = v[i]; o[i] = __int_as_float(__builtin_amdgcn_update_dpp(0, __float_as_int(f_), 0x111, 0xf, 0xf, true)); }
    return o; }
__device__ __forceinline__ float gelu_tanh1(float x) { const float t = 0.7978845608028654f * (x + 0.044715f * x * x * x); return x * __builtin_amdgcn_rcpf(1.f + __builtin_amdgcn_exp2f(-2.885390081777927f * t)); }
struct EpiUp {
    static constexpr bool PERM = true, AFTER_DRAIN = false, PERMA = true;
    bf16_t* ACT; float* HALO; const float* cw; const float* cb;
    __device__ __forceinline__ void operator()(const f32x4 (&acc)[2][2][4][2], const Unit& u, int wr, int wc, int fr, int fq) const {
        const int ch0 = u.pn * 128 + wc * 32 + 8 * fq, prow = u.pm * BM + (wr * 16 + fr) * 8, blk = u.pm * 2 + wr;
        unsigned pk[8][2];
#pragma unroll
        for (int n = 0; n < 2; ++n) {
            const int c = ch0 + 4 * n;
            const f32x4 wg0 = *(const f32x4*)(cw + c), wg1 = *(const f32x4*)(cw + 11008 + c), wg2 = *(const f32x4*)(cw + 22016 + c), bg = *(const f32x4*)(cb + c);
            const f32x4 wv0 = *(const f32x4*)(cw + 5504 + c), wv1 = *(const f32x4*)(cw + 11008 + 5504 + c), wv2 = *(const f32x4*)(cw + 22016 + 5504 + c), bv = *(const f32x4*)(cb + 5504 + c);
#define XG(j) acc[(j) >> 2][0][(j) & 3][n]
#define XV(j) acc[(j) >> 2][1][(j) & 3][n]
            const f32x4 gm1 = dpp_shr1(XG(7)), gm2 = dpp_shr1(XG(6)), vm1 = dpp_shr1(XV(7)), vm2 = dpp_shr1(XV(6));
            if (fr == 0) { float* hp = HALO + (size_t)(blk * 4) * 11008 + c; *(f32x4*)hp = XG(0); *(f32x4*)(hp + 11008) = XG(1); *(f32x4*)(hp + 5504) = XV(0); *(f32x4*)(hp + 11008 + 5504) = XV(1); }
            if (fr == 15) { float* hp = HALO + (size_t)(blk * 4 + 2) * 11008 + c; *(f32x4*)hp = XG(6); *(f32x4*)(hp + 11008) = XG(7); *(f32x4*)(hp + 5504) = XV(6); *(f32x4*)(hp + 11008 + 5504) = XV(7); }
#pragma unroll
            for (int j = 0; j < 8; ++j) {
                const f32x4 g2 = (j >= 2) ? XG(j >= 2 ? j - 2 : 0) : (j == 0 ? gm2 : gm1), g1 = (j >= 1) ? XG(j >= 1 ? j - 1 : 0) : gm1;
                const f32x4 v2 = (j >= 2) ? XV(j >= 2 ? j - 2 : 0) : (j == 0 ? vm2 : vm1), v1 = (j >= 1) ? XV(j >= 1 ? j - 1 : 0) : vm1;
                const f32x4 cg = bg + wg0 * g2 + wg1 * g1 + wg2 * XG(j), cv = bv + wv0 * v2 + wv1 * v1 + wv2 * XV(j);
                const unsigned p0 = cvt_pk_bf16(gelu_tanh1(cg[0]) * cv[0], gelu_tanh1(cg[1]) * cv[1]), p1 = cvt_pk_bf16(gelu_tanh1(cg[2]) * cv[2], gelu_tanh1(cg[3]) * cv[3]);
                if (n == 0) { pk[j][0] = p0; pk[j][1] = p1; }
                else if (!(fr == 0 && j < 2)) *(u32x4*)(ACT + (size_t)(prow + j) * 5504 + ch0) = (u32x4){pk[j][0], pk[j][1], p0, p1};
            }
#undef XG
#undef XV
        }
    }
};
struct EpiProj {
    static constexpr bool PERM = true, AFTER_DRAIN = false, PERMA = false;
    bf16_t *U16, *CQ, *CKV, *HQ, *HV, *HGT, *KF; float* LOGF; float* ssq_q; float* ssq_kv; const float* lb; const float* cosT; const float* sinT;
    __device__ __forceinline__ void operator()(const f32x4 (&acc)[2][2][4][2], const Unit& u, int wr, int wc, int fr, int fq) const {
        const int row0 = u.pm * BM + wr * 64 + fr, col8 = wc * 32 + 8 * fq, pn = u.pn;
        if (pn == 13) {
            if (wc < 2) { const int f0 = (wc * 4 + fq) * 4;
#pragma unroll
                for (int ai = 0; ai < 2; ++ai)
#pragma unroll
                    for (int m = 0; m < 4; ++m) { const int row = row0 + ai * HALF + m * 16, b = row >> 12, s = row & 4095;
                        const f32x4 cs = *(const f32x4*)(cosT + (size_t)row * 32 + f0), sn = *(const f32x4*)(sinT + (size_t)row * 32 + f0);
                        const f32x4 x1 = acc[ai][0][m][0], x2 = acc[ai][0][m][1]; const f32x4 o1 = x1 * cs - x2 * sn, o2 = x2 * cs + x1 * sn;
                        typedef unsigned u32x2 __attribute__((ext_vector_type(2)));
                        const u32x2 w1 = (u32x2){cvt_pk_bf16(o1[0], o1[1]), cvt_pk_bf16(o1[2], o1[3])}, w2 = (u32x2){cvt_pk_bf16(o2[0], o2[1]), cvt_pk_bf16(o2[2], o2[3])};
#pragma unroll
                        for (int h = 0; h < 8; ++h) { bf16_t* kp = KF + ((size_t)(b * 8 + h) * 4096 + s) * 192 + 128 + f0; *(u32x2*)kp = w1; *(u32x2*)(kp + 32) = w2; } } }
            return;
        }
        if (pn == 7 || pn == 8) {
            const int cbase = (pn - 7) * 256;
#pragma unroll
            for (int bj = 0; bj < 2; ++bj) { const int col = cbase + bj * HALF + col8; const f32x4 l0 = *(const f32x4*)(lb + col), l1 = *(const f32x4*)(lb + col + 4);
#pragma unroll
                for (int ai = 0; ai < 2; ++ai)
#pragma unroll
                    for (int m = 0; m < 4; ++m) { const size_t row = (size_t)(row0 + ai * HALF + m * 16); f32x4 o0, o1;
#pragma unroll
                        for (int e = 0; e < 4; ++e) { const float z0 = acc[ai][bj][m][0][e], z1 = acc[ai][bj][m][1][e];
                            o0[e] = __logf(l0[e] + (1.f - l0[e]) * __builtin_amdgcn_rcpf(1.f + __expf(-z0))); o1[e] = __logf(l1[e] + (1.f - l1[e]) * __builtin_amdgcn_rcpf(1.f + __expf(-z1))); }
                        *(f32x4*)(LOGF + row * 512 + col) = o0; *(f32x4*)(LOGF + row * 512 + col + 4) = o1; } }
            return;
        }
        bf16_t* base; int ld, cbase, nslot = 0, slot0 = 0; bool act = false; float* ssq = nullptr;
        if (pn < 2) { base = U16; ld = 512; cbase = pn * 256; }
        else if (pn < 4) { base = CQ; ld = 512; cbase = (pn - 2) * 256; ssq = ssq_q; nslot = 8; slot0 = (pn - 2) * 4; }
        else if (pn == 4) { base = CKV; ld = 256; cbase = 0; ssq = ssq_kv; nslot = 4; }
        else if (pn < 7) { base = HQ; ld = 512; cbase = (pn - 5) * 256; act = true; }
        else if (pn < 11) { base = HV; ld = 512; cbase = (pn - 9) * 256; }
        else { base = HGT; ld = 512; cbase = (pn - 11) * 256; act = true; }
#pragma unroll
        for (int ai = 0; ai < 2; ++ai)
#pragma unroll
            for (int m = 0; m < 4; ++m) { const size_t row = (size_t)(row0 + ai * HALF + m * 16); float ss = 0.f;
#pragma unroll
                for (int bj = 0; bj < 2; ++bj) { f32x4 v0 = acc[ai][bj][m][0], v1 = acc[ai][bj][m][1];
                    ss += (v0[0] * v0[0] + v0[1] * v0[1]) + (v0[2] * v0[2] + v0[3] * v0[3]) + (v1[0] * v1[0] + v1[1] * v1[1]) + (v1[2] * v1[2] + v1[3] * v1[3]);
                    if (act) {
#pragma unroll
                        for (int e = 0; e < 4; ++e) { v0[e] = v0[e] * __builtin_amdgcn_rcpf(1.f + __expf(-v0[e])); v1[e] = v1[e] * __builtin_amdgcn_rcpf(1.f + __expf(-v1[e])); } }
                    u32x4 w; w.x = cvt_pk_bf16(v0[0], v0[1]); w.y = cvt_pk_bf16(v0[2], v0[3]); w.z = cvt_pk_bf16(v1[0], v1[1]); w.w = cvt_pk_bf16(v1[2], v1[3]);
                    *(u32x4*)(base + row * ld + cbase + bj * HALF + col8) = w; }
                if (ssq) { ss += __shfl_xor(ss, 16); ss += __shfl_xor(ss, 32); if (fq == 0) ssq[row * nslot + slot0 + wc] = ss; } }
    }
};
struct EpiQGlu {
    static constexpr bool PERM = true, AFTER_DRAIN = false, PERMA = false;
    EpiQ q; EpiGlu glu;
    __device__ __forceinline__ void operator()(const f32x4 (&acc)[2][2][4][2], const Unit& u, int wr, int wc, int fr, int fq) const {
        if (u.pn < 6) q(acc, u, wr, wc, fr, fq);
        else { Unit v; v.pm = u.pm; v.pn = u.pn - 6; glu(acc, v, wr, wc, fr, fq); }
    }
};
template <class Epi, class Sched, bool ALIGN_EPI = false, bool SP2 = false>
__device__ __forceinline__ void gemm_phase(PG8_LAS unsigned char* lds, const Gemm g, const Sched& S, const Epi& E) {
    int tid_ = threadIdx.x; asm volatile("" : "+v"(tid_));
    const int tid = tid_, wid = __builtin_amdgcn_readfirstlane(tid >> 6), lane = tid & 63, wr = wid >> 2, wc = wid & 3, fr = lane & 15, fq = lane >> 4;
    const int K = g.K, nt = K / BK;
    unsigned voffA[2], voffB[2];
#pragma unroll
    for (int i = 0; i < 2; ++i) { int R, C; stage_rc(tid * 16 + i * 8192, R, C); const int Rb = Epi::PERM ? ((R & ~31) + perm32(R & 31)) : R;
        const int Ra = Epi::PERMA ? (((R >> 6) & 1) * 128 + (R & 15) * 8 + ((R >> 4) & 3)) : R;
        voffA[i] = (unsigned)(Ra * K + C) * 2u; voffB[i] = (unsigned)(Rb * K + C) * 2u; }
    const size_t kstep = (size_t)(BK * 2);
    const size_t hstep = (size_t)HALF * K * 2;
    const size_t hstepA = Epi::PERMA ? (size_t)4 * K * 2 : hstep;
    const size_t tstep = 2 * hstep;
    const unsigned ldsw = (unsigned)wid * 1024u;
    const int aoff = lds_byte(wr * 64 + fr, fq * 8), boff = lds_byte(wc * 32 + fr, fq * 8);
#define PG8_SA(b, h) (((b) * 2 + (h)) * HTB)
#define PG8_SB(b, h) ((4 + (b) * 2 + (h)) * HTB)
#define PG8_STAGE(bufoff, gbase, voff) do { _Pragma("unroll") for (int _i = 0; _i < 2; ++_i) \
        __builtin_amdgcn_global_load_lds((const unsigned*)((const char*)(gbase) + (voff)[_i]), (PG8_LAS unsigned*)(lds + (bufoff) + ldsw + _i * 8192), 16, 0, 0); } while (0)
#define PG8_LDA(dst, b, h) do { _Pragma("unroll") for (int m = 0; m < 4; ++m) _Pragma("unroll") for (int k = 0; k < 2; ++k) dst[m][k] = *(const PG8_LAS bf16x8*)(lds + PG8_SA(b, h) + aoff + m * 2048 + k * 1024); } while (0)
#define PG8_LDB(dst, b, h) do { _Pragma("unroll") for (int n = 0; n < 2; ++n) _Pragma("unroll") for (int k = 0; k < 2; ++k) dst[n][k] = *(const PG8_LAS bf16x8*)(lds + PG8_SB(b, h) + boff + n * 2048 + k * 1024); } while (0)
#define PG8_MMA(ai, bj, At, Bt) do { __builtin_amdgcn_s_setprio(1); _Pragma("unroll") for (int m = 0; m < 4; ++m) _Pragma("unroll") for (int n = 0; n < 2; ++n) _Pragma("unroll") for (int k = 0; k < 2; ++k) \
        acc[ai][bj][m][n] = __builtin_amdgcn_mfma_f32_16x16x32_bf16(Bt[n][k], At[m][k], acc[ai][bj][m][n], 0, 0, 0); __builtin_amdgcn_s_setprio(0); } while (0)
#define PG8_WAIT_V(n) asm volatile("s_waitcnt vmcnt(" #n ")" ::: "memory")
#define PG8_WAIT_L(n) asm volatile("s_waitcnt lgkmcnt(" #n ")" ::: "memory")
#define PG8_BAR __builtin_amdgcn_s_barrier()
#define PG8_SCHED __builtin_amdgcn_sched_barrier(0)
    Unit cur, nxt; int ui = 0;
    if (!S.next(0, cur)) return;
    f32x4 acc[2][2][4][2];
#pragma unroll
    for (int a = 0; a < 2; ++a)
#pragma unroll
        for (int b = 0; b < 2; ++b)
#pragma unroll
            for (int m = 0; m < 4; ++m)
#pragma unroll
                for (int n = 0; n < 2; ++n) acc[a][b][m][n] = (f32x4){0.f, 0.f, 0.f, 0.f};
    bf16x8 At[4][2], B0[2][2], B1[2][2];
    const char* cA = (const char*)(cur.pn >= g.pn_split ? g.A2 : g.A) + (size_t)cur.pm * tstep; const char* cB = (const char*)g.Bt + (size_t)cur.pn * tstep;
    S.a_ready(cur);
    if constexpr (SP2) {
        PG8_STAGE(PG8_SB(0, 0), cB, voffB); PG8_STAGE(PG8_SB(0, 1), cB + hstep, voffB); PG8_STAGE(PG8_SA(0, 0), cA, voffA); PG8_STAGE(PG8_SA(0, 1), cA + hstepA, voffA);
        if (wr == 1) PG8_BAR;
        PG8_WAIT_V(2); PG8_BAR;
        PG8_STAGE(PG8_SB(1, 0), cB + kstep, voffB); PG8_STAGE(PG8_SA(1, 0), cA + kstep, voffA); PG8_STAGE(PG8_SB(1, 1), cB + hstep + kstep, voffB);
        PG8_WAIT_V(6); PG8_BAR;
    } else {
        PG8_STAGE(PG8_SB(0, 0), cB, voffB); PG8_STAGE(PG8_SA(0, 0), cA, voffA); PG8_STAGE(PG8_SB(0, 1), cB + hstep, voffB); PG8_STAGE(PG8_SA(0, 1), cA + hstepA, voffA);
        if (wr == 1) PG8_BAR;
        PG8_WAIT_V(4); PG8_BAR;
        PG8_STAGE(PG8_SB(1, 0), cB + kstep, voffB); PG8_STAGE(PG8_SA(1, 0), cA + kstep, voffA); PG8_STAGE(PG8_SB(1, 1), cB + hstep + kstep, voffB);
        PG8_WAIT_V(6); PG8_BAR;
    }
    for (;;) {
        const bool has_next = S.next(ui + 1, nxt);
        const char* nA = has_next ? (const char*)(nxt.pn >= g.pn_split ? g.A2 : g.A) + (size_t)nxt.pm * tstep : cA; const char* nB = has_next ? (const char*)g.Bt + (size_t)nxt.pn * tstep : cB;
        for (int t = 0; t < nt; t += 2) {
            const bool last = (t == nt - 2);
            const char* a1 = cA + (size_t)(t + 1) * kstep;
            const char* a2 = last ? nA : cA + (size_t)(t + 2) * kstep; const char* b2 = last ? nB : cB + (size_t)(t + 2) * kstep;
            const char* a3 = a2 + kstep; const char* b3 = b2 + kstep;
            if (last && has_next) S.a_ready(nxt);
            if constexpr (SP2) {
            PG8_LDB(B0, 0, 0); PG8_LDB(B1, 0, 1); PG8_SCHED; PG8_LDA(At, 0, 0); PG8_STAGE(PG8_SA(1, 1), a1 + hstepA, voffA);
            PG8_WAIT_V(8); PG8_WAIT_L(0); PG8_BAR; PG8_MMA(0, 0, At, B0); PG8_MMA(0, 1, At, B1); PG8_BAR; PG8_SCHED;
            PG8_LDA(At, 0, 1); PG8_STAGE(PG8_SB(0, 0), b2, voffB); PG8_STAGE(PG8_SB(0, 1), b2 + hstep, voffB); PG8_STAGE(PG8_SA(0, 0), a2, voffA);
            PG8_WAIT_V(8); PG8_WAIT_L(0); PG8_BAR; PG8_MMA(1, 0, At, B0); PG8_MMA(1, 1, At, B1); PG8_BAR; PG8_SCHED;
            PG8_LDB(B0, 1, 0); PG8_LDB(B1, 1, 1); PG8_SCHED; PG8_LDA(At, 1, 0); PG8_STAGE(PG8_SA(0, 1), a2 + hstepA, voffA);
            PG8_WAIT_V(8); PG8_WAIT_L(0); PG8_BAR; PG8_MMA(0, 0, At, B0); PG8_MMA(0, 1, At, B1); PG8_BAR; PG8_SCHED;
            PG8_LDA(At, 1, 1); PG8_STAGE(PG8_SB(1, 0), b3, voffB); PG8_STAGE(PG8_SB(1, 1), b3 + hstep, voffB); PG8_STAGE(PG8_SA(1, 0), a3, voffA);
            PG8_WAIT_V(8); PG8_WAIT_L(0); PG8_BAR; PG8_MMA(1, 0, At, B0); PG8_MMA(1, 1, At, B1); PG8_BAR; PG8_SCHED;
            } else {
            PG8_LDB(B0, 0, 0); PG8_SCHED; PG8_LDA(At, 0, 0); PG8_STAGE(PG8_SA(1, 1), a1 + hstepA, voffA);
            PG8_WAIT_L(8); PG8_BAR; PG8_WAIT_L(0); PG8_MMA(0, 0, At, B0); PG8_BAR; PG8_SCHED;
            PG8_LDB(B1, 0, 1); PG8_STAGE(PG8_SB(0, 0), b2, voffB);
            PG8_BAR; PG8_WAIT_L(0); PG8_MMA(0, 1, At, B1); PG8_BAR;
            PG8_LDA(At, 0, 1); PG8_STAGE(PG8_SA(0, 0), a2, voffA);
            PG8_BAR; PG8_WAIT_L(0); PG8_MMA(1, 0, At, B0); PG8_BAR; PG8_SCHED;
            PG8_STAGE(PG8_SB(0, 1), b2 + hstep, voffB);
            PG8_WAIT_V(6); PG8_BAR; PG8_MMA(1, 1, At, B1); PG8_BAR;
            PG8_LDB(B0, 1, 0); PG8_SCHED; PG8_LDA(At, 1, 0); PG8_STAGE(PG8_SA(0, 1), a2 + hstepA, voffA);
            PG8_WAIT_L(8); PG8_BAR; PG8_WAIT_L(0); PG8_MMA(0, 0, At, B0); PG8_BAR; PG8_SCHED;
            PG8_LDB(B1, 1, 1); PG8_STAGE(PG8_SB(1, 0), b3, voffB);
            PG8_BAR; PG8_WAIT_L(0); PG8_MMA(0, 1, At, B1); PG8_BAR;
            PG8_LDA(At, 1, 1); PG8_STAGE(PG8_SA(1, 0), a3, voffA);
            PG8_BAR; PG8_WAIT_L(0); PG8_MMA(1, 0, At, B0); PG8_BAR; PG8_SCHED;
            PG8_STAGE(PG8_SB(1, 1), b3 + hstep, voffB);
            PG8_WAIT_V(6); PG8_BAR; PG8_MMA(1, 1, At, B1); PG8_BAR;
            }
        }
        if constexpr (ALIGN_EPI) { if (wr == 0) PG8_BAR; }
        if constexpr (!Epi::AFTER_DRAIN) { E(acc, cur, wr, wc, fr, fq); S.done(cur); }
        if (!has_next) break;
#pragma unroll
        for (int a = 0; a < 2; ++a)
#pragma unroll
            for (int b = 0; b < 2; ++b)
#pragma unroll
                for (int m = 0; m < 4; ++m)
#pragma unroll
                    for (int n = 0; n < 2; ++n) acc[a][b][m][n] = (f32x4){0.f, 0.f, 0.f, 0.f};
        cur = nxt; cA = nA; cB = nB; ++ui;
        if constexpr (ALIGN_EPI) { if (wr == 1) PG8_BAR; }
    }
    PG8_WAIT_V(0);
    if constexpr (!ALIGN_EPI) { if (wr == 0) PG8_BAR; }
    PG8_BAR;
    if constexpr (Epi::AFTER_DRAIN) { E.fused(acc, cur, wr, wc, fr, fq, lds, wid, lane); S.done(cur); }
#undef PG8_SA
#undef PG8_SB
#undef PG8_STAGE
#undef PG8_LDA
#undef PG8_LDB
#undef PG8_MMA
#undef PG8_WAIT_V
#undef PG8_WAIT_L
#undef PG8_BAR
#undef PG8_SCHED
}
}
constexpr int NB = 4, SEQ = 4096, DM = 2048, NL = 4, M = NB * SEQ;
constexpr int DIN = 3392, DINP = 3584;
constexpr int NH = 8, DQK = 192, QRANK = 512, KVRANK = 256;
constexpr int DFF = 5504, DFF2 = 11008;
constexpr float EPS = 1e-6f;
constexpr int PC_S5 = 0, PC_CQ = 512, PC_CKV = 1024, PC_HQ = 1280, PC_HF = 1792, PC_HI = 2304, PC_HG = 2816, PC_KR = 3328;
constexpr int NWAVES = 8, NTHR = 512;
constexpr int LDS_BYTES = 147456, RING_BYTES = 131072, CTRL_OFF = LDS_BYTES - 2048, MISC_OFF = CTRL_OFF + 320;

enum { I_X = 0, I_C, I_POS, I_WIN, I_LRE, I_LIM, I_LDT, I_BRE, I_BIM, I_CRE, I_CIM, I_S5D, I_WGLU, I_QN, I_WUQ, I_KVN, I_WUKV, I_LB, I_HGN, I_WOUT,
       I_MPRE, I_MPOST, I_FPRE, I_FPOST, I_WUP, I_CW, I_CB, I_WDN, I_WADA, I_BADA, N_IN };

constexpr size_t MiB = 1u << 20;
#ifndef MK_ONE_LAUNCH
#define MK_ONE_LAUNCH 1
#endif
constexpr size_t WS_CTL = 0, CTL_ZERO_BYTES = 1 * MiB;
constexpr int CW_BAR = 4096;
constexpr size_t WS_MODP = 1 * MiB;
constexpr size_t WS_MOD = 13 * MiB;
constexpr size_t WS_COS = 14 * MiB, WS_SIN = 16 * MiB;
constexpr size_t WS_LB = 18 * MiB;
constexpr size_t WS_RSTDQ = 18 * MiB + 65536, WS_RSTDKV = 18 * MiB + 2 * 65536;
constexpr size_t WS_W = 19 * MiB;
constexpr size_t WL_IN = 0, WL_UQ = WL_IN + (size_t)DINP * DM * 2, WL_GLU = WL_UQ + (size_t)1536 * 512 * 2  , WL_UKV = WL_GLU + (size_t)512 * 512 * 2,
                 WL_OUT = WL_UKV + (size_t)2048 * 256 * 2, WL_UP = WL_OUT + (size_t)DM * DM * 2, WL_DN = WL_UP + (size_t)DFF2 * DM * 2, WL_SIZE = WL_DN + (size_t)DM * DFF * 2;
static_assert(WL_SIZE == 93847552, "weight bytes per layer");
constexpr size_t WS_X = 378 * MiB;
constexpr size_t WS_H = 506 * MiB;
constexpr size_t WS_T1 = 570 * MiB;
constexpr size_t WS_T2 = 914 * MiB;
constexpr size_t WS_ACT = 1138 * MiB;
constexpr size_t WS_CAT = 1310 * MiB;
constexpr size_t WS_MISC = 1374 * MiB;
constexpr size_t WS_CQ = WS_MISC, WS_CKV = WS_MISC + 16 * MiB, WS_YG16 = WS_MISC + 24 * MiB, WS_DS5 = WS_MISC + 40 * MiB, WS_HP = WS_MISC + 44 * MiB, WS_BLAST = WS_MISC + 46 * MiB;
constexpr size_t WS_U16 = WS_T1, WS_HQ = WS_T1 + 16 * MiB, WS_LOGF = WS_T1 + 32 * MiB, WS_HV = WS_T1 + 64 * MiB, WS_HGT = WS_T1 + 80 * MiB;
constexpr size_t WS_SSQQ = WS_MISC + 47 * MiB, WS_SSQKV = WS_MISC + 47 * MiB + 512 * 1024;
constexpr size_t WS_DST = WS_T1 + 224 * MiB;
constexpr size_t WS_S5T = WS_T1 + 96 * MiB;
constexpr size_t WS_HALO = WS_T1 + 310 * MiB;
constexpr size_t WS_SPT = WS_ACT + 128 * MiB;
constexpr size_t WS_PW = 1510 * MiB;
constexpr size_t WS_BBAR = 1515 * MiB;
constexpr size_t WS_END = 1516 * MiB;
static_assert(WS_W + NL * WL_SIZE <= WS_X, "weights fit");

#define GAS __attribute__((address_space(1)))
#define LAS __attribute__((address_space(3)))
typedef unsigned short bf16;
typedef unsigned v4u __attribute__((ext_vector_type(4)));
typedef unsigned v2u __attribute__((ext_vector_type(2)));
typedef float f32x4 __attribute__((ext_vector_type(4)));
typedef GAS unsigned gu32;
#define RLX_AGENT __ATOMIC_RELAXED, __HIP_MEMORY_SCOPE_AGENT
#define LDS_WAIT() asm volatile("s_waitcnt lgkmcnt(0)" ::: "memory")
__device__ __forceinline__ unsigned f2bf(float f) { unsigned u = __builtin_bit_cast(unsigned, f); return (u + 0x7fffu + ((u >> 16) & 1u)) >> 16; }
__device__ __forceinline__ unsigned pk2(float lo, float hi) { return f2bf(lo) | (f2bf(hi) << 16); }
__device__ __forceinline__ float bf2f(unsigned short b) { return __builtin_bit_cast(float, ((unsigned)b) << 16); }
__device__ __forceinline__ float wave_sum(float v) {
#pragma unroll
    for (int o = 1; o < 64; o <<= 1) v += __shfl_xor(v, o);
    return v;
}
__device__ __forceinline__ float sigmoidf_(float x) { return 1.f / (1.f + __expf(-x)); }
__device__ __forceinline__ float siluf_(float x) { return x / (1.f + __expf(-x)); }
__device__ __forceinline__ float gelu_tanh(float x) { const float t = 0.7978845608028654f * (x + 0.044715f * x * x * x); return x / (1.f + __expf(-2.f * t)); }
#define XB_TMO      128
#define XB_XCNT(j)  (256  + 64 * (j))
#define XB_XSUB(j)  (1280 + 64 * (j))
#define XB_XGEN(j)  (2304 + 64 * (j))
#define XB_TOP      3328
#define XB_TOPGEN   3392
#define XCD_BAR_WORDS 3456
#define XB_SPIN_CAP (1u << 18)

__device__ __forceinline__ unsigned xb_ld(unsigned* p)              { return __hip_atomic_load(p, __ATOMIC_RELAXED, __HIP_MEMORY_SCOPE_AGENT); }
__device__ __forceinline__ unsigned xb_add(unsigned* p, unsigned v) { return __hip_atomic_fetch_add(p, v, __ATOMIC_RELAXED, __HIP_MEMORY_SCOPE_AGENT); }
__device__ __forceinline__ unsigned xb_xcc_id() { return (unsigned)__builtin_amdgcn_s_getreg((3 << 11) | 20) & 0xFu; }
#define XB_SPIN(cond, bar) do { unsigned _sp = 0; while (cond) { __builtin_amdgcn_s_sleep(1); \
    if ((++_sp & 255u) == 0u) { if (xb_ld(&(bar)[XB_TMO])) break; if (_sp > XB_SPIN_CAP) { atomicAdd(&(bar)[XB_TMO], 1u); break; } } } } while (0)

struct XcdBarrier {
    unsigned* bar; unsigned x;
    volatile LAS unsigned* st;
};

__device__ __forceinline__ XcdBarrier xcd_barrier_post(unsigned* bar, volatile LAS unsigned* st) {
    XcdBarrier b; b.bar = bar; b.x = xb_xcc_id(); b.st = st;
    if (threadIdx.x == 0) (void)xb_add(&bar[XB_XCNT(b.x)], 1u);
    return b;
}
__device__ __forceinline__ void xcd_barrier_complete(unsigned* bar, unsigned x, unsigned& nloc, unsigned& nx) {
    const unsigned G = gridDim.x * gridDim.y * gridDim.z;
    unsigned sum, cnt, mine, sp = 0u;
    for (;;) {
        sum = 0u; cnt = 0u; mine = 0u;
#pragma unroll
        for (unsigned j = 0; j < 16; ++j) { const unsigned c = xb_ld(&bar[XB_XCNT(j)]); sum += c; cnt += (c > 0u) ? 1u : 0u; mine = (j == x) ? c : mine; }
        if (sum == G) break;
        __builtin_amdgcn_s_sleep(1);
        if ((++sp & 255u) == 0u) { if (xb_ld(&bar[XB_TMO])) break; if (sp > XB_SPIN_CAP) { atomicAdd(&bar[XB_TMO], 1u); break; } }
    }
    nloc = mine > 0u ? mine : 1u; nx = cnt > 0u ? cnt : 1u;
}

__device__ __forceinline__ void xcd_barrier(const XcdBarrier& b) {
    asm volatile("s_waitcnt vmcnt(0)" ::: "memory");
    __syncthreads();
    if (threadIdx.x == 0) {
        unsigned* bar = b.bar;
        __builtin_amdgcn_s_waitcnt(0);
        unsigned nloc = b.st[0], nx = b.st[1];
        if (nloc == 0u) { xcd_barrier_complete(bar, b.x, nloc, nx); b.st[0] = nloc; b.st[1] = nx; }
        const unsigned old = xb_add(&bar[XB_XSUB(b.x)], 1u);
        const unsigned gen = old / nloc;
        if (old + 1u == (gen + 1u) * nloc) {
            __builtin_amdgcn_fence(__ATOMIC_RELEASE, "agent");
            asm volatile("s_waitcnt vmcnt(0)" ::: "memory");
            const unsigned og = xb_add(&bar[XB_TOP], 1u);
            const unsigned tg = og / nx;
            if (og + 1u == (tg + 1u) * nx) xb_add(&bar[XB_TOPGEN], 1u);
            else XB_SPIN(xb_ld(&bar[XB_TOPGEN]) == tg, bar);
            __builtin_amdgcn_fence(__ATOMIC_ACQUIRE, "agent");
            xb_add(&bar[XB_XGEN(b.x)], 1u);
            asm volatile("s_waitcnt vmcnt(0)" ::: "memory");
        } else {
            XB_SPIN(xb_ld(&bar[XB_XGEN(b.x)]) == gen, bar);
            __builtin_amdgcn_fence(__ATOMIC_ACQUIRE, "agent");
            asm volatile("s_waitcnt vmcnt(0)" ::: "memory");
        }
    }
    __syncthreads();
}
namespace att {
typedef short bf16x8 __attribute__((ext_vector_type(8)));
typedef short s16x4 __attribute__((ext_vector_type(4)));
typedef float f32x16 __attribute__((ext_vector_type(16)));
typedef float f32x4 __attribute__((ext_vector_type(4)));
typedef unsigned u32x4 __attribute__((ext_vector_type(4)));
constexpr int DQ = 192, DVV = 128, QBLK = 32, KVBLK = 64, QB = 256;
constexpr int SHM_V = KVBLK * DVV * 2, SHM_K = KVBLK * DQ * 2;
constexpr int LDS_V = 0, LDS_K = 3 * SHM_V, LDS_WS = LDS_K + 2 * SHM_K, LDS_OST = LDS_WS + 8 * 64 * 4, ATT_LDS = LDS_OST;
constexpr float SCALE = 0.07216878364870322f;
constexpr float QSCALE = SCALE * 1.4426950408889634f;
constexpr float THR2 = 8.f * 1.4426950408889634f;
#define SBAR() __builtin_amdgcn_sched_barrier(0)
__device__ __forceinline__ int v_st(int k, int c) { const int kk = (k & ~0xC) | ((k & 4) << 1) | ((k & 8) >> 1); return ((kk >> 3) * 4 + (c >> 5)) * 512 + ((kk & 7) * 32 + (c & 31)) * 2; }
__device__ __forceinline__ int v_rd_base(int lane) { return ((lane & 3) << 3) | (((lane >> 2) & 3) << 6) | (((lane >> 4) & 1) << 5) | (((lane >> 5) & 1) << 8); }
constexpr int v_rd_off(int d0, int ks, int half) { return d0 * 512 + ks * 4096 + half * 2048; }
__device__ __forceinline__ int crow(int r, int hi) { return (r & 3) + 8 * (r >> 2) + 4 * hi; }
__device__ __forceinline__ unsigned cvtpk(float lo, float hi) { typedef float f2_ __attribute__((ext_vector_type(2))); typedef __bf16 b2_ __attribute__((ext_vector_type(2))); const b2_ r = __builtin_convertvector((f2_){lo, hi}, b2_); return __builtin_bit_cast(unsigned, r); }
__device__ __forceinline__ int k_off(int row, int chunk  ) { return (chunk >> 3) * 8192 + row * 128 + ((((chunk & 7) ^ ((row >> 1) & 7))) << 4); }

__device__ __forceinline__ void mask_tile(f32x16& p0, f32x16& p1, int dq) {
    const float NEG = -__builtin_inff();
#pragma unroll
    for (int r = 0; r < 16; ++r) { const int c = (r & 3) + 8 * (r >> 2);
        if (dq - c < 0) p0[r] = NEG;
        if (dq - c - 32 < 0) p1[r] = NEG; }
}
__device__ __forceinline__ void partialSM(f32x16& p0, f32x16& p1, float& m_reg, float bs, float& alpha) {
    float pmax = p0[0];
#pragma unroll
    for (int r = 1; r < 16; ++r) pmax = fmaxf(pmax, p0[r]);
#pragma unroll
    for (int r = 0; r < 16; ++r) pmax = fmaxf(pmax, p1[r]);
    { auto rr = __builtin_amdgcn_permlane32_swap(__float_as_uint(pmax), __float_as_uint(pmax), false, false);
      pmax = fmaxf(__uint_as_float(rr[0]), __uint_as_float(rr[1])); }
    if (__builtin_expect(__all(pmax + bs - m_reg <= THR2), 1)) { alpha = 1.f; }
    else { const float mn = fmaxf(m_reg, pmax + bs); alpha = __builtin_amdgcn_exp2f(m_reg - mn); const float off = bs - mn; m_reg = mn;
#pragma unroll
        for (int r = 0; r < 16; ++r) { p0[r] += off; p1[r] += off; } }
#pragma unroll
    for (int r = 0; r < 16; ++r) p0[r] = __builtin_amdgcn_exp2f(p0[r]);
#pragma unroll
    for (int r = 0; r < 16; ++r) p1[r] = __builtin_amdgcn_exp2f(p1[r]);
}
__device__ __forceinline__ void finishSM(f32x16& p0, f32x16& p1, float alpha, float& l_reg, bf16x8& pa0, bf16x8& pa1, bf16x8& pa2, bf16x8& pa3) {
    float ps = 0;
#pragma unroll
    for (int r = 0; r < 16; ++r) ps += p0[r];
#pragma unroll
    for (int r = 0; r < 16; ++r) ps += p1[r];
    { auto rr = __builtin_amdgcn_permlane32_swap(__float_as_uint(ps), __float_as_uint(ps), false, false);
      ps = __uint_as_float(rr[0]) + __uint_as_float(rr[1]); }
    l_reg = l_reg * alpha + ps;
#define PK4(P, B_, OUT) do { unsigned a0 = cvtpk(P[B_+0], P[B_+1]), a1 = cvtpk(P[B_+2], P[B_+3]);                          \
        unsigned b0 = cvtpk(P[B_+4], P[B_+5]), b1 = cvtpk(P[B_+6], P[B_+7]);                                             \
        auto r0 = __builtin_amdgcn_permlane32_swap(a0, b0, false, false); auto r1 = __builtin_amdgcn_permlane32_swap(a1, b1, false, false); \
        u32x4 w = {r0[0], r1[0], r0[1], r1[1]}; OUT = *reinterpret_cast<bf16x8*>(&w); } while (0)
    PK4(p0, 0, pa0); PK4(p0, 8, pa1); PK4(p1, 0, pa2); PK4(p1, 8, pa3);
#undef PK4
}
__device__ __forceinline__ void qkt(f32x16& p0, f32x16& p1, const LAS unsigned char* lds, int kbuf, int r32, int hi, const bf16x8* qr, float init) {
#pragma unroll
    for (int r = 0; r < 16; ++r) { p0[r] = init; p1[r] = init; }
    const int e = hi ^ ((r32 >> 1) & 7);
    int kb[4];
#pragma unroll
    for (int j = 0; j < 4; ++j) kb[j] = (int)(uintptr_t)lds + kbuf + r32 * 128 + ((((j << 1) ^ e)) << 4);
#define KRD(dst, d0_, h_) asm volatile("ds_read_b128 %0, %1 offset:%2" : "=&v"(dst) : "v"(kb[(d0_) & 3]), "i"(((d0_) >> 2) * 8192 + (h_) * 4096) : "memory")
    bf16x8 ka[3][2];
    KRD(ka[0][0], 0, 0); KRD(ka[0][1], 0, 1); KRD(ka[1][0], 1, 0); KRD(ka[1][1], 1, 1);
#pragma unroll
    for (int d0 = 0; d0 < 12; ++d0) {
        if (d0 + 2 < 12) { KRD(ka[(d0 + 2) % 3][0], d0 + 2, 0); KRD(ka[(d0 + 2) % 3][1], d0 + 2, 1); asm volatile("s_waitcnt lgkmcnt(4)" ::: "memory"); }
        else if (d0 == 10) asm volatile("s_waitcnt lgkmcnt(2)" ::: "memory");
        else asm volatile("s_waitcnt lgkmcnt(0)" ::: "memory");
        SBAR();
        p0 = __builtin_amdgcn_mfma_f32_32x32x16_bf16(ka[d0 % 3][0], qr[d0], p0, 0, 0, 0);
        p1 = __builtin_amdgcn_mfma_f32_32x32x16_bf16(ka[d0 % 3][1], qr[d0], p1, 0, 0, 0);
        SBAR(); }
#undef KRD
}
__device__ __forceinline__ void pv_tile(f32x16* o, int vb0, bf16x8 pa0, bf16x8 pa1, bf16x8 pa2, bf16x8 pa3) {
#define TRRD(dst, off) asm volatile("ds_read_b64_tr_b16 %0, %1 offset:%2" : "=&v"(dst) : "v"(vb0), "i"(off) : "memory")
#define PV_D0(d0) do { s16x4 l0, l1, l2, l3, h0, h1, h2, h3; constexpr int b_ = v_rd_off(d0, 0, 0); \
        TRRD(l0, b_); TRRD(h0, b_ + 2048); TRRD(l1, b_ + 4096); TRRD(h1, b_ + 6144); TRRD(l2, b_ + 8192); TRRD(h2, b_ + 10240); TRRD(l3, b_ + 12288); TRRD(h3, b_ + 14336); \
        asm volatile("s_waitcnt lgkmcnt(0)" ::: "memory"); SBAR();   \
        o[d0] = __builtin_amdgcn_mfma_f32_32x32x16_bf16(pa0, (bf16x8){l0[0], l0[1], l0[2], l0[3], h0[0], h0[1], h0[2], h0[3]}, o[d0], 0, 0, 0);   \
        o[d0] = __builtin_amdgcn_mfma_f32_32x32x16_bf16(pa1, (bf16x8){l1[0], l1[1], l1[2], l1[3], h1[0], h1[1], h1[2], h1[3]}, o[d0], 0, 0, 0);   \
        o[d0] = __builtin_amdgcn_mfma_f32_32x32x16_bf16(pa2, (bf16x8){l2[0], l2[1], l2[2], l2[3], h2[0], h2[1], h2[2], h2[3]}, o[d0], 0, 0, 0);   \
        o[d0] = __builtin_amdgcn_mfma_f32_32x32x16_bf16(pa3, (bf16x8){l3[0], l3[1], l3[2], l3[3], h3[0], h3[1], h3[2], h3[3]}, o[d0], 0, 0, 0); } while (0)
    PV_D0(0); PV_D0(1); PV_D0(2); PV_D0(3);
#undef PV_D0
#undef TRRD
}
__device__ __forceinline__ void attn_block(const unsigned short* Q, const unsigned short* K, const unsigned short* V, unsigned short* O, int opitch, int qb, LAS unsigned char* lds) {
    int tid_ = threadIdx.x; asm volatile("" : "+v"(tid_));
    const int tid = tid_, wid = __builtin_amdgcn_readfirstlane(tid >> 6), lane = tid & 63, r32 = lane & 31, hi = lane >> 5;
    const int P0 = qb * QB, NT = (P0 + QB) / KVBLK;
    const int qlo = P0 + wid * QBLK, qpos = qlo + r32;
    LAS float* wsf = (LAS float*)(lds + LDS_WS) + wid * 64; LAS float* li_l = wsf; LAS float* al_l = wsf + 32;
    int voff[2], koff[3];
#pragma unroll
    for (int i = 0; i < 2; ++i) { const int P = (wid * 2 + i) * 1024 + lane * 16, sub = P >> 9, within = P & 511, kk = (sub >> 2) * 8 + (within >> 6);
        const int k = (kk & ~0xC) | ((kk & 4) << 1) | ((kk & 8) >> 1), c = (sub & 3) * 32 + ((within & 63) >> 1); voff[i] = k * DVV + c; }
#pragma unroll
    for (int i = 0; i < 3; ++i) { const int P = (wid * 3 + i) * 1024 + lane * 16, sblk = P >> 13, rem = P & 8191, row = rem >> 7, cc = ((rem & 127) >> 4) ^ ((row >> 1) & 7); koff[i] = row * DQ + sblk * 64 + cc * 8; }
    bf16x8 qr[12];
#pragma unroll
    for (int d0 = 0; d0 < 12; ++d0) qr[d0] = *(const bf16x8*)(Q + (size_t)(P0 + wid * QBLK + r32) * DQ + d0 * 16 + hi * 8);
#define SDMA(kb0, kbuf, vbuf) do { \
        _Pragma("unroll") for (int i = 0; i < 2; ++i) __builtin_amdgcn_global_load_lds((const unsigned*)(V + (size_t)(kb0) * DVV + voff[i]), (LAS unsigned*)(lds + LDS_V + (vbuf) * SHM_V + (wid * 2 + i) * 1024), 16, 0, 0); \
        _Pragma("unroll") for (int i = 0; i < 3; ++i) __builtin_amdgcn_global_load_lds((const unsigned*)(K + (size_t)(kb0) * DQ + koff[i]), (LAS unsigned*)(lds + LDS_K + (kbuf) * SHM_K + (wid * 3 + i) * 1024), 16, 0, 0); } while (0)
    __syncthreads();
    SDMA(0, 0, 0);
    asm volatile("s_waitcnt vmcnt(0)" ::: "memory"); __syncthreads();
    float m_reg = -1e30f, l_reg = 0.f; f32x16 o[4] = {};
    const int vbase = (int)(uintptr_t)(lds + LDS_V) + v_rd_base(lane);
    const bool late = wid >= 4;
    f32x16 p0, p1; float bs = 0.f; bool pend = false; int pt = 0;
#define SMPV() do { float alpha; bf16x8 pa0, pa1, pa2, pa3; \
        partialSM(p0, p1, m_reg, bs, alpha); finishSM(p0, p1, alpha, l_reg, pa0, pa1, pa2, pa3); \
        if (__any(alpha < 1.f)) { if (hi == 0) al_l[r32] = alpha; asm volatile("s_waitcnt lgkmcnt(0)" ::: "memory"); \
            _Pragma("unroll") for (int d_ = 0; d_ < 4; ++d_) _Pragma("unroll") for (int r = 0; r < 16; ++r) o[d_][r] *= al_l[crow(r, hi)]; } \
        pv_tile(o, vbase + (pt % 3) * SHM_V, pa0, pa1, pa2, pa3); pend = false; } while (0)
    for (int t = 0; t <= NT; ++t) {
        if (t + 1 < NT) SDMA((t + 1) * KVBLK, (t & 1) ^ 1, (t + 1) % 3);
        if (late && pend) SMPV();
        if (t < NT && t * KVBLK <= qlo + QBLK - 1) {
            bs = m_reg > -1e29f ? m_reg : 0.f;
            qkt(p0, p1, lds, LDS_K + (t & 1) * SHM_K, r32, hi, qr, -bs);
            if (t * KVBLK + KVBLK - 1 > qlo) mask_tile(p0, p1, qpos - t * KVBLK - 4 * hi);
            pend = true; pt = t; }
        if (!late && pend) SMPV();
        asm volatile("s_waitcnt vmcnt(0)" ::: "memory"); __syncthreads();
    }
#undef SMPV
    if (hi == 0) li_l[r32] = l_reg; asm volatile("s_waitcnt lgkmcnt(0)" ::: "memory");
    unsigned short* Ow = O + (size_t)(P0 + wid * QBLK) * opitch;
#pragma unroll
    for (int r = 0; r < 16; ++r) { const int orow = crow(r, hi); const float rl = __builtin_amdgcn_rcpf(li_l[orow]);
#pragma unroll
        for (int d0 = 0; d0 < 4; ++d0) { const float v = o[d0][r] * rl; const float vn = __shfl_xor(v, 1);
            if ((r32 & 1) == 0) *(unsigned*)(Ow + (size_t)orow * opitch + d0 * 32 + r32) = cvtpk(v, vn); } }
#undef SDMA
}
#undef SBAR
}
struct Args { const void* in[N_IN]; float* out; unsigned char* ws; int ph_lo, ph_hi; };
struct Frame {
    LAS unsigned char* lds; unsigned char* ldsg;
    int tid, lane, wave, G, bid;
    unsigned char* ws;
    const void* const* in;
};
constexpr int PTAB_OFF = CTRL_OFF + 1024;
__device__ __forceinline__ const void* ldp(const Frame& F, int i) {
    const unsigned long long v = ((const LAS unsigned long long*)(F.lds + PTAB_OFF))[i];
    const unsigned lo = __builtin_amdgcn_readfirstlane((unsigned)v), hi = __builtin_amdgcn_readfirstlane((unsigned)(v >> 32));
    return (const void*)(const GAS void*)(((unsigned long long)hi << 32) | lo); }
#define INF(i) ((const float*)ldp(F, i))
__device__ __forceinline__ bf16* wt(const Frame& F, int l, size_t off) { return (bf16*)(F.ws + WS_W + (size_t)l * WL_SIZE + off); }

__device__ __forceinline__ void tr_item(const float* W, int ldw, int K, int k0, int sc, const float* kscale, bf16* dst  , LAS float* scr, int lane) {
    float v[64];
    const float* src = W + (size_t)k0 * ldw + (sc >= 0 ? sc : 0);
#pragma unroll
    for (int i = 0; i < 64; ++i) v[i] = sc >= 0 ? src[(size_t)i * ldw] : 0.f;
#pragma unroll
    for (int i = 0; i < 64; ++i) scr[i * 65 + lane] = v[i];
    LDS_WAIT(); asm volatile("" ::: "memory");
    const int c = lane & 7;
    f32x4 ks0 = (f32x4){1.f, 1.f, 1.f, 1.f}, ks1 = ks0;
    if (kscale) { ks0 = *(const f32x4*)(kscale + k0 + 8 * c); ks1 = *(const f32x4*)(kscale + k0 + 8 * c + 4); }
#pragma unroll
    for (int j = 0; j < 8; ++j) { const int n = (lane >> 3) + 8 * j; const LAS float* s = scr + (8 * c) * 65 + n;
        v4u o; o.x = pk2(s[0 * 65] * ks0.x, s[1 * 65] * ks0.y); o.y = pk2(s[2 * 65] * ks0.z, s[3 * 65] * ks0.w); o.z = pk2(s[4 * 65] * ks1.x, s[5 * 65] * ks1.y); o.w = pk2(s[6 * 65] * ks1.z, s[7 * 65] * ks1.w);
        *(v4u*)(dst + (size_t)n * K + k0 + 8 * c) = o; }
    LDS_WAIT(); asm volatile("" ::: "memory");
}
__device__ __forceinline__ int uq_srccol(int n) {
    if (n < 1024) return (n >> 7) * 192 + (n & 127);
    const int r = n - 1024, h = r >> 6, pos = r & 63, i = pos >> 3, e = pos & 7, f = 4 * i + (e & 3);
    return h * 192 + 128 + (e < 4 ? f : 32 + f);
}
__device__ __forceinline__ int win_srccol(int n) {
    if (n < 1280) return n;
    if (n < 3328) return n + 64;
    if (n < 3392) { const int pos = n - 3328, i = pos >> 3, e = pos & 7, f = 4 * i + (e & 3); return 1280 + (e < 4 ? f : 32 + f); }
    return -1;
}

namespace mx {
typedef short bf16x8 __attribute__((ext_vector_type(8)));
typedef float f32x16 __attribute__((ext_vector_type(16)));
__device__ __forceinline__ int crow(int r, int hi) { return (r & 3) + 8 * (r >> 2) + 4 * hi; }
__device__ __forceinline__ unsigned cvtpk(float lo, float hi) { typedef float f2_ __attribute__((ext_vector_type(2))); typedef __bf16 b2_ __attribute__((ext_vector_type(2))); const b2_ r = __builtin_convertvector((f2_){lo, hi}, b2_); return __builtin_bit_cast(unsigned, r); }
__device__ __forceinline__ bf16x8 pack8g(const float* p) { const f32x4 a = *(const f32x4*)p, b = *(const f32x4*)(p + 4); v4u w = {cvtpk(a.x, a.y), cvtpk(a.z, a.w), cvtpk(b.x, b.y), cvtpk(b.z, b.w)}; return *reinterpret_cast<bf16x8*>(&w); }
__device__ __forceinline__ bf16x8 pack8f(const float* v) { v4u w = {cvtpk(v[0], v[1]), cvtpk(v[2], v[3]), cvtpk(v[4], v[5]), cvtpk(v[6], v[7])}; return *reinterpret_cast<bf16x8*>(&w); }
#define MX_MFMA(a, b, c) __builtin_amdgcn_mfma_f32_32x32x16_bf16(a, b, c, 0, 0, 0)
__device__ __forceinline__ void acc_to_A(const f32x16& p, bf16x8& lo, bf16x8& hi) {
#define PK4(P, B_, OUT) do { unsigned a0 = cvtpk(P[B_+0], P[B_+1]), a1 = cvtpk(P[B_+2], P[B_+3]);                          \
        unsigned b0 = cvtpk(P[B_+4], P[B_+5]), b1 = cvtpk(P[B_+6], P[B_+7]);                                             \
        auto r0 = __builtin_amdgcn_permlane32_swap(a0, b0, false, false); auto r1 = __builtin_amdgcn_permlane32_swap(a1, b1, false, false); \
        v4u w = {r0[0], r1[0], r0[1], r1[1]}; OUT = *reinterpret_cast<bf16x8*>(&w); } while (0)
    PK4(p, 0, lo); PK4(p, 8, hi);
#undef PK4
}
}

constexpr size_t S5T_WIN = 0, S5T_KT = S5T_WIN + 128 * 1024 * 2, S5T_WOUT = S5T_KT + 65 * 256 * 2, S5T_L64 = S5T_WOUT + 1024 * 128 * 2, S5T_PW = S5T_L64 + 512, S5T_SIZE = S5T_PW + 65 * 64 * 8 + 256;
static_assert(S5T_SIZE % 16 == 0, "table alignment");
__device__ __forceinline__ void s5_tables_a(Frame& F) {
    const int gt = F.bid * NTHR + F.tid, NGT = F.G * NTHR;
    for (int i = gt; i < NL * 32 * 65 * 64; i += NGT) {
        const int p = i & 63, j = (i >> 6) % 65, lg = i / (65 * 64);
        const float lre = INF(I_LRE)[lg * 64 + p], lim = INF(I_LIM)[lg * 64 + p];
        const float dt = expf(INF(I_LDT)[lg]);
        const float er = expf(lre * dt * (float)j); float sn, cs; sincosf(lim * dt * (float)j, &sn, &cs);
        ((float2*)(F.ws + WS_PW))[i] = make_float2(er * cs, er * sn);
    }
    for (int i = gt; i < NL * 32 * 64 * 16; i += NGT) {
        const int lgp = i >> 4, lg = i >> 10;
        const float lre = INF(I_LRE)[lgp], lim = INF(I_LIM)[lgp];
        const float dt = expf(INF(I_LDT)[lg]);
        const float er = expf(lre * dt); float sn, cs; sincosf(lim * dt, &sn, &cs);
        const float nr = er * cs - 1.f, ni = er * sn, den = lre * lre + lim * lim;
        const float cr = (nr * lre + ni * lim) / den, ci = (ni * lre - nr * lim) / den;
        const float xr = INF(I_BRE)[i], xi = INF(I_BIM)[i];
        ((float2*)(F.ws + WS_BBAR))[i] = make_float2(cr * xr - ci * xi, cr * xi + ci * xr);
    }
}
__device__ __forceinline__ void s5_tables_b(Frame& F, int l, int gt, int NGT) {
    const float2* pwl = (const float2*)(F.ws + WS_PW) + (size_t)l * 32 * 65 * 64;
    const float2* bbl = (const float2*)(F.ws + WS_BBAR) + (size_t)l * 32 * 64 * 16;
    const float* crl = INF(I_CRE) + (size_t)l * 32 * 16 * 64; const float* cil = INF(I_CIM) + (size_t)l * 32 * 16 * 64;
    for (int i = gt; i < 32 * 128 * 128; i += NGT) {
        const int k0 = (i & 127) * 8, n = (i >> 7) & 127, g = i >> 14;
        const int p = n & 63, ri = n >> 6, s = k0 >> 4, c0 = k0 & 15;
        const float2 w = pwl[(g * 65 + 63 - s) * 64 + p]; const f32x4* bp = (const f32x4*)(bbl + (g * 64 + p) * 16 + c0); float o[8];
#pragma unroll
        for (int q = 0; q < 4; ++q) { const f32x4 b2 = bp[q];
            o[2 * q] = ri ? (w.x * b2.y + w.y * b2.x) : (w.x * b2.x - w.y * b2.y); o[2 * q + 1] = ri ? (w.x * b2.w + w.y * b2.z) : (w.x * b2.z - w.y * b2.w); }
        *(v4u*)((bf16*)(F.ws + WS_S5T + (size_t)(l * 32 + g) * S5T_SIZE + S5T_WIN) + n * 1024 + k0) = (v4u){pk2(o[0], o[1]), pk2(o[2], o[3]), pk2(o[4], o[5]), pk2(o[6], o[7])};
    }
    for (int i = gt; i < 32 * 1024 * 16; i += NGT) {
        const int k0 = (i & 15) * 8, n = (i >> 4) & 1023, g = i >> 14;
        const int p0 = k0 & 63, ri = k0 >> 6, t = n >> 4, c = n & 15;
        const f32x4* wp = (const f32x4*)(pwl + (g * 65 + t + 1) * 64 + p0); const f32x4* crp = (const f32x4*)(crl + (g * 16 + c) * 64 + p0); const f32x4* cip = (const f32x4*)(cil + (g * 16 + c) * 64 + p0);
        const f32x4 cr0 = crp[0], cr1 = crp[1], ci0 = cip[0], ci1 = cip[1]; const float cr[8] = {cr0[0], cr0[1], cr0[2], cr0[3], cr1[0], cr1[1], cr1[2], cr1[3]}, ci[8] = {ci0[0], ci0[1], ci0[2], ci0[3], ci1[0], ci1[1], ci1[2], ci1[3]};
        float o[8];
#pragma unroll
        for (int q = 0; q < 4; ++q) { const f32x4 w2 = wp[q];
            o[2 * q] = ri ? -(cr[2 * q] * w2.y + ci[2 * q] * w2.x) : (cr[2 * q] * w2.x - ci[2 * q] * w2.y);
            o[2 * q + 1] = ri ? -(cr[2 * q + 1] * w2.w + ci[2 * q + 1] * w2.z) : (cr[2 * q + 1] * w2.z - ci[2 * q + 1] * w2.w); }
        *(v4u*)((bf16*)(F.ws + WS_S5T + (size_t)(l * 32 + g) * S5T_SIZE + S5T_WOUT) + n * 128 + k0) = (v4u){pk2(o[0], o[1]), pk2(o[2], o[3]), pk2(o[4], o[5]), pk2(o[6], o[7])};
    }
    for (int i = gt; i < 32 * 64; i += NGT) { const int p = i & 63, g = i >> 6; const float2 w = pwl[(g * 65 + 64) * 64 + p];
        float* l64 = (float*)(F.ws + WS_S5T + (size_t)(l * 32 + g) * S5T_SIZE + S5T_L64); l64[p] = w.x; l64[64 + p] = w.y; }
    for (int i = gt; i < 32 * 65 * 16; i += NGT) {
        const int cc0 = (i & 3) * 4, c0 = ((i >> 2) & 3) * 4, li = (i >> 4) % 65, g = i / (65 * 16);
        float acc[4][4];
#pragma unroll
        for (int a = 0; a < 4; ++a)
#pragma unroll
            for (int b = 0; b < 4; ++b) acc[a][b] = 0.f;
        if (li > 0) {
            for (int p = 0; p < 64; ++p) {
                const float2 w = pwl[(g * 65 + li - 1) * 64 + p];
                float2 bv[4]; float cr[4], ci[4];
#pragma unroll
                for (int b = 0; b < 4; ++b) bv[b] = bbl[(g * 64 + p) * 16 + cc0 + b];
#pragma unroll
                for (int a = 0; a < 4; ++a) { cr[a] = crl[(g * 16 + c0 + a) * 64 + p]; ci[a] = cil[(g * 16 + c0 + a) * 64 + p]; }
#pragma unroll
                for (int a = 0; a < 4; ++a) { const float er = cr[a] * w.x - ci[a] * w.y, ei = cr[a] * w.y + ci[a] * w.x;
#pragma unroll
                    for (int b = 0; b < 4; ++b) acc[a][b] += er * bv[b].x - ei * bv[b].y; }
            }
        }
        bf16* kt = (bf16*)(F.ws + WS_S5T + (size_t)(l * 32 + g) * S5T_SIZE + S5T_KT) + li * 256;
#pragma unroll
        for (int a = 0; a < 4; ++a) *(v2u*)(kt + (c0 + a) * 16 + cc0) = (v2u){pk2(acc[a][0], acc[a][1]), pk2(acc[a][2], acc[a][3])};
    }
}
__device__ __forceinline__ void s5_step1_item(Frame& F, int l, int g, int rb, const bf16* u16, float* dS) {
    const int lane = F.lane, w = F.wave, c32 = lane & 31, hi = lane >> 5, cb = w & 3, kh = w >> 2;
    const int R = rb * 32 + c32, b = R >> 6, n = R & 63;
    const bf16* arow = u16 + ((size_t)b * SEQ + n * 64) * 512 + g * 16 + 8 * hi;
    const bf16* brow = (const bf16*)(F.ws + WS_S5T + (size_t)(l * 32 + g) * S5T_SIZE + S5T_WIN) + (size_t)(cb * 32 + c32) * 1024 + 8 * hi;
    mx::f32x16 acc = {};
#pragma unroll 8
    for (int s = kh * 32; s < kh * 32 + 32; ++s) {
        const mx::bf16x8 a = *(const mx::bf16x8*)(arow + (size_t)s * 512), bb = *(const mx::bf16x8*)(brow + s * 16);
        acc = MX_MFMA(a, bb, acc);
    }
    LAS float* red = (LAS float*)F.lds;
    __syncthreads();
    if (kh == 1) {
#pragma unroll
        for (int r = 0; r < 16; ++r) red[(cb * 16 + r) * 64 + lane] = acc[r]; }
    __syncthreads();
    if (kh == 0) {
#pragma unroll
        for (int r = 0; r < 16; ++r) { const float v = acc[r] + red[(cb * 16 + r) * 64 + lane];
            dS[((size_t)g * 256 + rb * 32 + mx::crow(r, hi)) * 128 + cb * 32 + c32] = v; } }
}
__device__ __forceinline__ void s5_step3_item(Frame& F, int l, int g, int rb, const bf16* u16, const float* dS, bf16* yg16) {
    const int lane = F.lane, w = F.wave, c32 = lane & 31, hi = lane >> 5;
    LAS unsigned char* Ul = F.lds;
    LAS unsigned char* Kl = F.lds + 32 * 2064;
    __syncthreads();
    const bool scanw = F.tid < 64; const int sn0 = (rb & 1) * 32;
    float dr0[32], di0[32], dr1[32], di1[32];
    if (scanw) { const float* dp = dS + ((size_t)g * 256 + (rb >> 1) * 64) * 128 + F.tid;
#pragma unroll
        for (int j = 0; j < 32; ++j) { dr0[j] = dp[(size_t)j * 128]; di0[j] = dp[(size_t)j * 128 + 64]; }
        if (sn0) {
#pragma unroll
            for (int j = 0; j < 32; ++j) { dr1[j] = dp[(size_t)(32 + j) * 128]; di1[j] = dp[(size_t)(32 + j) * 128 + 64]; } } }
    for (int i = F.tid; i < 32 * 128; i += NTHR) {
        const int ch = i & 1, s = (i >> 1) & 63, r = i >> 7; const int R = rb * 32 + r, b = R >> 6, n = R & 63;
        *(LAS v4u*)(Ul + r * 2064 + s * 32 + ch * 16) = *(const v4u*)(u16 + ((size_t)b * SEQ + n * 64 + s) * 512 + g * 16 + ch * 8); }
    { const v4u* kt = (const v4u*)(F.ws + WS_S5T + (size_t)(l * 32 + g) * S5T_SIZE + S5T_KT);
      for (int i = F.tid; i < 65 * 32; i += NTHR) *(LAS v4u*)(Kl + i * 16) = kt[i]; }
    LAS unsigned char* Hl = Kl + 65 * 512;
    if (scanw) {
        const int p = F.tid;
        const float* l64 = (const float*)(F.ws + WS_S5T + (size_t)(l * 32 + g) * S5T_SIZE + S5T_L64);
        const float lr = l64[p], li = l64[64 + p];
        float hr = 0.f, hi2 = 0.f;
#pragma unroll
        for (int j = 0; j < 32; ++j) {
            if (!sn0) { *(LAS bf16*)(Hl + j * 272 + p * 2) = (bf16)f2bf(hr); *(LAS bf16*)(Hl + j * 272 + 128 + p * 2) = (bf16)f2bf(hi2); }
            const float nr = lr * hr - li * hi2 + dr0[j], ni = lr * hi2 + li * hr + di0[j]; hr = nr; hi2 = ni; }
        if (sn0) {
#pragma unroll
            for (int j = 0; j < 32; ++j) {
                *(LAS bf16*)(Hl + j * 272 + p * 2) = (bf16)f2bf(hr); *(LAS bf16*)(Hl + j * 272 + 128 + p * 2) = (bf16)f2bf(hi2);
                const float nr = lr * hr - li * hi2 + dr1[j], ni = lr * hi2 + li * hr + di1[j]; hr = nr; hi2 = ni; } }
    }
    __syncthreads();
    const bf16* wo = (const bf16*)(F.ws + WS_S5T + (size_t)(l * 32 + g) * S5T_SIZE + S5T_WOUT);
    mx::bf16x8 hf[8];
#pragma unroll
    for (int ks = 0; ks < 8; ++ks) hf[ks] = *(const LAS mx::bf16x8*)(Hl + c32 * 272 + ks * 32 + hi * 16);
    const float* Dv = INF(I_S5D) + l * 512 + g * 16;
#pragma unroll 1
    for (int jj = 0; jj < 4; ++jj) {
        const int j = (jj == 0) ? w : (jj == 1) ? 15 - w : (jj == 2) ? 16 + w : 31 - w;
        const int tcol = 2 * j + (c32 >> 4), ccol = c32 & 15;
        mx::f32x16 acc = {};
#pragma unroll
        for (int ks = 0; ks < 8; ++ks) { const mx::bf16x8 bb = *(const mx::bf16x8*)(wo + (size_t)(j * 32 + c32) * 128 + ks * 16 + 8 * hi); acc = MX_MFMA(bb, hf[ks], acc); }
        const LAS unsigned char* ab = Ul + c32 * 2064 + hi * 16;
        const LAS unsigned char* kb = Kl + (tcol + 1) * 512 + ccol * 32 + hi * 16;
        { mx::bf16x8 a = *(const LAS mx::bf16x8*)ab, bb = *(const LAS mx::bf16x8*)kb;
          const int ns = 2 * j + 2;
          for (int s = 0; s < ns; ++s) {
              const int sn = s + 1 < ns ? s + 1 : s;
              const mx::bf16x8 an = *(const LAS mx::bf16x8*)(ab + sn * 32), bn = *(const LAS mx::bf16x8*)(kb - sn * 512);
              acc = MX_MFMA(bb, a, acc); a = an; bb = bn; } }
        { const int Rr = rb * 32 + c32, b = Rr >> 6, nch = Rr & 63; const size_t tok0 = (size_t)b * SEQ + nch * 64 + 2 * j;
#pragma unroll
          for (int tk = 0; tk < 2; ++tk) {
              const bf16* up = u16 + (tok0 + tk) * 512 + g * 16 + 4 * hi; const float* dp = Dv + 4 * hi;
              unsigned pkx[2], pky[2];
#pragma unroll
              for (int kk = 0; kk < 2; ++kk) { const int k = 2 * tk + kk; const v2u uw = *(const v2u*)(up + 8 * kk); const f32x4 dv4 = *(const f32x4*)(dp + 8 * kk);
                  const float u0 = bf2f((unsigned short)uw.x), u1 = bf2f((unsigned short)(uw.x >> 16)), u2 = bf2f((unsigned short)uw.y), u3 = bf2f((unsigned short)(uw.y >> 16));
                  pkx[kk] = mx::cvtpk(gelu_tanh(acc[4 * k] + dv4[0] * u0), gelu_tanh(acc[4 * k + 1] + dv4[1] * u1));
                  pky[kk] = mx::cvtpk(gelu_tanh(acc[4 * k + 2] + dv4[2] * u2), gelu_tanh(acc[4 * k + 3] + dv4[3] * u3)); }
              auto rx = __builtin_amdgcn_permlane32_swap(pkx[0], pkx[1], false, false); auto ry = __builtin_amdgcn_permlane32_swap(pky[0], pky[1], false, false);
              *(v4u*)(yg16 + (tok0 + tk) * 512 + g * 16 + 8 * hi) = (v4u){rx[0], ry[0], rx[1], ry[1]}; } }
    }
}

__device__ __forceinline__ void hg_gate_loads(int h, const float* logf, size_t row0, int k, int seg, float (&g)[16]) {
#pragma unroll
    for (int j = 0; j < 16; ++j) g[j] = logf[(row0 + seg * 16 + j) * 512 + h * 128 + k];
}
__device__ __forceinline__ void hg_gate_scan(Frame& F, int k, int seg, const float (&g)[16], float (&bcum)[16], float (&kk)[16], float& bmid, float& blast) {
    LAS float* tot = (LAS float*)(F.lds + 120 * 1024);
    float run = 0.f;
#pragma unroll
    for (int j = 0; j < 16; ++j) { kk[j] = 1.f - __expf(g[j]); run += g[j]; bcum[j] = run; }
    tot[seg * 128 + k] = run;
    __syncthreads();
    float pre = 0.f;
    for (int s2 = 0; s2 < seg; ++s2) pre += tot[s2 * 128 + k];
#pragma unroll
    for (int j = 0; j < 16; ++j) bcum[j] += pre;
    if (seg == 1) tot[512 + k] = bcum[15];
    if (seg == 3) tot[640 + k] = bcum[15];
    __syncthreads();
    bmid = tot[512 + k]; blast = tot[640 + k];
}
__device__ __forceinline__ void hg_step1_item(Frame& F, int chunk  , const float* logf, const bf16* hv, bf16* dST, float* blastg) {
    const int bh = chunk >> 6, n = chunk & 63, b = bh >> 2, h = bh & 3;
    const size_t row0 = (size_t)b * SEQ + n * 64;
    const int k = F.tid & 127, seg = F.tid >> 7;
    LAS unsigned char* klT = F.lds;
    LAS unsigned char* vT = F.lds + 128 * 144;
    __syncthreads();
    float g[16], bc[16], kk[16], bmid, blast; bf16 vraw[16];
    hg_gate_loads(h, logf, row0, k, seg, g);
#pragma unroll
    for (int j = 0; j < 16; ++j) vraw[j] = hv[(row0 + seg * 16 + j) * 512 + h * 128 + k];
    hg_gate_scan(F, k, seg, g, bc, kk, bmid, blast);
    float tmp[16];
#pragma unroll
    for (int j = 0; j < 16; ++j) tmp[j] = kk[j] * __expf(blast - bc[j]);
    *(LAS mx::bf16x8*)(klT + k * 144 + seg * 32) = mx::pack8f(tmp); *(LAS mx::bf16x8*)(klT + k * 144 + seg * 32 + 16) = mx::pack8f(tmp + 8);
#pragma unroll
    for (int j = 0; j < 16; ++j) *(LAS bf16*)(vT + k * 144 + (seg * 16 + j) * 2) = vraw[j];
    if (seg == 0) blastg[(size_t)chunk * 128 + k] = blast;
    __syncthreads();
    const int lane = F.lane, w = F.wave, c32 = lane & 31, hi = lane >> 5, vb = w & 3, kb2 = w >> 2;
    mx::f32x16 a0 = {}, a1 = {};
#pragma unroll
    for (int ks = 0; ks < 4; ++ks) {
        const mx::bf16x8 av = *(const LAS mx::bf16x8*)(vT + (vb * 32 + c32) * 144 + ks * 32 + hi * 16);
        const mx::bf16x8 b0 = *(const LAS mx::bf16x8*)(klT + (kb2 * 64 + c32) * 144 + ks * 32 + hi * 16);
        const mx::bf16x8 b1 = *(const LAS mx::bf16x8*)(klT + (kb2 * 64 + 32 + c32) * 144 + ks * 32 + hi * 16);
        a0 = MX_MFMA(b0, av, a0); a1 = MX_MFMA(b1, av, a1);
    }
    bf16* dst = dST + (size_t)chunk * 16384 + (size_t)(vb * 32 + c32) * 128 + kb2 * 64 + 8 * hi;
#pragma unroll
    for (int q = 0; q < 4; q += 2) {
        { const unsigned ax = mx::cvtpk(a0[4 * q], a0[4 * q + 1]), ay = mx::cvtpk(a0[4 * q + 2], a0[4 * q + 3]), bx = mx::cvtpk(a0[4 * q + 4], a0[4 * q + 5]), by = mx::cvtpk(a0[4 * q + 6], a0[4 * q + 7]);
          auto rx = __builtin_amdgcn_permlane32_swap(ax, bx, false, false); auto ry = __builtin_amdgcn_permlane32_swap(ay, by, false, false);
          *(v4u*)(dst + 8 * q) = (v4u){rx[0], ry[0], rx[1], ry[1]}; }
        { const unsigned ax = mx::cvtpk(a1[4 * q], a1[4 * q + 1]), ay = mx::cvtpk(a1[4 * q + 2], a1[4 * q + 3]), bx = mx::cvtpk(a1[4 * q + 4], a1[4 * q + 5]), by = mx::cvtpk(a1[4 * q + 6], a1[4 * q + 7]);
          auto rx = __builtin_amdgcn_permlane32_swap(ax, bx, false, false); auto ry = __builtin_amdgcn_permlane32_swap(ay, by, false, false);
          *(v4u*)(dst + 32 + 8 * q) = (v4u){rx[0], ry[0], rx[1], ry[1]}; }
    }
}
__device__ __forceinline__ void hg_step2(Frame& F, const bf16* dST, const float* blastg, bf16* SpT) {
    typedef float f32x2 __attribute__((ext_vector_type(2)));
    const int gt = F.bid * NTHR + F.tid, NGT = F.G * NTHR;
    for (int i = gt; i < 16 * 8192; i += NGT) {
        const int k2 = (i & 63) * 2, bh = i >> 13, vk = (i & 8191) * 2;
        f32x2 S = (f32x2){0.f, 0.f};
        unsigned dA[16], dB[16]; f32x2 blA[16], blB[16];
#define H2_LOAD(d, bl, n0) do { _Pragma("unroll") for (int j = 0; j < 16; ++j) { const size_t ch = (size_t)bh * 64 + (n0) + j; d[j] = *(const unsigned*)(dST + ch * 16384 + vk); bl[j] = *(const f32x2*)(blastg + ch * 128 + k2); } } while (0)
#define H2_PROC(d, bl, n0) do { _Pragma("unroll") for (int j = 0; j < 16; ++j) { const size_t ch = (size_t)bh * 64 + (n0) + j; \
            *(unsigned*)(SpT + ch * 16384 + vk) = pk2(S.x, S.y); \
            S.x = __expf(bl[j].x) * S.x + bf2f((unsigned short)d[j]); S.y = __expf(bl[j].y) * S.y + bf2f((unsigned short)(d[j] >> 16)); } } while (0)
        H2_LOAD(dA, blA, 0); H2_LOAD(dB, blB, 16);
        H2_PROC(dA, blA, 0); H2_LOAD(dA, blA, 32);
        H2_PROC(dB, blB, 16); H2_LOAD(dB, blB, 48);
        H2_PROC(dA, blA, 32); H2_PROC(dB, blB, 48);
#undef H2_LOAD
#undef H2_PROC
    }
}
__device__ __forceinline__ void hg_step3_item(Frame& F, int l, int chunk, const float* logf, const bf16* hq, const bf16* hv, const bf16* hgt, const bf16* SpT, bf16* cat) {
    const int bh = chunk >> 6, n = chunk & 63, b = bh >> 2, h = bh & 3;
    const size_t row0 = (size_t)b * SEQ + n * 64;
    const int k = F.tid & 127, seg = F.tid >> 7;
    LAS unsigned char* qm = F.lds;
    LAS unsigned char* km = qm + 64 * 272;
    LAS unsigned char* vT = km + 64 * 272;
    LAS unsigned char* sp = vT + 128 * 144;
    LAS float* ot = (LAS float*)(sp + 128 * 272);
    LAS float* tot = (LAS float*)(F.lds + 120 * 1024);
    __syncthreads();
    float g[16], bc[16], kk[16], bmid, blast; bf16 qraw[16], vraw[16]; v4u spraw[4];
    hg_gate_loads(h, logf, row0, k, seg, g);
#pragma unroll
    for (int j = 0; j < 16; ++j) { qraw[j] = hq[(row0 + seg * 16 + j) * 512 + h * 128 + k]; vraw[j] = hv[(row0 + seg * 16 + j) * 512 + h * 128 + k]; }
    { const bf16* src = SpT + (size_t)chunk * 16384 + (F.tid >> 2) * 128 + (F.tid & 3) * 32;
#pragma unroll
      for (int q4 = 0; q4 < 4; ++q4) spraw[q4] = *(const v4u*)(src + q4 * 8); }
    hg_gate_scan(F, k, seg, g, bc, kk, bmid, blast);
#pragma unroll
    for (int j = 0; j < 16; ++j) { const int t = seg * 16 + j; const float qv = bf2f(qraw[j]);
        *(LAS bf16*)(qm + t * 272 + k * 2) = (bf16)f2bf(qv * __expf(bc[j] - bmid));
        *(LAS bf16*)(km + t * 272 + k * 2) = (bf16)f2bf(kk[j] * __expf(bmid - bc[j])); }
#pragma unroll
    for (int j = 0; j < 16; ++j) *(LAS bf16*)(vT + k * 144 + (seg * 16 + j) * 2) = vraw[j];
    {
      const int v = F.tid >> 2, k0 = (F.tid & 3) * 32;
#pragma unroll
      for (int q4 = 0; q4 < 4; ++q4) { const v4u raw = spraw[q4]; const unsigned rw[4] = {raw.x, raw.y, raw.z, raw.w}; float tmp[8];
#pragma unroll
          for (int e = 0; e < 8; ++e) tmp[e] = bf2f((unsigned short)(rw[e >> 1] >> ((e & 1) * 16))) * __expf(tot[512 + k0 + q4 * 8 + e]);
          *(LAS mx::bf16x8*)(sp + v * 272 + (k0 + q4 * 8) * 2) = mx::pack8f(tmp); } }
    __syncthreads();
    const int lane = F.lane, w = F.wave, c32 = lane & 31, hi = lane >> 5, tb = w & 1, vb = w >> 1;
    mx::f32x16 o = {};
#pragma unroll
    for (int ks = 0; ks < 8; ++ks) {
        const mx::bf16x8 a = *(const LAS mx::bf16x8*)(qm + (tb * 32 + c32) * 272 + ks * 32 + hi * 16);
        const mx::bf16x8 bb = *(const LAS mx::bf16x8*)(sp + (vb * 32 + c32) * 272 + ks * 32 + hi * 16);
        o = MX_MFMA(a, bb, o);
    }
    for (int sb = 0; sb <= tb; ++sb) {
        mx::f32x16 p = {};
#pragma unroll
        for (int ks = 0; ks < 8; ++ks) {
            const mx::bf16x8 a = *(const LAS mx::bf16x8*)(km + (sb * 32 + c32) * 272 + ks * 32 + hi * 16);
            const mx::bf16x8 bb = *(const LAS mx::bf16x8*)(qm + (tb * 32 + c32) * 272 + ks * 32 + hi * 16);
            p = MX_MFMA(a, bb, p);
        }
        if (sb == tb) {
#pragma unroll
            for (int r = 0; r < 16; ++r) if (mx::crow(r, hi) > c32) p[r] = 0.f; }
        mx::bf16x8 plo, phi; mx::acc_to_A(p, plo, phi);
        const mx::bf16x8 v0 = *(const LAS mx::bf16x8*)(vT + (vb * 32 + c32) * 144 + sb * 64 + hi * 16);
        const mx::bf16x8 v1 = *(const LAS mx::bf16x8*)(vT + (vb * 32 + c32) * 144 + sb * 64 + 32 + hi * 16);
        o = MX_MFMA(plo, v0, o); o = MX_MFMA(phi, v1, o);
    }
#pragma unroll
    for (int r = 0; r < 16; ++r) ot[(tb * 32 + mx::crow(r, hi)) * 132 + vb * 32 + c32] = o[r];
    __syncthreads();
    { const int t = F.tid >> 3, cg = F.tid & 7; float vals[16]; float ss = 0.f;
#pragma unroll
      for (int e = 0; e < 16; ++e) { vals[e] = ot[t * 132 + cg * 16 + e]; ss += vals[e] * vals[e]; }
      ss += __shfl_xor(ss, 1); ss += __shfl_xor(ss, 2); ss += __shfl_xor(ss, 4);
      const float r = 1.f / sqrtf(ss * (1.f / 128.f) + EPS);
      const bf16* gp = hgt + (row0 + t) * 512 + h * 128 + cg * 16; const float* gn = INF(I_HGN) + l * 128 + cg * 16;
      const v4u gw0 = *(const v4u*)gp, gw1 = *(const v4u*)(gp + 8); const unsigned gw[8] = {gw0.x, gw0.y, gw0.z, gw0.w, gw1.x, gw1.y, gw1.z, gw1.w};
#pragma unroll
      for (int e = 0; e < 16; ++e) vals[e] = vals[e] * r * gn[e] * bf2f((unsigned short)(gw[e >> 1] >> ((e & 1) * 16)));
      bf16* op = cat + (row0 + t) * DM + 1536 + h * 128 + cg * 16;
      *(mx::bf16x8*)op = mx::pack8f(vals); *(mx::bf16x8*)(op + 8) = mx::pack8f(vals + 8); }
}

__device__ __forceinline__ void phase_pre0(Frame& F) {
    LAS float* scr = (LAS float*)(F.lds + F.wave * 16640);
    const int gw = F.bid * NWAVES + F.wave, NGW = F.G * NWAVES;
    constexpr int IT_IN = 32 * (DINP / 64), IT_UQ = 8 * 24, IT_UKV = 4 * 32, IT_GLU = 8 * 8, IT_OUT = 32 * 32, IT_UP = 32 * (DFF2 / 64), IT_DN = (DFF / 64) * 32;
    constexpr int IT_L = IT_IN + IT_UQ + IT_UKV + IT_GLU + IT_OUT + IT_UP + IT_DN;
    for (int it = gw; it < NL * IT_L; it += NGW) {
        const int l = it / IT_L; int r = it % IT_L; const int ln = F.lane;
        if (r < IT_IN) { const int nb = r % (DINP / 64), kb = r / (DINP / 64); tr_item(INF(I_WIN) + (size_t)l * DM * DIN, DIN, DM, kb * 64, win_srccol(nb * 64 + ln), nullptr, wt(F, l, WL_IN) + (size_t)nb * 64 * DM, scr, ln); continue; } r -= IT_IN;
        if (r < IT_UQ) { const int nb = r % 24, kb = r / 24; tr_item(INF(I_WUQ) + (size_t)l * 512 * 1536, 1536, 512, kb * 64, uq_srccol(nb * 64 + ln), INF(I_QN) + l * 512, wt(F, l, WL_UQ) + (size_t)nb * 64 * 512, scr, ln); continue; } r -= IT_UQ;
        if (r < IT_UKV) { const int nb = r % 32, kb = r / 32; tr_item(INF(I_WUKV) + (size_t)l * 256 * 2048, 2048, 256, kb * 64, nb * 64 + ln, INF(I_KVN) + l * 256, wt(F, l, WL_UKV) + (size_t)nb * 64 * 256, scr, ln); continue; } r -= IT_UKV;
        if (r < IT_GLU) { const int nb = r % 8, kb = r / 8; tr_item(INF(I_WGLU) + (size_t)l * 512 * 512, 512, 512, kb * 64, nb * 64 + ln, nullptr, wt(F, l, WL_GLU) + (size_t)nb * 64 * 512, scr, ln); continue; } r -= IT_GLU;
        if (r < IT_OUT) { const int nb = r % 32, kb = r / 32; tr_item(INF(I_WOUT) + (size_t)l * DM * DM, DM, DM, kb * 64, nb * 64 + ln, nullptr, wt(F, l, WL_OUT) + (size_t)nb * 64 * DM, scr, ln); continue; } r -= IT_OUT;
        if (r < IT_UP) { const int nb = r % (DFF2 / 64), kb = r / (DFF2 / 64);
            tr_item(INF(I_WUP) + (size_t)l * DM * DFF2, DFF2, DM, kb * 64, ((nb & 3) < 2 ? (nb >> 2) * 128 + (nb & 3) * 64 : DFF + (nb >> 2) * 128 + ((nb & 3) - 2) * 64) + ln, nullptr, wt(F, l, WL_UP) + (size_t)nb * 64 * DM, scr, ln); continue; } r -= IT_UP;
        { const int nb = r % 32, kb = r / 32; tr_item(INF(I_WDN) + (size_t)l * DFF * DM, DM, DFF, kb * 64, nb * 64 + ln, nullptr, wt(F, l, WL_DN) + (size_t)nb * 64 * DFF, scr, ln); }
    }
    const float* c = INF(I_C);
    for (int it = gw; it < NL * 16 * 48; it += NGW) {
        const int jc = it % 48, kc = (it / 48) % 16, l = it / (48 * 16);
        const int j = jc * 256 + F.lane * 4;
        const float* w = INF(I_WADA) + ((size_t)l * DM + kc * 128) * 12288 + j;
#pragma unroll
        for (int q = 0; q < 8; ++q) { const int idx = q * 64 + F.lane, b = idx >> 7, k = idx & 127; const float cv = c[b * DM + kc * 128 + k]; scr[idx] = cv / (1.f + __expf(-cv)); }
        LDS_WAIT(); asm volatile("" ::: "memory");
        f32x4 acc[NB];
#pragma unroll
        for (int b = 0; b < NB; ++b) acc[b] = (f32x4){0.f, 0.f, 0.f, 0.f};
#pragma unroll 16
        for (int k = 0; k < 128; ++k) {
            const f32x4 wv = *(const f32x4*)(w + (size_t)k * 12288);
#pragma unroll
            for (int b = 0; b < NB; ++b) acc[b] += wv * scr[b * 128 + k];
        }
        float* mp = (float*)(F.ws + WS_MODP);
#pragma unroll
        for (int b = 0; b < NB; ++b) *(f32x4*)(mp + (((size_t)l * 16 + kc) * NB + b) * 12288 + j) = acc[b];
        LDS_WAIT(); asm volatile("" ::: "memory");
    }
    const int gt = F.bid * NTHR + F.tid, NGT = F.G * NTHR;
    const int* pos = (const int*)ldp(F, I_POS);
    for (int i = gt; i < M * 32; i += NGT) {
        const int tok = i >> 5, fi = i & 31;
        const float inv = exp2f(-(float)fi * 0.41524101186092033f);
        const float ang = (float)pos[tok] * inv; float sn, cs; sincosf(ang, &sn, &cs);
        ((float*)(F.ws + WS_COS))[i] = cs; ((float*)(F.ws + WS_SIN))[i] = sn;
    }
    s5_tables_a(F);
    for (int j = gt; j < 512; j += NGT) {
        float lg[NL], mx = -1e30f;
#pragma unroll
        for (int l = 0; l < NL; ++l) { lg[l] = INF(I_LB)[l * 512 + j]; mx = fmaxf(mx, lg[l]); }
        float s = 0.f;
#pragma unroll
        for (int l = 0; l < NL; ++l) { lg[l] = expf(lg[l] - mx); s += lg[l]; }
        float cum = 0.f;
#pragma unroll
        for (int l = 0; l < NL; ++l) { if (l > 0) cum += lg[l] / s; ((float*)(F.ws + WS_LB))[l * 512 + j] = cum; }
    }
}
__device__ __forceinline__ void phase_pre1(Frame& F) {
    const int gt = F.bid * NTHR + F.tid, NGT = F.G * NTHR;
    const float* mp = (const float*)(F.ws + WS_MODP); float* mod = (float*)(F.ws + WS_MOD);
    for (int i = gt; i < NL * NB * 12288; i += NGT) {
        const int j = i % 12288, b = (i / 12288) % NB, l = i / (12288 * NB);
        float s = INF(I_BADA)[l * 12288 + j];
        for (int kc = 0; kc < 16; ++kc) s += mp[(((size_t)l * 16 + kc) * NB + b) * 12288 + j];
        mod[i] = s;
    }
}
__device__ __forceinline__ float bflo(unsigned u) { return __builtin_bit_cast(float, u << 16); }
__device__ __forceinline__ float bfhi(unsigned u) { return __builtin_bit_cast(float, u & 0xffff0000u); }
__device__ __forceinline__ void phase_resnorm(Frame& F, const float* xin32, const bf16* xin16, const bf16* y, const float* gpost, const float* gate  ,
                                              bf16* xout16, float* xout32, const float* gpre, const float* sc, const float* sh, bf16* hout) {
    const int gw = F.bid * NWAVES + F.wave, NGW = F.G * NWAVES, RW = (M + NGW - 1) / NGW;
    int curb = -1; f32x4 pa[8], pg[8], ps[8];
    const int rend = (gw * RW + RW) < M ? (gw * RW + RW) : M;
    for (int row = gw * RW; row < rend; ++row) {
        const int b = row / SEQ;
        if (b != curb) { curb = b;
#pragma unroll
            for (int j = 0; j < 8; ++j) { const int ci = 128 * (j >> 1) + 2 * F.lane + (j & 1);
                if (y) pa[j] = ((const f32x4*)gpost)[ci] * ((const f32x4*)(gate + (size_t)b * 12288))[ci];
                if (hout) { pg[j] = ((const f32x4*)gpre)[ci] * (((const f32x4*)(sc + (size_t)b * 12288))[ci] + 1.f); ps[j] = ((const f32x4*)(sh + (size_t)b * 12288))[ci]; } } }
        f32x4 v[8];
        if (xin32) { const f32x4* xr = (const f32x4*)(xin32 + (size_t)row * DM) + 2 * F.lane;
#pragma unroll
            for (int j = 0; j < 4; ++j) { v[2 * j] = xr[128 * j]; v[2 * j + 1] = xr[128 * j + 1]; }
        } else { const v4u* xr = (const v4u*)(xin16 + (size_t)row * DM) + F.lane;
#pragma unroll
            for (int j = 0; j < 4; ++j) { const v4u w = xr[64 * j]; v[2 * j] = (f32x4){bflo(w.x), bfhi(w.x), bflo(w.y), bfhi(w.y)}; v[2 * j + 1] = (f32x4){bflo(w.z), bfhi(w.z), bflo(w.w), bfhi(w.w)}; }
        }
        if (y) {
            f32x4 yv[8]; float ss = 0.f;
            const v4u* yr = (const v4u*)(y + (size_t)row * DM) + F.lane;
#pragma unroll
            for (int j = 0; j < 4; ++j) { const v4u w = yr[64 * j]; yv[2 * j] = (f32x4){bflo(w.x), bfhi(w.x), bflo(w.y), bfhi(w.y)}; yv[2 * j + 1] = (f32x4){bflo(w.z), bfhi(w.z), bflo(w.w), bfhi(w.w)}; }
#pragma unroll
            for (int j = 0; j < 8; ++j) ss += (yv[j].x * yv[j].x + yv[j].y * yv[j].y) + (yv[j].z * yv[j].z + yv[j].w * yv[j].w);
            const float r = 1.f / sqrtf(wave_sum(ss) * (1.f / DM) + EPS);
#pragma unroll
            for (int j = 0; j < 8; ++j) v[j] += pa[j] * (yv[j] * r);
            if (xout16) { v4u* xo = (v4u*)(xout16 + (size_t)row * DM) + F.lane;
#pragma unroll
                for (int j = 0; j < 4; ++j) xo[64 * j] = (v4u){pk2(v[2 * j].x, v[2 * j].y), pk2(v[2 * j].z, v[2 * j].w), pk2(v[2 * j + 1].x, v[2 * j + 1].y), pk2(v[2 * j + 1].z, v[2 * j + 1].w)};
            } else { f32x4* xo = (f32x4*)(xout32 + (size_t)row * DM) + 2 * F.lane;
#pragma unroll
                for (int j = 0; j < 4; ++j) { xo[128 * j] = v[2 * j]; xo[128 * j + 1] = v[2 * j + 1]; }
            }
        }
        if (hout) {
            float ss = 0.f;
#pragma unroll
            for (int j = 0; j < 8; ++j) ss += (v[j].x * v[j].x + v[j].y * v[j].y) + (v[j].z * v[j].z + v[j].w * v[j].w);
            const float r = 1.f / sqrtf(wave_sum(ss) * (1.f / DM) + EPS);
            v4u* ho = (v4u*)(hout + (size_t)row * DM) + F.lane;
#pragma unroll
            for (int j = 0; j < 4; ++j) { const f32x4 h0 = v[2 * j] * r * pg[2 * j] + ps[2 * j], h1 = v[2 * j + 1] * r * pg[2 * j + 1] + ps[2 * j + 1];
                ho[64 * j] = (v4u){pk2(h0.x, h0.y), pk2(h0.z, h0.w), pk2(h1.x, h1.y), pk2(h1.z, h1.w)}; }
        }
    }
}

__device__ __forceinline__ void phase_mix1(Frame& F, int l) {
    for (int it = F.bid; it < 256; it += F.G) s5_step1_item(F, l, it >> 3, it & 7, (const bf16*)(F.ws + WS_U16), (float*)(F.ws + WS_DS5));
    for (int it = F.bid; it < 1024; it += F.G) hg_step1_item(F, it, (const float*)(F.ws + WS_LOGF), (const bf16*)(F.ws + WS_HV), (bf16*)(F.ws + WS_DST), (float*)(F.ws + WS_BLAST));
}
__device__ __forceinline__ void phase_s5out(Frame& F, int l) {
    for (int it = F.bid; it < 256; it += F.G) s5_step3_item(F, l, it >> 3, it & 7, (const bf16*)(F.ws + WS_U16), (const float*)(F.ws + WS_DS5), (bf16*)(F.ws + WS_YG16));
}
__device__ __forceinline__ void phase_hgout(Frame& F, int l) {
    for (int it = F.bid; it < 1024; it += F.G) hg_step3_item(F, l, it, (const float*)(F.ws + WS_LOGF), (const bf16*)(F.ws + WS_HQ), (const bf16*)(F.ws + WS_HV), (const bf16*)(F.ws + WS_HGT), (const bf16*)(F.ws + WS_SPT), (bf16*)(F.ws + WS_CAT));
}
__device__ __forceinline__ void phase_attn(Frame& F) {
    const bf16* qo = (const bf16*)(F.ws + WS_ACT); const bf16* ko = (const bf16*)(F.ws + WS_ACT + 48 * MiB); const bf16* vo = (const bf16*)(F.ws + WS_ACT + 96 * MiB);
    bf16* cat = (bf16*)(F.ws + WS_CAT);
    const int vcu = (F.G % 8 == 0) ? (F.bid % 8) * (F.G / 8) + F.bid / 8 : F.bid;
    for (int it = vcu; it < NB * NH * 8; it += F.G) {
        const int bh = it >> 3, x = it & 7, b = bh / NH, h = bh % NH;
        for (int pass = 0; pass < 2; ++pass)
            att::attn_block(qo + (size_t)bh * SEQ * DQK, ko + (size_t)bh * SEQ * DQK, vo + (size_t)bh * SEQ * 128, cat + (size_t)b * SEQ * DM + 512 + h * 128, DM, pass ? x : 15 - x, F.lds);
    }
}
__device__ __forceinline__ void fixup_panel(Frame& F, int l, int pm) {
    const float* halo = (const float*)(F.ws + WS_HALO); bf16* act = (bf16*)(F.ws + WS_ACT);
    const float* cw = INF(I_CW) + (size_t)l * 3 * DFF2; const float* cb = INF(I_CB) + (size_t)l * DFF2;
    for (int i = F.tid; i < 4 * (DFF / 4); i += NTHR) {
        const int c = (i % (DFF / 4)) * 4, r = (i / (DFF / 4)) & 1, blk = pm * 2 + i / (2 * (DFF / 4));
        const int pos = blk * 128 + r, s = pos & (SEQ - 1);
        const float* t0 = halo + (size_t)(blk * 4 + r) * DFF2;
        const float* t1 = r ? halo + (size_t)(blk * 4) * DFF2 : halo + (size_t)((blk - 1) * 4 + 3) * DFF2;
        const float* t2 = r ? halo + (size_t)((blk - 1) * 4 + 3) * DFF2 : halo + (size_t)((blk - 1) * 4 + 2) * DFF2;
        const f32x4 z4 = (f32x4){0.f, 0.f, 0.f, 0.f};
        const f32x4 g0 = *(const f32x4*)(t0 + c), v0 = *(const f32x4*)(t0 + DFF + c);
        const f32x4 g1 = (s >= 1) ? *(const f32x4*)(t1 + c) : z4, v1 = (s >= 1) ? *(const f32x4*)(t1 + DFF + c) : z4;
        const f32x4 g2 = (s >= 2) ? *(const f32x4*)(t2 + c) : z4, v2 = (s >= 2) ? *(const f32x4*)(t2 + DFF + c) : z4;
        const f32x4 cg = *(const f32x4*)(cb + c) + *(const f32x4*)(cw + c) * g2 + *(const f32x4*)(cw + DFF2 + c) * g1 + *(const f32x4*)(cw + 2 * DFF2 + c) * g0;
        const f32x4 cv = *(const f32x4*)(cb + DFF + c) + *(const f32x4*)(cw + DFF + c) * v2 + *(const f32x4*)(cw + DFF2 + DFF + c) * v1 + *(const f32x4*)(cw + 2 * DFF2 + DFF + c) * v0;
        *(v2u*)(act + (size_t)pos * DFF + c) = (v2u){pk2(gelu_tanh(cg.x) * cv.x, gelu_tanh(cg.y) * cv.y), pk2(gelu_tanh(cg.z) * cv.z, gelu_tanh(cg.w) * cv.w)};
    }
}

constexpr int PH_PER_LAYER = 10, PH_LAYER0 = 2, PH_FINAL = PH_LAYER0 + NL * PH_PER_LAYER, N_PHASES = PH_FINAL + 1;
__global__ void __launch_bounds__(NTHR, 2) skel_fwd(Args args) {
    extern __shared__ __attribute__((aligned(16))) unsigned char lds[];
    Frame F;
    F.lds = (LAS unsigned char*)lds; F.ldsg = lds;
    F.tid = threadIdx.x; F.lane = F.tid & 63; F.wave = __builtin_amdgcn_readfirstlane(F.tid >> 6);
    F.G = gridDim.x; F.bid = blockIdx.x; F.ws = args.ws; F.in = nullptr;
    const int lo = args.ph_lo, hi = args.ph_hi;
    for (int u = F.tid; u < (LDS_BYTES - CTRL_OFF) / 4; u += NTHR) ((LAS unsigned*)(F.lds + CTRL_OFF))[u] = 0u;
    if (F.tid == 0) { LAS unsigned long long* pt = (LAS unsigned long long*)(F.lds + PTAB_OFF);
#pragma unroll
        for (int i = 0; i < N_IN; ++i) pt[i] = (unsigned long long)args.in[i];
        pt[N_IN] = (unsigned long long)args.ws; }
    __syncthreads();
    XcdBarrier bar; bar.bar = (unsigned*)(F.ws + WS_CTL) + CW_BAR; bar.x = 0; bar.st = nullptr;
    if (hi - lo > 1) bar = xcd_barrier_post((unsigned*)(F.ws + WS_CTL) + CW_BAR, (volatile LAS unsigned*)(F.lds + MISC_OFF) + 8);
#define SEAM(k) do { if (IN(k) && IN((k) + 1)) xcd_barrier(bar); } while (0)
#define IN(k) (lo <= (k) && (k) < hi)
#define REFRESH() do { int t_ = threadIdx.x; asm volatile("" : "+v"(t_)); F.tid = t_; F.lane = t_ & 63; F.wave = __builtin_amdgcn_readfirstlane(t_ >> 6); \
    F.ws = (unsigned char*)ldp(F, N_IN); } while (0)
    if (IN(0)) phase_pre0(F);
    SEAM(0);
    if (IN(1)) { phase_pre1(F); if (F.G != 256) for (int l = 0; l < NL; ++l) s5_tables_b(F, l, F.bid * NTHR + F.tid, F.G * NTHR); }
    SEAM(1);
#define mod ((const float*)(F.ws + WS_MOD))
#define X ((bf16*)(F.ws + WS_X))
#define H ((bf16*)(F.ws + WS_H))
#define T2f ((const bf16*)(F.ws + WS_T2))
#define modl (mod + (size_t)l * NB * 12288)
    for (int l = 0; l < NL; ++l) {
        const int base = PH_LAYER0 + l * PH_PER_LAYER;
        if (IN(base + 0)) { REFRESH();
            if (l == 0) phase_resnorm(F, INF(I_X), nullptr, nullptr, nullptr, nullptr, nullptr, nullptr, INF(I_MPRE), modl + 2048, modl + 0, H);
            else phase_resnorm(F, nullptr, X, T2f, INF(I_FPOST) + (l - 1) * DM, mod + (size_t)(l - 1) * NB * 12288 + 10240, X, nullptr, INF(I_MPRE) + l * DM, modl + 2048, modl + 0, H);
        }
        SEAM(base + 0);
        if (IN(base + 1)) { REFRESH();
            pg8::Gemm g{H, wt(F, l, WL_IN), M, DINP, DM}; pg8::StaticOrder S; S.init(M, DINP, F.G, F.bid);
            pg8::EpiProj E{(bf16*)(F.ws + WS_U16), (bf16*)(F.ws + WS_CQ), (bf16*)(F.ws + WS_CKV), (bf16*)(F.ws + WS_HQ), (bf16*)(F.ws + WS_HV), (bf16*)(F.ws + WS_HGT), (bf16*)(F.ws + WS_ACT + 48 * MiB),
                           (float*)(F.ws + WS_LOGF), (float*)(F.ws + WS_SSQQ), (float*)(F.ws + WS_SSQKV), (const float*)(F.ws + WS_LB) + l * 512, (const float*)(F.ws + WS_COS), (const float*)(F.ws + WS_SIN)};
            pg8::gemm_phase<pg8::EpiProj, pg8::StaticOrder, true, true>(F.lds, g, S, E);
            if (F.G == 256 && F.bid >= 128) { REFRESH(); s5_tables_b(F, l, (F.bid - 128) * NTHR + F.tid, 128 * NTHR); }
        }
        SEAM(base + 1);
        if (IN(base + 2)) { REFRESH(); phase_mix1(F, l); }
        SEAM(base + 2);
        if (IN(base + 3)) { REFRESH();
            { pg8::Gemm g{(const bf16*)(F.ws + WS_CKV), wt(F, l, WL_UKV), M, 2048, 256}; pg8::StaticOrder S; S.init(M, 2048, F.G, F.bid);
              pg8::EpiKV E{(bf16*)(F.ws + WS_ACT + 48 * MiB), (bf16*)(F.ws + WS_ACT + 96 * MiB), (const float*)(F.ws + WS_SSQKV)};
              pg8::gemm_phase<pg8::EpiKV, pg8::StaticOrder, true, true>(F.lds, g, S, E); }
            REFRESH();
            hg_step2(F, (const bf16*)(F.ws + WS_DST), (const float*)(F.ws + WS_BLAST), (bf16*)(F.ws + WS_SPT));
            REFRESH();
            phase_s5out(F, l);
        }
        SEAM(base + 3);
        if (IN(base + 4)) { REFRESH();
            { pg8::Gemm g{(const bf16*)(F.ws + WS_CQ), wt(F, l, WL_UQ), M, 2048, 512, (const bf16*)(F.ws + WS_YG16), 6}; pg8::StaticOrder S; S.init(M, 2048, F.G, F.bid);
              pg8::EpiQGlu E{pg8::EpiQ{(bf16*)(F.ws + WS_ACT), (const float*)(F.ws + WS_SSQQ), (const float*)(F.ws + WS_COS), (const float*)(F.ws + WS_SIN)},
                             pg8::EpiGlu{(const bf16*)(F.ws + WS_YG16), 512, (bf16*)(F.ws + WS_CAT), DM}};
              pg8::gemm_phase<pg8::EpiQGlu, pg8::StaticOrder, true, true>(F.lds, g, S, E); }
            REFRESH();
            phase_hgout(F, l); }
        SEAM(base + 4);
        if (IN(base + 5)) { REFRESH(); phase_attn(F); }
        SEAM(base + 5);
        if (IN(base + 6)) { REFRESH();
            pg8::Gemm g{(const bf16*)(F.ws + WS_CAT), wt(F, l, WL_OUT), M, DM, DM}; pg8::StaticOrder S; S.init(M, DM, F.G, F.bid);
            pg8::EpiBf16<0> E{(bf16*)(F.ws + WS_T2), DM, nullptr, 0, 0, 1.f};
            pg8::gemm_phase<pg8::EpiBf16<0>, pg8::StaticOrder, true, true>(F.lds, g, S, E);
        }
        SEAM(base + 6);
        if (IN(base + 7)) { REFRESH(); phase_resnorm(F, l == 0 ? INF(I_X) : (const float*)nullptr, X, T2f, INF(I_MPOST) + l * DM, modl + 4096, X, nullptr, INF(I_FPRE) + l * DM, modl + 8192, modl + 6144, H); }
        SEAM(base + 7);
        if (IN(base + 8)) { REFRESH();
            pg8::Gemm g{H, wt(F, l, WL_UP), M, DFF2, DM}; pg8::StaticOrder S; S.init(M, DFF2, F.G, F.bid);
            pg8::EpiUp E{(bf16*)(F.ws + WS_ACT), (float*)(F.ws + WS_HALO), INF(I_CW) + (size_t)l * 3 * DFF2, INF(I_CB) + (size_t)l * DFF2};
            pg8::gemm_phase<pg8::EpiUp, pg8::StaticOrder, true, true>(F.lds, g, S, E);
        }
        SEAM(base + 8);
        if (IN(base + 9)) { REFRESH();
            { pg8::StaticOrder S0; S0.init(M, DM, F.G, F.bid); pg8::Unit u0; int last = -1;
              for (int i = 0; S0.next(i, u0); ++i) if (u0.pm != last) { fixup_panel(F, l, u0.pm); last = u0.pm; } }
            asm volatile("s_waitcnt vmcnt(0)" ::: "memory"); __syncthreads();
            REFRESH();
            pg8::Gemm g{(const bf16*)(F.ws + WS_ACT), wt(F, l, WL_DN), M, DM, DFF}; pg8::StaticOrder S; S.init(M, DM, F.G, F.bid);
            pg8::EpiBf16<0> E{(bf16*)(F.ws + WS_T2), DM, nullptr, 0, 0, 1.f};
            pg8::gemm_phase<pg8::EpiBf16<0>, pg8::StaticOrder, true, true>(F.lds, g, S, E);
        }
        SEAM(base + 9);
    }
    if (IN(PH_FINAL)) { REFRESH(); phase_resnorm(F, nullptr, X, T2f, INF(I_FPOST) + (NL - 1) * DM, mod + (size_t)(NL - 1) * NB * 12288 + 10240, nullptr, args.out, nullptr, nullptr, nullptr, nullptr); }
#undef mod
#undef X
#undef H
#undef T2f
#undef modl
#undef IN
}

extern "C" void kernel_launch(void* const* d_in, const int* in_sizes, int n_in, void* d_out, int out_size, void* d_ws, size_t ws_size, hipStream_t stream) {
    static int grid = 0;
    if (grid == 0) {
        if (n_in != N_IN || in_sizes[0] != M * DM || out_size != M * DM || ws_size < WS_END) { fprintf(stderr, "kernel_launch: shape/workspace mismatch (n_in %d, in0 %d, out %d, ws %zu < %zu)\n", n_in, n_in > 0 ? in_sizes[0] : -1, out_size, ws_size, (size_t)WS_END); grid = -1; return; }
        int dev = 0, cus = 0;
        if (hipGetDevice(&dev) != hipSuccess || hipDeviceGetAttribute(&cus, hipDeviceAttributeMultiprocessorCount, dev) != hipSuccess) { grid = -1; return; }
        if (hipFuncSetAttribute((const void*)skel_fwd, hipFuncAttributeMaxDynamicSharedMemorySize, LDS_BYTES) != hipSuccess) { fprintf(stderr, "kernel_launch: hipFuncSetAttribute failed\n"); grid = -1; return; }
        (void)hipGetLastError();
        grid = cus;
    }
    if (grid < 0) return;
    Args a{};
    for (int i = 0; i < N_IN; ++i) a.in[i] = d_in[i];
    a.out = (float*)d_out; a.ws = (unsigned char*)d_ws;
    if (hipMemsetAsync((char*)d_ws + WS_CTL, 0, CTL_ZERO_BYTES, stream) != hipSuccess) { fprintf(stderr, "kernel_launch: memset failed\n"); return; }
#if MK_ONE_LAUNCH
    a.ph_lo = 0; a.ph_hi = N_PHASES;
    hipLaunchKernelGGL(skel_fwd, dim3(grid), dim3(NTHR), LDS_BYTES, stream, a);
#else
    for (int p = 0; p < N_PHASES; ++p) {
        a.ph_lo = p; a.ph_hi = p + 1;
        hipLaunchKernelGGL(skel_fwd, dim3(grid), dim3(NTHR), LDS_BYTES, stream, a);
    }
#endif
}
```

```cpp
#include <hip/hip_runtime.h>
#include <cstdio>
#include <cstdint>
namespace pg8 {
#define PG8_LAS __attribute__((address_space(3)))
typedef unsigned short bf16_t;
typedef short bf16x8 __attribute__((ext_vector_type(8)));
typedef float f32x4 __attribute__((ext_vector_type(4)));
typedef unsigned u32x4 __attribute__((ext_vector_type(4)));
constexpr int BM = 256, BK = 64, HALF = 128, HTB = HALF * BK * 2  , STAGE_BYTES = 8 * HTB, NXCD = 8, WGM = 8;

__host__ __device__ __forceinline__ int lds_byte(int r, int c) { const int st = (r >> 4) * 2 + (c >> 5), rr = r & 15, cc = c & 31, ob = rr * 64 + cc * 2; return st * 1024 + (ob ^ (((ob >> 9) & 1) << 5)); }
__host__ __device__ __forceinline__ void stage_rc(int b, int& R, int& C) { const int st = b / 1024, sb = b % 1024, swz = sb ^ (((sb >> 9) & 1) << 5); R = (st >> 1) * 16 + swz / 64; C = (st & 1) * 32 + (swz % 64) / 2; }
__host__ __device__ __forceinline__ int perm32(int rho) { const int n = rho >> 4, i = rho & 15; return 8 * (i >> 2) + 4 * n + (i & 3); }

__device__ __forceinline__ __amdgpu_buffer_rsrc_t wt_rsrc(const void* base, size_t nbytes) { return __builtin_amdgcn_make_buffer_rsrc((void*)base, 0, (int)nbytes, 0x00020000); }
__device__ __forceinline__ void st16_wt(__amdgpu_buffer_rsrc_t r, size_t byte_off, u32x4 v) { __builtin_amdgcn_raw_buffer_store_b128(v, r, (int)byte_off, 0, 16); }
struct Unit { int pm, pn; };
struct Gemm { const bf16_t* A; const bf16_t* Bt; int M, N, K; const bf16_t* A2 = nullptr; int pn_split = 1 << 30; };

struct StaticOrder {
    int nM, nN, nwg, G, c;
    __host__ __device__ void init(int M, int N, int G_, int c_) { nM = M / BM; nN = N / BM; nwg = nM * nN; G = G_; c = c_; }
    __host__ __device__ __forceinline__ bool next(int i, Unit& u) const {
        const long L = (long)i * G + c; if (L >= nwg) return false;
        int wgid = (int)L; { const int q = nwg / NXCD, r = nwg % NXCD, xcd = wgid % NXCD, off = wgid / NXCD; wgid = (xcd < r ? xcd * (q + 1) : r * (q + 1) + (xcd - r) * q) + off; }
        const int nig = WGM * nN, gid = wgid / nig, fm = gid * WGM, gsz = (nM - fm) < WGM ? (nM - fm) : WGM;
        u.pm = fm + ((wgid % nig) % gsz); u.pn = (wgid % nig) / gsz; return true;
    }
    __device__ __forceinline__ void a_ready(const Unit&) const {}
    __device__ __forceinline__ void done(const Unit&) const {}
};

__device__ __forceinline__ unsigned cvt_pk_bf16(float lo, float hi) { typedef float f2_ __attribute__((ext_vector_type(2))); typedef __bf16 b2_ __attribute__((ext_vector_type(2))); const b2_ r = __builtin_convertvector((f2_){lo, hi}, b2_); return __builtin_bit_cast(unsigned, r); }
typedef float f32x2 __attribute__((ext_vector_type(2)));
__device__ __forceinline__ f32x2 gelu_pk(f32x2 v) {
    const f32x2 av = __builtin_elementwise_abs(v), d = av * 0.2316418882f + 1.0f;
    f32x2 t; t.x = __builtin_amdgcn_rcpf(d.x); t.y = __builtin_amdgcn_rcpf(d.y);
    f32x2 q = t * 0.5307027145f + (-0.7265760135f); q = q * t + 0.7107068705f; q = q * t + (-0.142248368f); q = q * t + 0.127414796f; q = q * t;
    const f32x2 s = (v * v) * (-0.72134752044f);
    f32x2 e; e.x = __builtin_amdgcn_exp2f(s.x); e.y = __builtin_amdgcn_exp2f(s.y);
    const f32x2 m = v * (q * e), r = v - m;
    f32x2 o; o.x = v.x < 0.f ? m.x : r.x; o.y = v.y < 0.f ? m.y : r.y; return o;
}

template <int ACT  > struct EpiBf16 {
    static constexpr bool PERM = true, AFTER_DRAIN = false, PERMA = false; static_assert(ACT == 0 || ACT == 1, "EpiBf16: ACT is 0 (none) or 1 (gelu_pk)");
    bf16_t* O; int ldc; const float* bias; int split_cols; size_t split_stride; float scale0;
    __device__ __forceinline__ void operator()(const f32x4 (&acc)[2][2][4][2], const Unit& u, int wr, int wc, int fr, int fq) const {
        const int row0 = u.pm * BM + wr * 64 + fr; int colt = u.pn * BM; bf16_t* base = O;
        float sc = 1.f; if (split_cols) { const int t = colt / split_cols; base += (size_t)t * split_stride; colt -= t * split_cols; if (t == 0) sc = scale0; }
        const int col0 = colt + wc * 32 + 8 * fq, bcol0 = u.pn * BM + wc * 32 + 8 * fq;
        f32x4 bv[2][2];
#pragma unroll
        for (int bj = 0; bj < 2; ++bj)
#pragma unroll
            for (int n = 0; n < 2; ++n) bv[bj][n] = bias ? *(const f32x4*)(bias + bcol0 + bj * HALF + 4 * n) : (f32x4){0.f, 0.f, 0.f, 0.f};
#pragma unroll
        for (int ai = 0; ai < 2; ++ai)
#pragma unroll
            for (int m = 0; m < 4; ++m) { bf16_t* rowp = base + (size_t)(row0 + ai * HALF + m * 16) * ldc + col0;
#pragma unroll
                for (int bj = 0; bj < 2; ++bj) { f32x4 v0 = acc[ai][bj][m][0] + bv[bj][0], v1 = acc[ai][bj][m][1] + bv[bj][1];
                    if (ACT == 1) { f32x2 a = gelu_pk((f32x2){v0[0], v0[1]}), b = gelu_pk((f32x2){v0[2], v0[3]}), c = gelu_pk((f32x2){v1[0], v1[1]}), d = gelu_pk((f32x2){v1[2], v1[3]});
                        v0 = (f32x4){a.x, a.y, b.x, b.y}; v1 = (f32x4){c.x, c.y, d.x, d.y}; }
                    v0 = v0 * sc; v1 = v1 * sc; u32x4 w; w.x = cvt_pk_bf16(v0[0], v0[1]); w.y = cvt_pk_bf16(v0[2], v0[3]); w.z = cvt_pk_bf16(v1[0], v1[1]); w.w = cvt_pk_bf16(v1[2], v1[3]);
                    *(u32x4*)(rowp + bj * HALF) = w; } }
    }
};
struct EpiF32 {
    static constexpr bool PERM = false, AFTER_DRAIN = false, PERMA = false;
    float* C; int ldc; const float* bias;
    __device__ __forceinline__ void operator()(const f32x4 (&acc)[2][2][4][2], const Unit& u, int wr, int wc, int fr, int fq) const {
        const int row0 = u.pm * BM + wr * 64 + fr, col0 = u.pn * BM + wc * 32 + 4 * fq;
        f32x4 bv[2][2];
#pragma unroll
        for (int bj = 0; bj < 2; ++bj)
#pragma unroll
            for (int n = 0; n < 2; ++n) bv[bj][n] = bias ? *(const f32x4*)(bias + col0 + bj * HALF + n * 16) : (f32x4){0.f, 0.f, 0.f, 0.f};
#pragma unroll
        for (int ai = 0; ai < 2; ++ai)
#pragma unroll
            for (int m = 0; m < 4; ++m) { float* rowp = C + (size_t)(row0 + ai * HALF + m * 16) * ldc + col0;
#pragma unroll
                for (int bj = 0; bj < 2; ++bj)
#pragma unroll
                    for (int n = 0; n < 2; ++n) *(f32x4*)(rowp + bj * HALF + n * 16) = acc[ai][bj][m][n] + bv[bj][n]; }
    }
};
struct EpiGlu {
    static constexpr bool PERM = true, AFTER_DRAIN = false, PERMA = false;
    const bf16_t* Y; int ldy; bf16_t* O; int ldo;
    __device__ __forceinline__ void operator()(const f32x4 (&acc)[2][2][4][2], const Unit& u, int wr, int wc, int fr, int fq) const {
        const int row0 = u.pm * BM + wr * 64 + fr, col0 = u.pn * BM + wc * 32 + 8 * fq;
#pragma unroll
        for (int ai = 0; ai < 2; ++ai)
#pragma unroll
            for (int m = 0; m < 4; ++m) { const size_t row = (size_t)(row0 + ai * HALF + m * 16);
#pragma unroll
                for (int bj = 0; bj < 2; ++bj) { const int col = col0 + bj * HALF;
                    const u32x4 yv = *(const u32x4*)(Y + row * ldy + col); const unsigned yw[4] = {yv.x, yv.y, yv.z, yv.w};
                    const f32x4 v0 = acc[ai][bj][m][0], v1 = acc[ai][bj][m][1]; const float vv[8] = {v0[0], v0[1], v0[2], v0[3], v1[0], v1[1], v1[2], v1[3]};
                    float o[8];
#pragma unroll
                    for (int e = 0; e < 8; ++e) { const float y = __builtin_bit_cast(float, (yw[e >> 1] >> ((e & 1) * 16)) << 16); o[e] = y / (1.f + __expf(-vv[e])); }
                    u32x4 w; w.x = cvt_pk_bf16(o[0], o[1]); w.y = cvt_pk_bf16(o[2], o[3]); w.z = cvt_pk_bf16(o[4], o[5]); w.w = cvt_pk_bf16(o[6], o[7]);
                    *(u32x4*)(O + row * ldo + col) = w; } }
    }
};
struct EpiQ {
    static constexpr bool PERM = true, AFTER_DRAIN = false, PERMA = false;
    bf16_t* Q; const float* ssq; const float* cosT; const float* sinT;
    __device__ __forceinline__ void operator()(const f32x4 (&acc)[2][2][4][2], const Unit& u, int wr, int wc, int fr, int fq) const {
        const int row0 = u.pm * BM + wr * 64 + fr;
#pragma unroll
        for (int ai = 0; ai < 2; ++ai)
#pragma unroll
            for (int m = 0; m < 4; ++m) { const int row = row0 + ai * HALF + m * 16, b = row >> 12, s = row & 4095; const f32x4 sa = *(const f32x4*)(ssq + (size_t)row * 8), sb = *(const f32x4*)(ssq + (size_t)row * 8 + 4); const float r = __builtin_amdgcn_rsqf((((sa[0] + sa[1]) + (sa[2] + sa[3])) + ((sb[0] + sb[1]) + (sb[2] + sb[3]))) * (1.f / 512.f) + 1e-6f) * 0.10411754f;
                if (u.pn < 4) {
#pragma unroll
                    for (int bj = 0; bj < 2; ++bj) { const int h = 2 * u.pn + bj; const f32x4 v0 = acc[ai][bj][m][0] * r, v1 = acc[ai][bj][m][1] * r;
                        u32x4 w; w.x = cvt_pk_bf16(v0[0], v0[1]); w.y = cvt_pk_bf16(v0[2], v0[3]); w.z = cvt_pk_bf16(v1[0], v1[1]); w.w = cvt_pk_bf16(v1[2], v1[3]);
                        *(u32x4*)(Q + ((size_t)(b * 8 + h) * 4096 + s) * 192 + wc * 32 + 8 * fq) = w; }
                } else {
                    const int f0 = ((wc & 1) * 4 + fq) * 4; const f32x4 cs = *(const f32x4*)(cosT + (size_t)row * 32 + f0), sn = *(const f32x4*)(sinT + (size_t)row * 32 + f0);
#pragma unroll
                    for (int bj = 0; bj < 2; ++bj) { const int h = (u.pn - 4) * 4 + bj * 2 + (wc >> 1); const f32x4 x1 = acc[ai][bj][m][0] * r, x2 = acc[ai][bj][m][1] * r;
                        const f32x4 o1 = x1 * cs - x2 * sn, o2 = x2 * cs + x1 * sn;
                        bf16_t* qp = Q + ((size_t)(b * 8 + h) * 4096 + s) * 192 + 128 + f0;
                        typedef unsigned u32x2 __attribute__((ext_vector_type(2)));
                        *(u32x2*)qp = (u32x2){cvt_pk_bf16(o1[0], o1[1]), cvt_pk_bf16(o1[2], o1[3])};
                        *(u32x2*)(qp + 32) = (u32x2){cvt_pk_bf16(o2[0], o2[1]), cvt_pk_bf16(o2[2], o2[3])}; }
                } }
    }
};
struct EpiKV {
    static constexpr bool PERM = true, AFTER_DRAIN = false, PERMA = false;
    bf16_t* Kf; bf16_t* V; const float* ssq;
    __device__ __forceinline__ void operator()(const f32x4 (&acc)[2][2][4][2], const Unit& u, int wr, int wc, int fr, int fq) const {
        const int row0 = u.pm * BM + wr * 64 + fr, h = u.pn, d = wc * 32 + 8 * fq;
#pragma unroll
        for (int ai = 0; ai < 2; ++ai)
#pragma unroll
            for (int m = 0; m < 4; ++m) { const int row = row0 + ai * HALF + m * 16, b = row >> 12, s = row & 4095; const f32x4 sa = *(const f32x4*)(ssq + (size_t)row * 4); const float r = __builtin_amdgcn_rsqf(((sa[0] + sa[1]) + (sa[2] + sa[3])) * (1.f / 256.f) + 1e-6f);
#pragma unroll
                for (int bj = 0; bj < 2; ++bj) { const f32x4 v0 = acc[ai][bj][m][0] * r, v1 = acc[ai][bj][m][1] * r;
                    u32x4 w; w.x = cvt_pk_bf16(v0[0], v0[1]); w.y = cvt_pk_bf16(v0[2], v0[3]); w.z = cvt_pk_bf16(v1[0], v1[1]); w.w = cvt_pk_bf16(v1[2], v1[3]);
                    bf16_t* dst = bj ? V + ((size_t)(b * 8 + h) * 4096 + s) * 128 + d : Kf + ((size_t)(b * 8 + h) * 4096 + s) * 192 + d;
                    *(u32x4*)dst = w; } }
    }
};
__device__ __forceinline__ f32x4 dpp_shr1(f32x4 v) { f32x4 o;
#pragma unroll
    for (int i = 0; i < 4; ++i) { const float f_ = v[i]; o[i] = __int_as_float(__builtin_amdgcn_update_dpp(0, __float_as_int(f_), 0x111, 0xf, 0xf, true)); }
    return o; }
__device__ __forceinline__ float gelu_tanh1(float x) { const float t = 0.7978845608028654f * (x + 0.044715f * x * x * x); return x * __builtin_amdgcn_rcpf(1.f + __builtin_amdgcn_exp2f(-2.885390081777927f * t)); }
struct EpiUp {
    static constexpr bool PERM = true, AFTER_DRAIN = false, PERMA = true;
    bf16_t* ACT; float* HALO; const float* cw; const float* cb;
    __device__ __forceinline__ void operator()(const f32x4 (&acc)[2][2][4][2], const Unit& u, int wr, int wc, int fr, int fq) const {
        const int ch0 = u.pn * 128 + wc * 32 + 8 * fq, prow = u.pm * BM + (wr * 16 + fr) * 8, blk = u.pm * 2 + wr;
        unsigned pk[8][2];
#pragma unroll
        for (int n = 0; n < 2; ++n) {
            const int c = ch0 + 4 * n;
            const f32x4 wg0 = *(const f32x4*)(cw + c), wg1 = *(const f32x4*)(cw + 11008 + c), wg2 = *(const f32x4*)(cw + 22016 + c), bg = *(const f32x4*)(cb + c);
            const f32x4 wv0 = *(const f32x4*)(cw + 5504 + c), wv1 = *(const f32x4*)(cw + 11008 + 5504 + c), wv2 = *(const f32x4*)(cw + 22016 + 5504 + c), bv = *(const f32x4*)(cb + 5504 + c);
#define XG(j) acc[(j) >> 2][0][(j) & 3][n]
#define XV(j) acc[(j) >> 2][1][(j) & 3][n]
            const f32x4 gm1 = dpp_shr1(XG(7)), gm2 = dpp_shr1(XG(6)), vm1 = dpp_shr1(XV(7)), vm2 = dpp_shr1(XV(6));
            if (fr == 0) { float* hp = HALO + (size_t)(blk * 4) * 11008 + c; *(f32x4*)hp = XG(0); *(f32x4*)(hp + 11008) = XG(1); *(f32x4*)(hp + 5504) = XV(0); *(f32x4*)(hp + 11008 + 5504) = XV(1); }
            if (fr == 15) { float* hp = HALO + (size_t)(blk * 4 + 2) * 11008 + c; *(f32x4*)hp = XG(6); *(f32x4*)(hp + 11008) = XG(7); *(f32x4*)(hp + 5504) = XV(6); *(f32x4*)(hp + 11008 + 5504) = XV(7); }
#pragma unroll
            for (int j = 0; j < 8; ++j) {
                const f32x4 g2 = (j >= 2) ? XG(j >= 2 ? j - 2 : 0) : (j == 0 ? gm2 : gm1), g1 = (j >= 1) ? XG(j >= 1 ? j - 1 : 0) : gm1;
                const f32x4 v2 = (j >= 2) ? XV(j >= 2 ? j - 2 : 0) : (j == 0 ? vm2 : vm1), v1 = (j >= 1) ? XV(j >= 1 ? j - 1 : 0) : vm1;
                const f32x4 cg = bg + wg0 * g2 + wg1 * g1 + wg2 * XG(j), cv = bv + wv0 * v2 + wv1 * v1 + wv2 * XV(j);
                const unsigned p0 = cvt_pk_bf16(gelu_tanh1(cg[0]) * cv[0], gelu_tanh1(cg[1]) * cv[1]), p1 = cvt_pk_bf16(gelu_tanh1(cg[2]) * cv[2], gelu_tanh1(cg[3]) * cv[3]);
                if (n == 0) { pk[j][0] = p0; pk[j][1] = p1; }
                else if (!(fr == 0 && j < 2)) *(u32x4*)(ACT + (size_t)(prow + j) * 5504 + ch0) = (u32x4){pk[j][0], pk[j][1], p0, p1};
            }
#undef XG
#undef XV
        }
    }
};
struct EpiProj {
    static constexpr bool PERM = true, AFTER_DRAIN = false, PERMA = false;
    bf16_t *U16, *CQ, *CKV, *HQ, *HV, *HGT, *KF; float* LOGF; float* ssq_q; float* ssq_kv; const float* lb; const float* cosT; const float* sinT;
    __device__ __forceinline__ void operator()(const f32x4 (&acc)[2][2][4][2], const Unit& u, int wr, int wc, int fr, int fq) const {
        const int row0 = u.pm * BM + wr * 64 + fr, col8 = wc * 32 + 8 * fq, pn = u.pn;
        if (pn == 13) {
            if (wc < 2) { const int f0 = (wc * 4 + fq) * 4;
#pragma unroll
                for (int ai = 0; ai < 2; ++ai)
#pragma unroll
                    for (int m = 0; m < 4; ++m) { const int row = row0 + ai * HALF + m * 16, b = row >> 12, s = row & 4095;
                        const f32x4 cs = *(const f32x4*)(cosT + (size_t)row * 32 + f0), sn = *(const f32x4*)(sinT + (size_t)row * 32 + f0);
                        const f32x4 x1 = acc[ai][0][m][0], x2 = acc[ai][0][m][1]; const f32x4 o1 = x1 * cs - x2 * sn, o2 = x2 * cs + x1 * sn;
                        typedef unsigned u32x2 __attribute__((ext_vector_type(2)));
                        const u32x2 w1 = (u32x2){cvt_pk_bf16(o1[0], o1[1]), cvt_pk_bf16(o1[2], o1[3])}, w2 = (u32x2){cvt_pk_bf16(o2[0], o2[1]), cvt_pk_bf16(o2[2], o2[3])};
#pragma unroll
                        for (int h = 0; h < 8; ++h) { bf16_t* kp = KF + ((size_t)(b * 8 + h) * 4096 + s) * 192 + 128 + f0; *(u32x2*)kp = w1; *(u32x2*)(kp + 32) = w2; } } }
            return;
        }
        if (pn == 7 || pn == 8) {
            const int cbase = (pn - 7) * 256;
#pragma unroll
            for (int bj = 0; bj < 2; ++bj) { const int col = cbase + bj * HALF + col8; const f32x4 l0 = *(const f32x4*)(lb + col), l1 = *(const f32x4*)(lb + col + 4);
#pragma unroll
                for (int ai = 0; ai < 2; ++ai)
#pragma unroll
                    for (int m = 0; m < 4; ++m) { const size_t row = (size_t)(row0 + ai * HALF + m * 16); f32x4 o0, o1;
#pragma unroll
                        for (int e = 0; e < 4; ++e) { const float z0 = acc[ai][bj][m][0][e], z1 = acc[ai][bj][m][1][e];
                            o0[e] = __logf(l0[e] + (1.f - l0[e]) * __builtin_amdgcn_rcpf(1.f + __expf(-z0))); o1[e] = __logf(l1[e] + (1.f - l1[e]) * __builtin_amdgcn_rcpf(1.f + __expf(-z1))); }
                        *(f32x4*)(LOGF + row * 512 + col) = o0; *(f32x4*)(LOGF + row * 512 + col + 4) = o1; } }
            return;
        }
        bf16_t* base; int ld, cbase, nslot = 0, slot0 = 0; bool act = false; float* ssq = nullptr;
        if (pn < 2) { base = U16; ld = 512; cbase = pn * 256; }
        else if (pn < 4) { base = CQ; ld = 512; cbase = (pn - 2) * 256; ssq = ssq_q; nslot = 8; slot0 = (pn - 2) * 4; }
        else if (pn == 4) { base = CKV; ld = 256; cbase = 0; ssq = ssq_kv; nslot = 4; }
        else if (pn < 7) { base = HQ; ld = 512; cbase = (pn - 5) * 256; act = true; }
        else if (pn < 11) { base = HV; ld = 512; cbase = (pn - 9) * 256; }
        else { base = HGT; ld = 512; cbase = (pn - 11) * 256; act = true; }
#pragma unroll
        for (int ai = 0; ai < 2; ++ai)
#pragma unroll
            for (int m = 0; m < 4; ++m) { const size_t row = (size_t)(row0 + ai * HALF + m * 16); float ss = 0.f;
#pragma unroll
                for (int bj = 0; bj < 2; ++bj) { f32x4 v0 = acc[ai][bj][m][0], v1 = acc[ai][bj][m][1];
                    ss += (v0[0] * v0[0] + v0[1] * v0[1]) + (v0[2] * v0[2] + v0[3] * v0[3]) + (v1[0] * v1[0] + v1[1] * v1[1]) + (v1[2] * v1[2] + v1[3] * v1[3]);
                    if (act) {
#pragma unroll
                        for (int e = 0; e < 4; ++e) { v0[e] = v0[e] * __builtin_amdgcn_rcpf(1.f + __expf(-v0[e])); v1[e] = v1[e] * __builtin_amdgcn_rcpf(1.f + __expf(-v1[e])); } }
                    u32x4 w; w.x = cvt_pk_bf16(v0[0], v0[1]); w.y = cvt_pk_bf16(v0[2], v0[3]); w.z = cvt_pk_bf16(v1[0], v1[1]); w.w = cvt_pk_bf16(v1[2], v1[3]);
                    *(u32x4*)(base + row * ld + cbase + bj * HALF + col8) = w; }
                if (ssq) { ss += __shfl_xor(ss, 16); ss += __shfl_xor(ss, 32); if (fq == 0) ssq[row * nslot + slot0 + wc] = ss; } }
    }
};
struct EpiQGlu {
    static constexpr bool PERM = true, AFTER_DRAIN = false, PERMA = false;
    EpiQ q; EpiGlu glu;
    __device__ __forceinline__ void operator()(const f32x4 (&acc)[2][2][4][2], const Unit& u, int wr, int wc, int fr, int fq) const {
        if (u.pn < 6) q(acc, u, wr, wc, fr, fq);
        else { Unit v; v.pm = u.pm; v.pn = u.pn - 6; glu(acc, v, wr, wc, fr, fq); }
    }
};
template <class Epi, class Sched, bool ALIGN_EPI = false, bool SP2 = false>
__device__ __forceinline__ void gemm_phase(PG8_LAS unsigned char* lds, const Gemm g, const Sched& S, const Epi& E) {
    int tid_ = threadIdx.x; asm volatile("" : "+v"(tid_));
    const int tid = tid_, wid = __builtin_amdgcn_readfirstlane(tid >> 6), lane = tid & 63, wr = wid >> 2, wc = wid & 3, fr = lane & 15, fq = lane >> 4;
    const int K = g.K, nt = K / BK;
    unsigned voffA[2], voffB[2];
#pragma unroll
    for (int i = 0; i < 2; ++i) { int R, C; stage_rc(tid * 16 + i * 8192, R, C); const int Rb = Epi::PERM ? ((R & ~31) + perm32(R & 31)) : R;
        const int Ra = Epi::PERMA ? (((R >> 6) & 1) * 128 + (R & 15) * 8 + ((R >> 4) & 3)) : R;
        voffA[i] = (unsigned)(Ra * K + C) * 2u; voffB[i] = (unsigned)(Rb * K + C) * 2u; }
    const size_t kstep = (size_t)(BK * 2);
    const size_t hstep = (size_t)HALF * K * 2;
    const size_t hstepA = Epi::PERMA ? (size_t)4 * K * 2 : hstep;
    const size_t tstep = 2 * hstep;
    const unsigned ldsw = (unsigned)wid * 1024u;
    const int aoff = lds_byte(wr * 64 + fr, fq * 8), boff = lds_byte(wc * 32 + fr, fq * 8);
#define PG8_SA(b, h) (((b) * 2 + (h)) * HTB)
#define PG8_SB(b, h) ((4 + (b) * 2 + (h)) * HTB)
#define PG8_STAGE(bufoff, gbase, voff) do { _Pragma("unroll") for (int _i = 0; _i < 2; ++_i) \
        __builtin_amdgcn_global_load_lds((const unsigned*)((const char*)(gbase) + (voff)[_i]), (PG8_LAS unsigned*)(lds + (bufoff) + ldsw + _i * 8192), 16, 0, 0); } while (0)
#define PG8_LDA(dst, b, h) do { _Pragma("unroll") for (int m = 0; m < 4; ++m) _Pragma("unroll") for (int k = 0; k < 2; ++k) dst[m][k] = *(const PG8_LAS bf16x8*)(lds + PG8_SA(b, h) + aoff + m * 2048 + k * 1024); } while (0)
#define PG8_LDB(dst, b, h) do { _Pragma("unroll") for (int n = 0; n < 2; ++n) _Pragma("unroll") for (int k = 0; k < 2; ++k) dst[n][k] = *(const PG8_LAS bf16x8*)(lds + PG8_SB(b, h) + boff + n * 2048 + k * 1024); } while (0)
#define PG8_MMA(ai, bj, At, Bt) do { __builtin_amdgcn_s_setprio(1); _Pragma("unroll") for (int m = 0; m < 4; ++m) _Pragma("unroll") for (int n = 0; n < 2; ++n) _Pragma("unroll") for (int k = 0; k < 2; ++k) \
        acc[ai][bj][m][n] = __builtin_amdgcn_mfma_f32_16x16x32_bf16(Bt[n][k], At[m][k], acc[ai][bj][m][n], 0, 0, 0); __builtin_amdgcn_s_setprio(0); } while (0)
#define PG8_WAIT_V(n) asm volatile("s_waitcnt vmcnt(" #n ")" ::: "memory")
#define PG8_WAIT_L(n) asm volatile("s_waitcnt lgkmcnt(" #n ")" ::: "memory")
#define PG8_BAR __builtin_amdgcn_s_barrier()
#define PG8_SCHED __builtin_amdgcn_sched_barrier(0)
    Unit cur, nxt; int ui = 0;
    if (!S.next(0, cur)) return;
    f32x4 acc[2][2][4][2];
#pragma unroll
    for (int a = 0; a < 2; ++a)
#pragma unroll
        for (int b = 0; b < 2; ++b)
#pragma unroll
            for (int m = 0; m < 4; ++m)
#pragma unroll
                for (int n = 0; n < 2; ++n) acc[a][b][m][n] = (f32x4){0.f, 0.f, 0.f, 0.f};
    bf16x8 At[4][2], B0[2][2], B1[2][2];
    const char* cA = (const char*)(cur.pn >= g.pn_split ? g.A2 : g.A) + (size_t)cur.pm * tstep; const char* cB = (const char*)g.Bt + (size_t)cur.pn * tstep;
    S.a_ready(cur);
    if constexpr (SP2) {
        PG8_STAGE(PG8_SB(0, 0), cB, voffB); PG8_STAGE(PG8_SB(0, 1), cB + hstep, voffB); PG8_STAGE(PG8_SA(0, 0), cA, voffA); PG8_STAGE(PG8_SA(0, 1), cA + hstepA, voffA);
        if (wr == 1) PG8_BAR;
        PG8_WAIT_V(2); PG8_BAR;
        PG8_STAGE(PG8_SB(1, 0), cB + kstep, voffB); PG8_STAGE(PG8_SA(1, 0), cA + kstep, voffA); PG8_STAGE(PG8_SB(1, 1), cB + hstep + kstep, voffB);
        PG8_WAIT_V(6); PG8_BAR;
    } else {
        PG8_STAGE(PG8_SB(0, 0), cB, voffB); PG8_STAGE(PG8_SA(0, 0), cA, voffA); PG8_STAGE(PG8_SB(0, 1), cB + hstep, voffB); PG8_STAGE(PG8_SA(0, 1), cA + hstepA, voffA);
        if (wr == 1) PG8_BAR;
        PG8_WAIT_V(4); PG8_BAR;
        PG8_STAGE(PG8_SB(1, 0), cB + kstep, voffB); PG8_STAGE(PG8_SA(1, 0), cA + kstep, voffA); PG8_STAGE(PG8_SB(1, 1), cB + hstep + kstep, voffB);
        PG8_WAIT_V(6); PG8_BAR;
    }
    for (;;) {
        const bool has_next = S.next(ui + 1, nxt);
        const char* nA = has_next ? (const char*)(nxt.pn >= g.pn_split ? g.A2 : g.A) + (size_t)nxt.pm * tstep : cA; const char* nB = has_next ? (const char*)g.Bt + (size_t)nxt.pn * tstep : cB;
        for (int t = 0; t < nt; t += 2) {
            const bool last = (t == nt - 2);
            const char* a1 = cA + (size_t)(t + 1) * kstep;
            const char* a2 = last ? nA : cA + (size_t)(t + 2) * kstep; const char* b2 = last ? nB : cB + (size_t)(t + 2) * kstep;
            const char* a3 = a2 + kstep; const char* b3 = b2 + kstep;
            if (last && has_next) S.a_ready(nxt);
            if constexpr (SP2) {
            PG8_LDB(B0, 0, 0); PG8_LDB(B1, 0, 1); PG8_SCHED; PG8_LDA(At, 0, 0); PG8_STAGE(PG8_SA(1, 1), a1 + hstepA, voffA);
            PG8_WAIT_V(8); PG8_WAIT_L(0); PG8_BAR; PG8_MMA(0, 0, At, B0); PG8_MMA(0, 1, At, B1); PG8_BAR; PG8_SCHED;
            PG8_LDA(At, 0, 1); PG8_STAGE(PG8_SB(0, 0), b2, voffB); PG8_STAGE(PG8_SB(0, 1), b2 + hstep, voffB); PG8_STAGE(PG8_SA(0, 0), a2, voffA);
            PG8_WAIT_V(8); PG8_WAIT_L(0); PG8_BAR; PG8_MMA(1, 0, At, B0); PG8_MMA(1, 1, At, B1); PG8_BAR; PG8_SCHED;
            PG8_LDB(B0, 1, 0); PG8_LDB(B1, 1, 1); PG8_SCHED; PG8_LDA(At, 1, 0); PG8_STAGE(PG8_SA(0, 1), a2 + hstepA, voffA);
            PG8_WAIT_V(8); PG8_WAIT_L(0); PG8_BAR; PG8_MMA(0, 0, At, B0); PG8_MMA(0, 1, At, B1); PG8_BAR; PG8_SCHED;
            PG8_LDA(At, 1, 1); PG8_STAGE(PG8_SB(1, 0), b3, voffB); PG8_STAGE(PG8_SB(1, 1), b3 + hstep, voffB); PG8_STAGE(PG8_SA(1, 0), a3, voffA);
            PG8_WAIT_V(8); PG8_WAIT_L(0); PG8_BAR; PG8_MMA(1, 0, At, B0); PG8_MMA(1, 1, At, B1); PG8_BAR; PG8_SCHED;
            } else {
            PG8_LDB(B0, 0, 0); PG8_SCHED; PG8_LDA(At, 0, 0); PG8_STAGE(PG8_SA(1, 1), a1 + hstepA, voffA);
            PG8_WAIT_L(8); PG8_BAR; PG8_WAIT_L(0); PG8_MMA(0, 0, At, B0); PG8_BAR; PG8_SCHED;
            PG8_LDB(B1, 0, 1); PG8_STAGE(PG8_SB(0, 0), b2, voffB);
            PG8_BAR; PG8_WAIT_L(0); PG8_MMA(0, 1, At, B1); PG8_BAR;
            PG8_LDA(At, 0, 1); PG8_STAGE(PG8_SA(0, 0), a2, voffA);
            PG8_BAR; PG8_WAIT_L(0); PG8_MMA(1, 0, At, B0); PG8_BAR; PG8_SCHED;
            PG8_STAGE(PG8_SB(0, 1), b2 + hstep, voffB);
            PG8_WAIT_V(6); PG8_BAR; PG8_MMA(1, 1, At, B1); PG8_BAR;
            PG8_LDB(B0, 1, 0); PG8_SCHED; PG8_LDA(At, 1, 0); PG8_STAGE(PG8_SA(0, 1), a2 + hstepA, voffA);
            PG8_WAIT_L(8); PG8_BAR; PG8_WAIT_L(0); PG8_MMA(0, 0, At, B0); PG8_BAR; PG8_SCHED;
            PG8_LDB(B1, 1, 1); PG8_STAGE(PG8_SB(1, 0), b3, voffB);
            PG8_BAR; PG8_WAIT_L(0); PG8_MMA(0, 1, At, B1); PG8_BAR;
            PG8_LDA(At, 1, 1); PG8_STAGE(PG8_SA(1, 0), a3, voffA);
            PG8_BAR; PG8_WAIT_L(0); PG8_MMA(1, 0, At, B0); PG8_BAR; PG8_SCHED;
            PG8_STAGE(PG8_SB(1, 1), b3 + hstep, voffB);
            PG8_WAIT_V(6); PG8_BAR; PG8_MMA(1, 1, At, B1); PG8_BAR;
            }
        }
        if constexpr (ALIGN_EPI) { if (wr == 0) PG8_BAR; }
        if constexpr (!Epi::AFTER_DRAIN) { E(acc, cur, wr, wc, fr, fq); S.done(cur); }
        if (!has_next) break;
#pragma unroll
        for (int a = 0; a < 2; ++a)
#pragma unroll
            for (int b = 0; b < 2; ++b)
#pragma unroll
                for (int m = 0; m < 4; ++m)
#pragma unroll
                    for (int n = 0; n < 2; ++n) acc[a][b][m][n] = (f32x4){0.f, 0.f, 0.f, 0.f};
        cur = nxt; cA = nA; cB = nB; ++ui;
        if constexpr (ALIGN_EPI) { if (wr == 1) PG8_BAR; }
    }
    PG8_WAIT_V(0);
    if constexpr (!ALIGN_EPI) { if (wr == 0) PG8_BAR; }
    PG8_BAR;
    if constexpr (Epi::AFTER_DRAIN) { E.fused(acc, cur, wr, wc, fr, fq, lds, wid, lane); S.done(cur); }
#undef PG8_SA
#undef PG8_SB
#undef PG8_STAGE
#undef PG8_LDA
#undef PG8_LDB
#undef PG8_MMA
#undef PG8_WAIT_V
#undef PG8_WAIT_L
#undef PG8_BAR
#undef PG8_SCHED
}
}
constexpr int NB = 4, SEQ = 4096, DM = 2048, NL = 4, M = NB * SEQ;
constexpr int DIN = 3392, DINP = 3584;
constexpr int NH = 8, DQK = 192, QRANK = 512, KVRANK = 256;
constexpr int DFF = 5504, DFF2 = 11008;
constexpr float EPS = 1e-6f;
constexpr int PC_S5 = 0, PC_CQ = 512, PC_CKV = 1024, PC_HQ = 1280, PC_HF = 1792, PC_HI = 2304, PC_HG = 2816, PC_KR = 3328;
constexpr int NWAVES = 8, NTHR = 512;
constexpr int LDS_BYTES = 147456, RING_BYTES = 131072, CTRL_OFF = LDS_BYTES - 2048, MISC_OFF = CTRL_OFF + 320;

enum { I_X = 0, I_C, I_POS, I_WIN, I_LRE, I_LIM, I_LDT, I_BRE, I_BIM, I_CRE, I_CIM, I_S5D, I_WGLU, I_QN, I_WUQ, I_KVN, I_WUKV, I_LB, I_HGN, I_WOUT,
       I_MPRE, I_MPOST, I_FPRE, I_FPOST, I_WUP, I_CW, I_CB, I_WDN, I_WADA, I_BADA, N_IN };

constexpr size_t MiB = 1u << 20;
#ifndef MK_ONE_LAUNCH
#define MK_ONE_LAUNCH 1
#endif
constexpr size_t WS_CTL = 0, CTL_ZERO_BYTES = 1 * MiB;
constexpr int CW_BAR = 4096;
constexpr size_t WS_MODP = 1 * MiB;
constexpr size_t WS_MOD = 13 * MiB;
constexpr size_t WS_COS = 14 * MiB, WS_SIN = 16 * MiB;
constexpr size_t WS_LB = 18 * MiB;
constexpr size_t WS_RSTDQ = 18 * MiB + 65536, WS_RSTDKV = 18 * MiB + 2 * 65536;
constexpr size_t WS_W = 19 * MiB;
constexpr size_t WL_IN = 0, WL_UQ = WL_IN + (size_t)DINP * DM * 2, WL_GLU = WL_UQ + (size_t)1536 * 512 * 2  , WL_UKV = WL_GLU + (size_t)512 * 512 * 2,
                 WL_OUT = WL_UKV + (size_t)2048 * 256 * 2, WL_UP = WL_OUT + (size_t)DM * DM * 2, WL_DN = WL_UP + (size_t)DFF2 * DM * 2, WL_SIZE = WL_DN + (size_t)DM * DFF * 2;
static_assert(WL_SIZE == 93847552, "weight bytes per layer");
constexpr size_t WS_X = 378 * MiB;
constexpr size_t WS_H = 506 * MiB;
constexpr size_t WS_T1 = 570 * MiB;
constexpr size_t WS_T2 = 914 * MiB;
constexpr size_t WS_ACT = 1138 * MiB;
constexpr size_t WS_CAT = 1310 * MiB;
constexpr size_t WS_MISC = 1374 * MiB;
constexpr size_t WS_CQ = WS_MISC, WS_CKV = WS_MISC + 16 * MiB, WS_YG16 = WS_MISC + 24 * MiB, WS_DS5 = WS_MISC + 40 * MiB, WS_HP = WS_MISC + 44 * MiB, WS_BLAST = WS_MISC + 46 * MiB;
constexpr size_t WS_U16 = WS_T1, WS_HQ = WS_T1 + 16 * MiB, WS_LOGF = WS_T1 + 32 * MiB, WS_HV = WS_T1 + 64 * MiB, WS_HGT = WS_T1 + 80 * MiB;
constexpr size_t WS_SSQQ = WS_MISC + 47 * MiB, WS_SSQKV = WS_MISC + 47 * MiB + 512 * 1024;
constexpr size_t WS_DST = WS_T1 + 224 * MiB;
constexpr size_t WS_S5T = WS_T1 + 96 * MiB;
constexpr size_t WS_HALO = WS_T1 + 310 * MiB;
constexpr size_t WS_SPT = WS_ACT + 128 * MiB;
constexpr size_t WS_PW = 1510 * MiB;
constexpr size_t WS_BBAR = 1515 * MiB;
constexpr size_t WS_END = 1516 * MiB;
static_assert(WS_W + NL * WL_SIZE <= WS_X, "weights fit");

#define GAS __attribute__((address_space(1)))
#define LAS __attribute__((address_space(3)))
typedef unsigned short bf16;
typedef unsigned v4u __attribute__((ext_vector_type(4)));
typedef unsigned v2u __attribute__((ext_vector_type(2)));
typedef float f32x4 __attribute__((ext_vector_type(4)));
typedef GAS unsigned gu32;
#define RLX_AGENT __ATOMIC_RELAXED, __HIP_MEMORY_SCOPE_AGENT
#define LDS_WAIT() asm volatile("s_waitcnt lgkmcnt(0)" ::: "memory")
__device__ __forceinline__ unsigned f2bf(float f) { unsigned u = __builtin_bit_cast(unsigned, f); return (u + 0x7fffu + ((u >> 16) & 1u)) >> 16; }
__device__ __forceinline__ unsigned pk2(float lo, float hi) { return f2bf(lo) | (f2bf(hi) << 16); }
__device__ __forceinline__ float bf2f(unsigned short b) { return __builtin_bit_cast(float, ((unsigned)b) << 16); }
__device__ __forceinline__ float wave_sum(float v) {
#pragma unroll
    for (int o = 1; o < 64; o <<= 1) v += __shfl_xor(v, o);
    return v;
}
__device__ __forceinline__ float sigmoidf_(float x) { return 1.f / (1.f + __expf(-x)); }
__device__ __forceinline__ float siluf_(float x) { return x / (1.f + __expf(-x)); }
__device__ __forceinline__ float gelu_tanh(float x) { const float t = 0.7978845608028654f * (x + 0.044715f * x * x * x); return x / (1.f + __expf(-2.f * t)); }
#define XB_TMO      128
#define XB_XCNT(j)  (256  + 64 * (j))
#define XB_XSUB(j)  (1280 + 64 * (j))
#define XB_XGEN(j)  (2304 + 64 * (j))
#define XB_TOP      3328
#define XB_TOPGEN   3392
#define XCD_BAR_WORDS 3456
#define XB_SPIN_CAP (1u << 18)

__device__ __forceinline__ unsigned xb_ld(unsigned* p)              { return __hip_atomic_load(p, __ATOMIC_RELAXED, __HIP_MEMORY_SCOPE_AGENT); }
__device__ __forceinline__ unsigned xb_add(unsigned* p, unsigned v) { return __hip_atomic_fetch_add(p, v, __ATOMIC_RELAXED, __HIP_MEMORY_SCOPE_AGENT); }
__device__ __forceinline__ unsigned xb_xcc_id() { return (unsigned)__builtin_amdgcn_s_getreg((3 << 11) | 20) & 0xFu; }
#define XB_SPIN(cond, bar) do { unsigned _sp = 0; while (cond) { __builtin_amdgcn_s_sleep(1); \
    if ((++_sp & 255u) == 0u) { if (xb_ld(&(bar)[XB_TMO])) break; if (_sp > XB_SPIN_CAP) { atomicAdd(&(bar)[XB_TMO], 1u); break; } } } } while (0)

struct XcdBarrier {
    unsigned* bar; unsigned x;
    volatile LAS unsigned* st;
};

__device__ __forceinline__ XcdBarrier xcd_barrier_post(unsigned* bar, volatile LAS unsigned* st) {
    XcdBarrier b; b.bar = bar; b.x = xb_xcc_id(); b.st = st;
    if (threadIdx.x == 0) (void)xb_add(&bar[XB_XCNT(b.x)], 1u);
    return b;
}
__device__ __forceinline__ void xcd_barrier_complete(unsigned* bar, unsigned x, unsigned& nloc, unsigned& nx) {
    const unsigned G = gridDim.x * gridDim.y * gridDim.z;
    unsigned sum, cnt, mine, sp = 0u;
    for (;;) {
        sum = 0u; cnt = 0u; mine = 0u;
#pragma unroll
        for (unsigned j = 0; j < 16; ++j) { const unsigned c = xb_ld(&bar[XB_XCNT(j)]); sum += c; cnt += (c > 0u) ? 1u : 0u; mine = (j == x) ? c : mine; }
        if (sum == G) break;
        __builtin_amdgcn_s_sleep(1);
        if ((++sp & 255u) == 0u) { if (xb_ld(&bar[XB_TMO])) break; if (sp > XB_SPIN_CAP) { atomicAdd(&bar[XB_TMO], 1u); break; } }
    }
    nloc = mine > 0u ? mine : 1u; nx = cnt > 0u ? cnt : 1u;
}

__device__ __forceinline__ void xcd_barrier(const XcdBarrier& b) {
    asm volatile("s_waitcnt vmcnt(0)" ::: "memory");
    __syncthreads();
    if (threadIdx.x == 0) {
        unsigned* bar = b.bar;
        __builtin_amdgcn_s_waitcnt(0);
        unsigned nloc = b.st[0], nx = b.st[1];
        if (nloc == 0u) { xcd_barrier_complete(bar, b.x, nloc, nx); b.st[0] = nloc; b.st[1] = nx; }
        const unsigned old = xb_add(&bar[XB_XSUB(b.x)], 1u);
        const unsigned gen = old / nloc;
        if (old + 1u == (gen + 1u) * nloc) {
            __builtin_amdgcn_fence(__ATOMIC_RELEASE, "agent");
            asm volatile("s_waitcnt vmcnt(0)" ::: "memory");
            const unsigned og = xb_add(&bar[XB_TOP], 1u);
            const unsigned tg = og / nx;
            if (og + 1u == (tg + 1u) * nx) xb_add(&bar[XB_TOPGEN], 1u);
            else XB_SPIN(xb_ld(&bar[XB_TOPGEN]) == tg, bar);
            __builtin_amdgcn_fence(__ATOMIC_ACQUIRE, "agent");
            xb_add(&bar[XB_XGEN(b.x)], 1u);
            asm volatile("s_waitcnt vmcnt(0)" ::: "memory");
        } else {
            XB_SPIN(xb_ld(&bar[XB_XGEN(b.x)]) == gen, bar);
            __builtin_amdgcn_fence(__ATOMIC_ACQUIRE, "agent");
            asm volatile("s_waitcnt vmcnt(0)" ::: "memory");
        }
    }
    __syncthreads();
}
namespace att {
typedef short bf16x8 __attribute__((ext_vector_type(8)));
typedef short s16x4 __attribute__((ext_vector_type(4)));
typedef float f32x16 __attribute__((ext_vector_type(16)));
typedef float f32x4 __attribute__((ext_vector_type(4)));
typedef unsigned u32x4 __attribute__((ext_vector_type(4)));
constexpr int DQ = 192, DVV = 128, QBLK = 32, KVBLK = 64, QB = 256;
constexpr int SHM_V = KVBLK * DVV * 2, SHM_K = KVBLK * DQ * 2;
constexpr int LDS_V = 0, LDS_K = 3 * SHM_V, LDS_WS = LDS_K + 2 * SHM_K, LDS_OST = LDS_WS + 8 * 64 * 4, ATT_LDS = LDS_OST;
constexpr float SCALE = 0.07216878364870322f;
constexpr float QSCALE = SCALE * 1.4426950408889634f;
constexpr float THR2 = 8.f * 1.4426950408889634f;
#define SBAR() __builtin_amdgcn_sched_barrier(0)
__device__ __forceinline__ int v_st(int k, int c) { const int kk = (k & ~0xC) | ((k & 4) << 1) | ((k & 8) >> 1); return ((kk >> 3) * 4 + (c >> 5)) * 512 + ((kk & 7) * 32 + (c & 31)) * 2; }
__device__ __forceinline__ int v_rd_base(int lane) { return ((lane & 3) << 3) | (((lane >> 2) & 3) << 6) | (((lane >> 4) & 1) << 5) | (((lane >> 5) & 1) << 8); }
constexpr int v_rd_off(int d0, int ks, int half) { return d0 * 512 + ks * 4096 + half * 2048; }
__device__ __forceinline__ int crow(int r, int hi) { return (r & 3) + 8 * (r >> 2) + 4 * hi; }
__device__ __forceinline__ unsigned cvtpk(float lo, float hi) { typedef float f2_ __attribute__((ext_vector_type(2))); typedef __bf16 b2_ __attribute__((ext_vector_type(2))); const b2_ r = __builtin_convertvector((f2_){lo, hi}, b2_); return __builtin_bit_cast(unsigned, r); }
__device__ __forceinline__ int k_off(int row, int chunk  ) { return (chunk >> 3) * 8192 + row * 128 + ((((chunk & 7) ^ ((row >> 1) & 7))) << 4); }

__device__ __forceinline__ void mask_tile(f32x16& p0, f32x16& p1, int dq) {
    const float NEG = -__builtin_inff();
#pragma unroll
    for (int r = 0; r < 16; ++r) { const int c = (r & 3) + 8 * (r >> 2);
        if (dq - c < 0) p0[r] = NEG;
        if (dq - c - 32 < 0) p1[r] = NEG; }
}
__device__ __forceinline__ void partialSM(f32x16& p0, f32x16& p1, float& m_reg, float bs, float& alpha) {
    float pmax = p0[0];
#pragma unroll
    for (int r = 1; r < 16; ++r) pmax = fmaxf(pmax, p0[r]);
#pragma unroll
    for (int r = 0; r < 16; ++r) pmax = fmaxf(pmax, p1[r]);
    { auto rr = __builtin_amdgcn_permlane32_swap(__float_as_uint(pmax), __float_as_uint(pmax), false, false);
      pmax = fmaxf(__uint_as_float(rr[0]), __uint_as_float(rr[1])); }
    if (__builtin_expect(__all(pmax + bs - m_reg <= THR2), 1)) { alpha = 1.f; }
    else { const float mn = fmaxf(m_reg, pmax + bs); alpha = __builtin_amdgcn_exp2f(m_reg - mn); const float off = bs - mn; m_reg = mn;
#pragma unroll
        for (int r = 0; r < 16; ++r) { p0[r] += off; p1[r] += off; } }
#pragma unroll
    for (int r = 0; r < 16; ++r) p0[r] = __builtin_amdgcn_exp2f(p0[r]);
#pragma unroll
    for (int r = 0; r < 16; ++r) p1[r] = __builtin_amdgcn_exp2f(p1[r]);
}
__device__ __forceinline__ void finishSM(f32x16& p0, f32x16& p1, float alpha, float& l_reg, bf16x8& pa0, bf16x8& pa1, bf16x8& pa2, bf16x8& pa3) {
    float ps = 0;
#pragma unroll
    for (int r = 0; r < 16; ++r) ps += p0[r];
#pragma unroll
    for (int r = 0; r < 16; ++r) ps += p1[r];
    { auto rr = __builtin_amdgcn_permlane32_swap(__float_as_uint(ps), __float_as_uint(ps), false, false);
      ps = __uint_as_float(rr[0]) + __uint_as_float(rr[1]); }
    l_reg = l_reg * alpha + ps;
#define PK4(P, B_, OUT) do { unsigned a0 = cvtpk(P[B_+0], P[B_+1]), a1 = cvtpk(P[B_+2], P[B_+3]);                          \
        unsigned b0 = cvtpk(P[B_+4], P[B_+5]), b1 = cvtpk(P[B_+6], P[B_+7]);                                             \
        auto r0 = __builtin_amdgcn_permlane32_swap(a0, b0, false, false); auto r1 = __builtin_amdgcn_permlane32_swap(a1, b1, false, false); \
        u32x4 w = {r0[0], r1[0], r0[1], r1[1]}; OUT = *reinterpret_cast<bf16x8*>(&w); } while (0)
    PK4(p0, 0, pa0); PK4(p0, 8, pa1); PK4(p1, 0, pa2); PK4(p1, 8, pa3);
#undef PK4
}
__device__ __forceinline__ void qkt(f32x16& p0, f32x16& p1, const LAS unsigned char* lds, int kbuf, int r32, int hi, const bf16x8* qr, float init) {
#pragma unroll
    for (int r = 0; r < 16; ++r) { p0[r] = init; p1[r] = init; }
    const int e = hi ^ ((r32 >> 1) & 7);
    int kb[4];
#pragma unroll
    for (int j = 0; j < 4; ++j) kb[j] = (int)(uintptr_t)lds + kbuf + r32 * 128 + ((((j << 1) ^ e)) << 4);
#define KRD(dst, d0_, h_) asm volatile("ds_read_b128 %0, %1 offset:%2" : "=&v"(dst) : "v"(kb[(d0_) & 3]), "i"(((d0_) >> 2) * 8192 + (h_) * 4096) : "memory")
    bf16x8 ka[3][2];
    KRD(ka[0][0], 0, 0); KRD(ka[0][1], 0, 1); KRD(ka[1][0], 1, 0); KRD(ka[1][1], 1, 1);
#pragma unroll
    for (int d0 = 0; d0 < 12; ++d0) {
        if (d0 + 2 < 12) { KRD(ka[(d0 + 2) % 3][0], d0 + 2, 0); KRD(ka[(d0 + 2) % 3][1], d0 + 2, 1); asm volatile("s_waitcnt lgkmcnt(4)" ::: "memory"); }
        else if (d0 == 10) asm volatile("s_waitcnt lgkmcnt(2)" ::: "memory");
        else asm volatile("s_waitcnt lgkmcnt(0)" ::: "memory");
        SBAR();
        p0 = __builtin_amdgcn_mfma_f32_32x32x16_bf16(ka[d0 % 3][0], qr[d0], p0, 0, 0, 0);
        p1 = __builtin_amdgcn_mfma_f32_32x32x16_bf16(ka[d0 % 3][1], qr[d0], p1, 0, 0, 0);
        SBAR(); }
#undef KRD
}
__device__ __forceinline__ void pv_tile(f32x16* o, int vb0, bf16x8 pa0, bf16x8 pa1, bf16x8 pa2, bf16x8 pa3) {
#define TRRD(dst, off) asm volatile("ds_read_b64_tr_b16 %0, %1 offset:%2" : "=&v"(dst) : "v"(vb0), "i"(off) : "memory")
#define PV_D0(d0) do { s16x4 l0, l1, l2, l3, h0, h1, h2, h3; constexpr int b_ = v_rd_off(d0, 0, 0); \
        TRRD(l0, b_); TRRD(h0, b_ + 2048); TRRD(l1, b_ + 4096); TRRD(h1, b_ + 6144); TRRD(l2, b_ + 8192); TRRD(h2, b_ + 10240); TRRD(l3, b_ + 12288); TRRD(h3, b_ + 14336); \
        asm volatile("s_waitcnt lgkmcnt(0)" ::: "memory"); SBAR();   \
        o[d0] = __builtin_amdgcn_mfma_f32_32x32x16_bf16(pa0, (bf16x8){l0[0], l0[1], l0[2], l0[3], h0[0], h0[1], h0[2], h0[3]}, o[d0], 0, 0, 0);   \
        o[d0] = __builtin_amdgcn_mfma_f32_32x32x16_bf16(pa1, (bf16x8){l1[0], l1[1], l1[2], l1[3], h1[0], h1[1], h1[2], h1[3]}, o[d0], 0, 0, 0);   \
        o[d0] = __builtin_amdgcn_mfma_f32_32x32x16_bf16(pa2, (bf16x8){l2[0], l2[1], l2[2], l2[3], h2[0], h2[1], h2[2], h2[3]}, o[d0], 0, 0, 0);   \
        o[d0] = __builtin_amdgcn_mfma_f32_32x32x16_bf16(pa3, (bf16x8){l3[0], l3[1], l3[2], l3[3], h3[0], h3[1], h3[2], h3[3]}, o[d0], 0, 0, 0); } while (0)
    PV_D0(0); PV_D0(1); PV_D0(2); PV_D0(3);
#undef PV_D0
#undef TRRD
}
__device__ __forceinline__ void attn_block(const unsigned short* Q, const unsigned short* K, const unsigned short* V, unsigned short* O, int opitch, int qb, LAS unsigned char* lds) {
    int tid_ = threadIdx.x; asm volatile("" : "+v"(tid_));
    const int tid = tid_, wid = __builtin_amdgcn_readfirstlane(tid >> 6), lane = tid & 63, r32 = lane & 31, hi = lane >> 5;
    const int P0 = qb * QB, NT = (P0 + QB) / KVBLK;
    const int qlo = P0 + wid * QBLK, qpos = qlo + r32;
    LAS float* wsf = (LAS float*)(lds + LDS_WS) + wid * 64; LAS float* li_l = wsf; LAS float* al_l = wsf + 32;
    int voff[2], koff[3];
#pragma unroll
    for (int i = 0; i < 2; ++i) { const int P = (wid * 2 + i) * 1024 + lane * 16, sub = P >> 9, within = P & 511, kk = (sub >> 2) * 8 + (within >> 6);
        const int k = (kk & ~0xC) | ((kk & 4) << 1) | ((kk & 8) >> 1), c = (sub & 3) * 32 + ((within & 63) >> 1); voff[i] = k * DVV + c; }
#pragma unroll
    for (int i = 0; i < 3; ++i) { const int P = (wid * 3 + i) * 1024 + lane * 16, sblk = P >> 13, rem = P & 8191, row = rem >> 7, cc = ((rem & 127) >> 4) ^ ((row >> 1) & 7); koff[i] = row * DQ + sblk * 64 + cc * 8; }
    bf16x8 qr[12];
#pragma unroll
    for (int d0 = 0; d0 < 12; ++d0) qr[d0] = *(const bf16x8*)(Q + (size_t)(P0 + wid * QBLK + r32) * DQ + d0 * 16 + hi * 8);
#define SDMA(kb0, kbuf, vbuf) do { \
        _Pragma("unroll") for (int i = 0; i < 2; ++i) __builtin_amdgcn_global_load_lds((const unsigned*)(V + (size_t)(kb0) * DVV + voff[i]), (LAS unsigned*)(lds + LDS_V + (vbuf) * SHM_V + (wid * 2 + i) * 1024), 16, 0, 0); \
        _Pragma("unroll") for (int i = 0; i < 3; ++i) __builtin_amdgcn_global_load_lds((const unsigned*)(K + (size_t)(kb0) * DQ + koff[i]), (LAS unsigned*)(lds + LDS_K + (kbuf) * SHM_K + (wid * 3 + i) * 1024), 16, 0, 0); } while (0)
    __syncthreads();
    SDMA(0, 0, 0);
    asm volatile("s_waitcnt vmcnt(0)" ::: "memory"); __syncthreads();
    float m_reg = -1e30f, l_reg = 0.f; f32x16 o[4] = {};
    const int vbase = (int)(uintptr_t)(lds + LDS_V) + v_rd_base(lane);
    const bool late = wid >= 4;
    f32x16 p0, p1; float bs = 0.f; bool pend = false; int pt = 0;
#define SMPV() do { float alpha; bf16x8 pa0, pa1, pa2, pa3; \
        partialSM(p0, p1, m_reg, bs, alpha); finishSM(p0, p1, alpha, l_reg, pa0, pa1, pa2, pa3); \
        if (__any(alpha < 1.f)) { if (hi == 0) al_l[r32] = alpha; asm volatile("s_waitcnt lgkmcnt(0)" ::: "memory"); \
            _Pragma("unroll") for (int d_ = 0; d_ < 4; ++d_) _Pragma("unroll") for (int r = 0; r < 16; ++r) o[d_][r] *= al_l[crow(r, hi)]; } \
        pv_tile(o, vbase + (pt % 3) * SHM_V, pa0, pa1, pa2, pa3); pend = false; } while (0)
    for (int t = 0; t <= NT; ++t) {
        if (t + 1 < NT) SDMA((t + 1) * KVBLK, (t & 1) ^ 1, (t + 1) % 3);
        if (late && pend) SMPV();
        if (t < NT && t * KVBLK <= qlo + QBLK - 1) {
            bs = m_reg > -1e29f ? m_reg : 0.f;
            qkt(p0, p1, lds, LDS_K + (t & 1) * SHM_K, r32, hi, qr, -bs);
            if (t * KVBLK + KVBLK - 1 > qlo) mask_tile(p0, p1, qpos - t * KVBLK - 4 * hi);
            pend = true; pt = t; }
        if (!late && pend) SMPV();
        asm volatile("s_waitcnt vmcnt(0)" ::: "memory"); __syncthreads();
    }
#undef SMPV
    if (hi == 0) li_l[r32] = l_reg; asm volatile("s_waitcnt lgkmcnt(0)" ::: "memory");
    unsigned short* Ow = O + (size_t)(P0 + wid * QBLK) * opitch;
#pragma unroll
    for (int r = 0; r < 16; ++r) { const int orow = crow(r, hi); const float rl = __builtin_amdgcn_rcpf(li_l[orow]);
#pragma unroll
        for (int d0 = 0; d0 < 4; ++d0) { const float v = o[d0][r] * rl; const float vn = __shfl_xor(v, 1);
            if ((r32 & 1) == 0) *(unsigned*)(Ow + (size_t)orow * opitch + d0 * 32 + r32) = cvtpk(v, vn); } }
#undef SDMA
}
#undef SBAR
}
struct Args { const void* in[N_IN]; float* out; unsigned char* ws; int ph_lo, ph_hi; };
struct Frame {
    LAS unsigned char* lds; unsigned char* ldsg;
    int tid, lane, wave, G, bid;
    unsigned char* ws;
    const void* const* in;
};
constexpr int PTAB_OFF = CTRL_OFF + 1024;
__device__ __forceinline__ const void* ldp(const Frame& F, int i) {
    const unsigned long long v = ((const LAS unsigned long long*)(F.lds + PTAB_OFF))[i];
    const unsigned lo = __builtin_amdgcn_readfirstlane((unsigned)v), hi = __builtin_amdgcn_readfirstlane((unsigned)(v >> 32));
    return (const void*)(const GAS void*)(((unsigned long long)hi << 32) | lo); }
#define INF(i) ((const float*)ldp(F, i))
__device__ __forceinline__ bf16* wt(const Frame& F, int l, size_t off) { return (bf16*)(F.ws + WS_W + (size_t)l * WL_SIZE + off); }

__device__ __forceinline__ void tr_item(const float* W, int ldw, int K, int k0, int sc, const float* kscale, bf16* dst  , LAS float* scr, int lane) {
    float v[64];
    const float* src = W + (size_t)k0 * ldw + (sc >= 0 ? sc : 0);
#pragma unroll
    for (int i = 0; i < 64; ++i) v[i] = sc >= 0 ? src[(size_t)i * ldw] : 0.f;
#pragma unroll
    for (int i = 0; i < 64; ++i) scr[i * 65 + lane] = v[i];
    LDS_WAIT(); asm volatile("" ::: "memory");
    const int c = lane & 7;
    f32x4 ks0 = (f32x4){1.f, 1.f, 1.f, 1.f}, ks1 = ks0;
    if (kscale) { ks0 = *(const f32x4*)(kscale + k0 + 8 * c); ks1 = *(const f32x4*)(kscale + k0 + 8 * c + 4); }
#pragma unroll
    for (int j = 0; j < 8; ++j) { const int n = (lane >> 3) + 8 * j; const LAS float* s = scr + (8 * c) * 65 + n;
        v4u o; o.x = pk2(s[0 * 65] * ks0.x, s[1 * 65] * ks0.y); o.y = pk2(s[2 * 65] * ks0.z, s[3 * 65] * ks0.w); o.z = pk2(s[4 * 65] * ks1.x, s[5 * 65] * ks1.y); o.w = pk2(s[6 * 65] * ks1.z, s[7 * 65] * ks1.w);
        *(v4u*)(dst + (size_t)n * K + k0 + 8 * c) = o; }
    LDS_WAIT(); asm volatile("" ::: "memory");
}
__device__ __forceinline__ int uq_srccol(int n) {
    if (n < 1024) return (n >> 7) * 192 + (n & 127);
    const int r = n - 1024, h = r >> 6, pos = r & 63, i = pos >> 3, e = pos & 7, f = 4 * i + (e & 3);
    return h * 192 + 128 + (e < 4 ? f : 32 + f);
}
__device__ __forceinline__ int win_srccol(int n) {
    if (n < 1280) return n;
    if (n < 3328) return n + 64;
    if (n < 3392) { const int pos = n - 3328, i = pos >> 3, e = pos & 7, f = 4 * i + (e & 3); return 1280 + (e < 4 ? f : 32 + f); }
    return -1;
}

namespace mx {
typedef short bf16x8 __attribute__((ext_vector_type(8)));
typedef float f32x16 __attribute__((ext_vector_type(16)));
__device__ __forceinline__ int crow(int r, int hi) { return (r & 3) + 8 * (r >> 2) + 4 * hi; }
__device__ __forceinline__ unsigned cvtpk(float lo, float hi) { typedef float f2_ __attribute__((ext_vector_type(2))); typedef __bf16 b2_ __attribute__((ext_vector_type(2))); const b2_ r = __builtin_convertvector((f2_){lo, hi}, b2_); return __builtin_bit_cast(unsigned, r); }
__device__ __forceinline__ bf16x8 pack8g(const float* p) { const f32x4 a = *(const f32x4*)p, b = *(const f32x4*)(p + 4); v4u w = {cvtpk(a.x, a.y), cvtpk(a.z, a.w), cvtpk(b.x, b.y), cvtpk(b.z, b.w)}; return *reinterpret_cast<bf16x8*>(&w); }
__device__ __forceinline__ bf16x8 pack8f(const float* v) { v4u w = {cvtpk(v[0], v[1]), cvtpk(v[2], v[3]), cvtpk(v[4], v[5]), cvtpk(v[6], v[7])}; return *reinterpret_cast<bf16x8*>(&w); }
#define MX_MFMA(a, b, c) __builtin_amdgcn_mfma_f32_32x32x16_bf16(a, b, c, 0, 0, 0)
__device__ __forceinline__ void acc_to_A(const f32x16& p, bf16x8& lo, bf16x8& hi) {
#define PK4(P, B_, OUT) do { unsigned a0 = cvtpk(P[B_+0], P[B_+1]), a1 = cvtpk(P[B_+2], P[B_+3]);                          \
        unsigned b0 = cvtpk(P[B_+4], P[B_+5]), b1 = cvtpk(P[B_+6], P[B_+7]);                                             \
        auto r0 = __builtin_amdgcn_permlane32_swap(a0, b0, false, false); auto r1 = __builtin_amdgcn_permlane32_swap(a1, b1, false, false); \
        v4u w = {r0[0], r1[0], r0[1], r1[1]}; OUT = *reinterpret_cast<bf16x8*>(&w); } while (0)
    PK4(p, 0, lo); PK4(p, 8, hi);
#undef PK4
}
}

constexpr size_t S5T_WIN = 0, S5T_KT = S5T_WIN + 128 * 1024 * 2, S5T_WOUT = S5T_KT + 65 * 256 * 2, S5T_L64 = S5T_WOUT + 1024 * 128 * 2, S5T_PW = S5T_L64 + 512, S5T_SIZE = S5T_PW + 65 * 64 * 8 + 256;
static_assert(S5T_SIZE % 16 == 0, "table alignment");
__device__ __forceinline__ void s5_tables_a(Frame& F) {
    const int gt = F.bid * NTHR + F.tid, NGT = F.G * NTHR;
    for (int i = gt; i < NL * 32 * 65 * 64; i += NGT) {
        const int p = i & 63, j = (i >> 6) % 65, lg = i / (65 * 64);
        const float lre = INF(I_LRE)[lg * 64 + p], lim = INF(I_LIM)[lg * 64 + p];
        const float dt = expf(INF(I_LDT)[lg]);
        const float er = expf(lre * dt * (float)j); float sn, cs; sincosf(lim * dt * (float)j, &sn, &cs);
        ((float2*)(F.ws + WS_PW))[i] = make_float2(er * cs, er * sn);
    }
    for (int i = gt; i < NL * 32 * 64 * 16; i += NGT) {
        const int lgp = i >> 4, lg = i >> 10;
        const float lre = INF(I_LRE)[lgp], lim = INF(I_LIM)[lgp];
        const float dt = expf(INF(I_LDT)[lg]);
        const float er = expf(lre * dt); float sn, cs; sincosf(lim * dt, &sn, &cs);
        const float nr = er * cs - 1.f, ni = er * sn, den = lre * lre + lim * lim;
        const float cr = (nr * lre + ni * lim) / den, ci = (ni * lre - nr * lim) / den;
        const float xr = INF(I_BRE)[i], xi = INF(I_BIM)[i];
        ((float2*)(F.ws + WS_BBAR))[i] = make_float2(cr * xr - ci * xi, cr * xi + ci * xr);
    }
}
__device__ __forceinline__ void s5_tables_b(Frame& F, int l, int gt, int NGT) {
    const float2* pwl = (const float2*)(F.ws + WS_PW) + (size_t)l * 32 * 65 * 64;
    const float2* bbl = (const float2*)(F.ws + WS_BBAR) + (size_t)l * 32 * 64 * 16;
    const float* crl = INF(I_CRE) + (size_t)l * 32 * 16 * 64; const float* cil = INF(I_CIM) + (size_t)l * 32 * 16 * 64;
    for (int i = gt; i < 32 * 128 * 128; i += NGT) {
        const int k0 = (i & 127) * 8, n = (i >> 7) & 127, g = i >> 14;
        const int p = n & 63, ri = n >> 6, s = k0 >> 4, c0 = k0 & 15;
        const float2 w = pwl[(g * 65 + 63 - s) * 64 + p]; const f32x4* bp = (const f32x4*)(bbl + (g * 64 + p) * 16 + c0); float o[8];
#pragma unroll
        for (int q = 0; q < 4; ++q) { const f32x4 b2 = bp[q];
            o[2 * q] = ri ? (w.x * b2.y + w.y * b2.x) : (w.x * b2.x - w.y * b2.y); o[2 * q + 1] = ri ? (w.x * b2.w + w.y * b2.z) : (w.x * b2.z - w.y * b2.w); }
        *(v4u*)((bf16*)(F.ws + WS_S5T + (size_t)(l * 32 + g) * S5T_SIZE + S5T_WIN) + n * 1024 + k0) = (v4u){pk2(o[0], o[1]), pk2(o[2], o[3]), pk2(o[4], o[5]), pk2(o[6], o[7])};
    }
    for (int i = gt; i < 32 * 1024 * 16; i += NGT) {
        const int k0 = (i & 15) * 8, n = (i >> 4) & 1023, g = i >> 14;
        const int p0 = k0 & 63, ri = k0 >> 6, t = n >> 4, c = n & 15;
        const f32x4* wp = (const f32x4*)(pwl + (g * 65 + t + 1) * 64 + p0); const f32x4* crp = (const f32x4*)(crl + (g * 16 + c) * 64 + p0); const f32x4* cip = (const f32x4*)(cil + (g * 16 + c) * 64 + p0);
        const f32x4 cr0 = crp[0], cr1 = crp[1], ci0 = cip[0], ci1 = cip[1]; const float cr[8] = {cr0[0], cr0[1], cr0[2], cr0[3], cr1[0], cr1[1], cr1[2], cr1[3]}, ci[8] = {ci0[0], ci0[1], ci0[2], ci0[3], ci1[0], ci1[1], ci1[2], ci1[3]};
        float o[8];
#pragma unroll
        for (int q = 0; q < 4; ++q) { const f32x4 w2 = wp[q];
            o[2 * q] = ri ? -(cr[2 * q] * w2.y + ci[2 * q] * w2.x) : (cr[2 * q] * w2.x - ci[2 * q] * w2.y);
            o[2 * q + 1] = ri ? -(cr[2 * q + 1] * w2.w + ci[2 * q + 1] * w2.z) : (cr[2 * q + 1] * w2.z - ci[2 * q + 1] * w2.w); }
        *(v4u*)((bf16*)(F.ws + WS_S5T + (size_t)(l * 32 + g) * S5T_SIZE + S5T_WOUT) + n * 128 + k0) = (v4u){pk2(o[0], o[1]), pk2(o[2], o[3]), pk2(o[4], o[5]), pk2(o[6], o[7])};
    }
    for (int i = gt; i < 32 * 64; i += NGT) { const int p = i & 63, g = i >> 6; const float2 w = pwl[(g * 65 + 64) * 64 + p];
        float* l64 = (float*)(F.ws + WS_S5T + (size_t)(l * 32 + g) * S5T_SIZE + S5T_L64); l64[p] = w.x; l64[64 + p] = w.y; }
    for (int i = gt; i < 32 * 65 * 16; i += NGT) {
        const int cc0 = (i & 3) * 4, c0 = ((i >> 2) & 3) * 4, li = (i >> 4) % 65, g = i / (65 * 16);
        float acc[4][4];
#pragma unroll
        for (int a = 0; a < 4; ++a)
#pragma unroll
            for (int b = 0; b < 4; ++b) acc[a][b] = 0.f;
        if (li > 0) {
            for (int p = 0; p < 64; ++p) {
                const float2 w = pwl[(g * 65 + li - 1) * 64 + p];
                float2 bv[4]; float cr[4], ci[4];
#pragma unroll
                for (int b = 0; b < 4; ++b) bv[b] = bbl[(g * 64 + p) * 16 + cc0 + b];
#pragma unroll
                for (int a = 0; a < 4; ++a) { cr[a] = crl[(g * 16 + c0 + a) * 64 + p]; ci[a] = cil[(g * 16 + c0 + a) * 64 + p]; }
#pragma unroll
                for (int a = 0; a < 4; ++a) { const float er = cr[a] * w.x - ci[a] * w.y, ei = cr[a] * w.y + ci[a] * w.x;
#pragma unroll
                    for (int b = 0; b < 4; ++b) acc[a][b] += er * bv[b].x - ei * bv[b].y; }
            }
        }
        bf16* kt = (bf16*)(F.ws + WS_S5T + (size_t)(l * 32 + g) * S5T_SIZE + S5T_KT) + li * 256;
#pragma unroll
        for (int a = 0; a < 4; ++a) *(v2u*)(kt + (c0 + a) * 16 + cc0) = (v2u){pk2(acc[a][0], acc[a][1]), pk2(acc[a][2], acc[a][3])};
    }
}
__device__ __forceinline__ void s5_step1_item(Frame& F, int l, int g, int rb, const bf16* u16, float* dS) {
    const int lane = F.lane, w = F.wave, c32 = lane & 31, hi = lane >> 5, cb = w & 3, kh = w >> 2;
    const int R = rb * 32 + c32, b = R >> 6, n = R & 63;
    const bf16* arow = u16 + ((size_t)b * SEQ + n * 64) * 512 + g * 16 + 8 * hi;
    const bf16* brow = (const bf16*)(F.ws + WS_S5T + (size_t)(l * 32 + g) * S5T_SIZE + S5T_WIN) + (size_t)(cb * 32 + c32) * 1024 + 8 * hi;
    mx::f32x16 acc = {};
#pragma unroll 8
    for (int s = kh * 32; s < kh * 32 + 32; ++s) {
        const mx::bf16x8 a = *(const mx::bf16x8*)(arow + (size_t)s * 512), bb = *(const mx::bf16x8*)(brow + s * 16);
        acc = MX_MFMA(a, bb, acc);
    }
    LAS float* red = (LAS float*)F.lds;
    __syncthreads();
    if (kh == 1) {
#pragma unroll
        for (int r = 0; r < 16; ++r) red[(cb * 16 + r) * 64 + lane] = acc[r]; }
    __syncthreads();
    if (kh == 0) {
#pragma unroll
        for (int r = 0; r < 16; ++r) { const float v = acc[r] + red[(cb * 16 + r) * 64 + lane];
            dS[((size_t)g * 256 + rb * 32 + mx::crow(r, hi)) * 128 + cb * 32 + c32] = v; } }
}
__device__ __forceinline__ void s5_step3_item(Frame& F, int l, int g, int rb, const bf16* u16, const float* dS, bf16* yg16) {
    const int lane = F.lane, w = F.wave, c32 = lane & 31, hi = lane >> 5;
    LAS unsigned char* Ul = F.lds;
    LAS unsigned char* Kl = F.lds + 32 * 2064;
    __syncthreads();
    for (int i = F.tid; i < 32 * 128; i += NTHR) {
        const int ch = i & 1, s = (i >> 1) & 63, r = i >> 7; const int R = rb * 32 + r, b = R >> 6, n = R & 63;
        *(LAS v4u*)(Ul + r * 2064 + s * 32 + ch * 16) = *(const v4u*)(u16 + ((size_t)b * SEQ + n * 64 + s) * 512 + g * 16 + ch * 8); }
    { const v4u* kt = (const v4u*)(F.ws + WS_S5T + (size_t)(l * 32 + g) * S5T_SIZE + S5T_KT);
      for (int i = F.tid; i < 65 * 32; i += NTHR) *(LAS v4u*)(Kl + i * 16) = kt[i]; }
    LAS unsigned char* Hl = Kl + 65 * 512;
    if (F.tid < 64) {
        const int p = F.tid, bq = rb >> 1, n0 = (rb & 1) * 32;
        const float* l64 = (const float*)(F.ws + WS_S5T + (size_t)(l * 32 + g) * S5T_SIZE + S5T_L64);
        const float lr = l64[p], li = l64[64 + p];
        const float* dp = dS + ((size_t)g * 256 + bq * 64) * 128 + p;
        float hr = 0.f, hi2 = 0.f;
        for (int nb = 0; nb < n0 + 32; nb += 16) {
            float dr[16], di[16];
#pragma unroll
            for (int j = 0; j < 16; ++j) { dr[j] = dp[(size_t)(nb + j) * 128]; di[j] = dp[(size_t)(nb + j) * 128 + 64]; }
#pragma unroll
            for (int j = 0; j < 16; ++j) { const int n = nb + j;
                if (n >= n0) { *(LAS bf16*)(Hl + (n - n0) * 272 + p * 2) = (bf16)f2bf(hr); *(LAS bf16*)(Hl + (n - n0) * 272 + 128 + p * 2) = (bf16)f2bf(hi2); }
                const float nr = lr * hr - li * hi2 + dr[j], ni = lr * hi2 + li * hr + di[j]; hr = nr; hi2 = ni; }
        }
    }
    __syncthreads();
    const bf16* wo = (const bf16*)(F.ws + WS_S5T + (size_t)(l * 32 + g) * S5T_SIZE + S5T_WOUT);
    mx::bf16x8 hf[8];
#pragma unroll
    for (int ks = 0; ks < 8; ++ks) hf[ks] = *(const LAS mx::bf16x8*)(Hl + c32 * 272 + ks * 32 + hi * 16);
    const float* Dv = INF(I_S5D) + l * 512 + g * 16;
#pragma unroll 1
    for (int jj = 0; jj < 4; ++jj) {
        const int j = (jj == 0) ? w : (jj == 1) ? 15 - w : (jj == 2) ? 16 + w : 31 - w;
        const int tcol = 2 * j + (c32 >> 4), ccol = c32 & 15;
        mx::f32x16 acc = {};
#pragma unroll
        for (int ks = 0; ks < 8; ++ks) { const mx::bf16x8 bb = *(const mx::bf16x8*)(wo + (size_t)(j * 32 + c32) * 128 + ks * 16 + 8 * hi); acc = MX_MFMA(bb, hf[ks], acc); }
        const LAS unsigned char* ab = Ul + c32 * 2064 + hi * 16;
        const LAS unsigned char* kb = Kl + (tcol + 1) * 512 + ccol * 32 + hi * 16;
        { mx::bf16x8 a = *(const LAS mx::bf16x8*)ab, bb = *(const LAS mx::bf16x8*)kb;
          const int ns = 2 * j + 2;
          for (int s = 0; s < ns; ++s) {
              const int sn = s + 1 < ns ? s + 1 : s;
              const mx::bf16x8 an = *(const LAS mx::bf16x8*)(ab + sn * 32), bn = *(const LAS mx::bf16x8*)(kb - sn * 512);
              acc = MX_MFMA(bb, a, acc); a = an; bb = bn; } }
        { const int Rr = rb * 32 + c32, b = Rr >> 6, nch = Rr & 63; const size_t tok0 = (size_t)b * SEQ + nch * 64 + 2 * j;
#pragma unroll
          for (int tk = 0; tk < 2; ++tk) {
              const bf16* up = u16 + (tok0 + tk) * 512 + g * 16 + 4 * hi; const float* dp = Dv + 4 * hi;
              unsigned pkx[2], pky[2];
#pragma unroll
              for (int kk = 0; kk < 2; ++kk) { const int k = 2 * tk + kk; const v2u uw = *(const v2u*)(up + 8 * kk); const f32x4 dv4 = *(const f32x4*)(dp + 8 * kk);
                  const float u0 = bf2f((unsigned short)uw.x), u1 = bf2f((unsigned short)(uw.x >> 16)), u2 = bf2f((unsigned short)uw.y), u3 = bf2f((unsigned short)(uw.y >> 16));
                  pkx[kk] = mx::cvtpk(gelu_tanh(acc[4 * k] + dv4[0] * u0), gelu_tanh(acc[4 * k + 1] + dv4[1] * u1));
                  pky[kk] = mx::cvtpk(gelu_tanh(acc[4 * k + 2] + dv4[2] * u2), gelu_tanh(acc[4 * k + 3] + dv4[3] * u3)); }
              auto rx = __builtin_amdgcn_permlane32_swap(pkx[0], pkx[1], false, false); auto ry = __builtin_amdgcn_permlane32_swap(pky[0], pky[1], false, false);
              *(v4u*)(yg16 + (tok0 + tk) * 512 + g * 16 + 8 * hi) = (v4u){rx[0], ry[0], rx[1], ry[1]}; } }
    }
}

__device__ __forceinline__ void hg_gate_loads(int h, const float* logf, size_t row0, int k, int seg, float (&g)[16]) {
#pragma unroll
    for (int j = 0; j < 16; ++j) g[j] = logf[(row0 + seg * 16 + j) * 512 + h * 128 + k];
}
__device__ __forceinline__ void hg_gate_scan(Frame& F, int k, int seg, const float (&g)[16], float (&bcum)[16], float (&kk)[16], float& bmid, float& blast) {
    LAS float* tot = (LAS float*)(F.lds + 120 * 1024);
    float run = 0.f;
#pragma unroll
    for (int j = 0; j < 16; ++j) { kk[j] = 1.f - __expf(g[j]); run += g[j]; bcum[j] = run; }
    tot[seg * 128 + k] = run;
    __syncthreads();
    float pre = 0.f;
    for (int s2 = 0; s2 < seg; ++s2) pre += tot[s2 * 128 + k];
#pragma unroll
    for (int j = 0; j < 16; ++j) bcum[j] += pre;
    if (seg == 1) tot[512 + k] = bcum[15];
    if (seg == 3) tot[640 + k] = bcum[15];
    __syncthreads();
    bmid = tot[512 + k]; blast = tot[640 + k];
}
__device__ __forceinline__ void hg_step1_item(Frame& F, int chunk  , const float* logf, const bf16* hv, bf16* dST, float* blastg) {
    const int bh = chunk >> 6, n = chunk & 63, b = bh >> 2, h = bh & 3;
    const size_t row0 = (size_t)b * SEQ + n * 64;
    const int k = F.tid & 127, seg = F.tid >> 7;
    LAS unsigned char* klT = F.lds;
    LAS unsigned char* vT = F.lds + 128 * 144;
    __syncthreads();
    float g[16], bc[16], kk[16], bmid, blast; bf16 vraw[16];
    hg_gate_loads(h, logf, row0, k, seg, g);
#pragma unroll
    for (int j = 0; j < 16; ++j) vraw[j] = hv[(row0 + seg * 16 + j) * 512 + h * 128 + k];
    hg_gate_scan(F, k, seg, g, bc, kk, bmid, blast);
    float tmp[16];
#pragma unroll
    for (int j = 0; j < 16; ++j) tmp[j] = kk[j] * __expf(blast - bc[j]);
    *(LAS mx::bf16x8*)(klT + k * 144 + seg * 32) = mx::pack8f(tmp); *(LAS mx::bf16x8*)(klT + k * 144 + seg * 32 + 16) = mx::pack8f(tmp + 8);
#pragma unroll
    for (int j = 0; j < 16; ++j) *(LAS bf16*)(vT + k * 144 + (seg * 16 + j) * 2) = vraw[j];
    if (seg == 0) blastg[(size_t)chunk * 128 + k] = blast;
    __syncthreads();
    const int lane = F.lane, w = F.wave, c32 = lane & 31, hi = lane >> 5, vb = w & 3, kb2 = w >> 2;
    mx::f32x16 a0 = {}, a1 = {};
#pragma unroll
    for (int ks = 0; ks < 4; ++ks) {
        const mx::bf16x8 av = *(const LAS mx::bf16x8*)(vT + (vb * 32 + c32) * 144 + ks * 32 + hi * 16);
        const mx::bf16x8 b0 = *(const LAS mx::bf16x8*)(klT + (kb2 * 64 + c32) * 144 + ks * 32 + hi * 16);
        const mx::bf16x8 b1 = *(const LAS mx::bf16x8*)(klT + (kb2 * 64 + 32 + c32) * 144 + ks * 32 + hi * 16);
        a0 = MX_MFMA(b0, av, a0); a1 = MX_MFMA(b1, av, a1);
    }
    bf16* dst = dST + (size_t)chunk * 16384 + (size_t)(vb * 32 + c32) * 128 + kb2 * 64 + 8 * hi;
#pragma unroll
    for (int q = 0; q < 4; q += 2) {
        { const unsigned ax = mx::cvtpk(a0[4 * q], a0[4 * q + 1]), ay = mx::cvtpk(a0[4 * q + 2], a0[4 * q + 3]), bx = mx::cvtpk(a0[4 * q + 4], a0[4 * q + 5]), by = mx::cvtpk(a0[4 * q + 6], a0[4 * q + 7]);
          auto rx = __builtin_amdgcn_permlane32_swap(ax, bx, false, false); auto ry = __builtin_amdgcn_permlane32_swap(ay, by, false, false);
          *(v4u*)(dst + 8 * q) = (v4u){rx[0], ry[0], rx[1], ry[1]}; }
        { const unsigned ax = mx::cvtpk(a1[4 * q], a1[4 * q + 1]), ay = mx::cvtpk(a1[4 * q + 2], a1[4 * q + 3]), bx = mx::cvtpk(a1[4 * q + 4], a1[4 * q + 5]), by = mx::cvtpk(a1[4 * q + 6], a1[4 * q + 7]);
          auto rx = __builtin_amdgcn_permlane32_swap(ax, bx, false, false); auto ry = __builtin_amdgcn_permlane32_swap(ay, by, false, false);
          *(v4u*)(dst + 32 + 8 * q) = (v4u){rx[0], ry[0], rx[1], ry[1]}; }
    }
}
__device__ __forceinline__ void hg_step2(Frame& F, const bf16* dST, const float* blastg, bf16* SpT) {
    typedef float f32x2 __attribute__((ext_vector_type(2)));
    const int gt = F.bid * NTHR + F.tid, NGT = F.G * NTHR;
    for (int i = gt; i < 16 * 8192; i += NGT) {
        const int k2 = (i & 63) * 2, bh = i >> 13, vk = (i & 8191) * 2;
        f32x2 S = (f32x2){0.f, 0.f};
        unsigned dA[16], dB[16]; f32x2 blA[16], blB[16];
#define H2_LOAD(d, bl, n0) do { _Pragma("unroll") for (int j = 0; j < 16; ++j) { const size_t ch = (size_t)bh * 64 + (n0) + j; d[j] = *(const unsigned*)(dST + ch * 16384 + vk); bl[j] = *(const f32x2*)(blastg + ch * 128 + k2); } } while (0)
#define H2_PROC(d, bl, n0) do { _Pragma("unroll") for (int j = 0; j < 16; ++j) { const size_t ch = (size_t)bh * 64 + (n0) + j; \
            *(unsigned*)(SpT + ch * 16384 + vk) = pk2(S.x, S.y); \
            S.x = __expf(bl[j].x) * S.x + bf2f((unsigned short)d[j]); S.y = __expf(bl[j].y) * S.y + bf2f((unsigned short)(d[j] >> 16)); } } while (0)
        H2_LOAD(dA, blA, 0); H2_LOAD(dB, blB, 16);
        H2_PROC(dA, blA, 0); H2_LOAD(dA, blA, 32);
        H2_PROC(dB, blB, 16); H2_LOAD(dB, blB, 48);
        H2_PROC(dA, blA, 32); H2_PROC(dB, blB, 48);
#undef H2_LOAD
#undef H2_PROC
    }
}
__device__ __forceinline__ void hg_step3_item(Frame& F, int l, int chunk, const float* logf, const bf16* hq, const bf16* hv, const bf16* hgt, const bf16* SpT, bf16* cat) {
    const int bh = chunk >> 6, n = chunk & 63, b = bh >> 2, h = bh & 3;
    const size_t row0 = (size_t)b * SEQ + n * 64;
    const int k = F.tid & 127, seg = F.tid >> 7;
    LAS unsigned char* qm = F.lds;
    LAS unsigned char* km = qm + 64 * 272;
    LAS unsigned char* vT = km + 64 * 272;
    LAS unsigned char* sp = vT + 128 * 144;
    LAS float* ot = (LAS float*)(sp + 128 * 272);
    LAS float* tot = (LAS float*)(F.lds + 120 * 1024);
    __syncthreads();
    float g[16], bc[16], kk[16], bmid, blast; bf16 qraw[16], vraw[16]; v4u spraw[4];
    hg_gate_loads(h, logf, row0, k, seg, g);
#pragma unroll
    for (int j = 0; j < 16; ++j) { qraw[j] = hq[(row0 + seg * 16 + j) * 512 + h * 128 + k]; vraw[j] = hv[(row0 + seg * 16 + j) * 512 + h * 128 + k]; }
    { const bf16* src = SpT + (size_t)chunk * 16384 + (F.tid >> 2) * 128 + (F.tid & 3) * 32;
#pragma unroll
      for (int q4 = 0; q4 < 4; ++q4) spraw[q4] = *(const v4u*)(src + q4 * 8); }
    hg_gate_scan(F, k, seg, g, bc, kk, bmid, blast);
#pragma unroll
    for (int j = 0; j < 16; ++j) { const int t = seg * 16 + j; const float qv = bf2f(qraw[j]);
        *(LAS bf16*)(qm + t * 272 + k * 2) = (bf16)f2bf(qv * __expf(bc[j] - bmid));
        *(LAS bf16*)(km + t * 272 + k * 2) = (bf16)f2bf(kk[j] * __expf(bmid - bc[j])); }
#pragma unroll
    for (int j = 0; j < 16; ++j) *(LAS bf16*)(vT + k * 144 + (seg * 16 + j) * 2) = vraw[j];
    {
      const int v = F.tid >> 2, k0 = (F.tid & 3) * 32;
#pragma unroll
      for (int q4 = 0; q4 < 4; ++q4) { const v4u raw = spraw[q4]; const unsigned rw[4] = {raw.x, raw.y, raw.z, raw.w}; float tmp[8];
#pragma unroll
          for (int e = 0; e < 8; ++e) tmp[e] = bf2f((unsigned short)(rw[e >> 1] >> ((e & 1) * 16))) * __expf(tot[512 + k0 + q4 * 8 + e]);
          *(LAS mx::bf16x8*)(sp + v * 272 + (k0 + q4 * 8) * 2) = mx::pack8f(tmp); } }
    __syncthreads();
    const int lane = F.lane, w = F.wave, c32 = lane & 31, hi = lane >> 5, tb = w & 1, vb = w >> 1;
    mx::f32x16 o = {};
#pragma unroll
    for (int ks = 0; ks < 8; ++ks) {
        const mx::bf16x8 a = *(const LAS mx::bf16x8*)(qm + (tb * 32 + c32) * 272 + ks * 32 + hi * 16);
        const mx::bf16x8 bb = *(const LAS mx::bf16x8*)(sp + (vb * 32 + c32) * 272 + ks * 32 + hi * 16);
        o = MX_MFMA(a, bb, o);
    }
    for (int sb = 0; sb <= tb; ++sb) {
        mx::f32x16 p = {};
#pragma unroll
        for (int ks = 0; ks < 8; ++ks) {
            const mx::bf16x8 a = *(const LAS mx::bf16x8*)(km + (sb * 32 + c32) * 272 + ks * 32 + hi * 16);
            const mx::bf16x8 bb = *(const LAS mx::bf16x8*)(qm + (tb * 32 + c32) * 272 + ks * 32 + hi * 16);
            p = MX_MFMA(a, bb, p);
        }
        if (sb == tb) {
#pragma unroll
            for (int r = 0; r < 16; ++r) if (mx::crow(r, hi) > c32) p[r] = 0.f; }
        mx::bf16x8 plo, phi; mx::acc_to_A(p, plo, phi);
        const mx::bf16x8 v0 = *(const LAS mx::bf16x8*)(vT + (vb * 32 + c32) * 144 + sb * 64 + hi * 16);
        const mx::bf16x8 v1 = *(const LAS mx::bf16x8*)(vT + (vb * 32 + c32) * 144 + sb * 64 + 32 + hi * 16);
        o = MX_MFMA(plo, v0, o); o = MX_MFMA(phi, v1, o);
    }
#pragma unroll
    for (int r = 0; r < 16; ++r) ot[(tb * 32 + mx::crow(r, hi)) * 132 + vb * 32 + c32] = o[r];
    __syncthreads();
    { const int t = F.tid >> 3, cg = F.tid & 7; float vals[16]; float ss = 0.f;
#pragma unroll
      for (int e = 0; e < 16; ++e) { vals[e] = ot[t * 132 + cg * 16 + e]; ss += vals[e] * vals[e]; }
      ss += __shfl_xor(ss, 1); ss += __shfl_xor(ss, 2); ss += __shfl_xor(ss, 4);
      const float r = 1.f / sqrtf(ss * (1.f / 128.f) + EPS);
      const bf16* gp = hgt + (row0 + t) * 512 + h * 128 + cg * 16; const float* gn = INF(I_HGN) + l * 128 + cg * 16;
      const v4u gw0 = *(const v4u*)gp, gw1 = *(const v4u*)(gp + 8); const unsigned gw[8] = {gw0.x, gw0.y, gw0.z, gw0.w, gw1.x, gw1.y, gw1.z, gw1.w};
#pragma unroll
      for (int e = 0; e < 16; ++e) vals[e] = vals[e] * r * gn[e] * bf2f((unsigned short)(gw[e >> 1] >> ((e & 1) * 16)));
      bf16* op = cat + (row0 + t) * DM + 1536 + h * 128 + cg * 16;
      *(mx::bf16x8*)op = mx::pack8f(vals); *(mx::bf16x8*)(op + 8) = mx::pack8f(vals + 8); }
}

__device__ __forceinline__ void phase_pre0(Frame& F) {
    LAS float* scr = (LAS float*)(F.lds + F.wave * 16640);
    const int gw = F.bid * NWAVES + F.wave, NGW = F.G * NWAVES;
    constexpr int IT_IN = 32 * (DINP / 64), IT_UQ = 8 * 24, IT_UKV = 4 * 32, IT_GLU = 8 * 8, IT_OUT = 32 * 32, IT_UP = 32 * (DFF2 / 64), IT_DN = (DFF / 64) * 32;
    constexpr int IT_L = IT_IN + IT_UQ + IT_UKV + IT_GLU + IT_OUT + IT_UP + IT_DN;
    for (int it = gw; it < NL * IT_L; it += NGW) {
        const int l = it / IT_L; int r = it % IT_L; const int ln = F.lane;
        if (r < IT_IN) { const int nb = r % (DINP / 64), kb = r / (DINP / 64); tr_item(INF(I_WIN) + (size_t)l * DM * DIN, DIN, DM, kb * 64, win_srccol(nb * 64 + ln), nullptr, wt(F, l, WL_IN) + (size_t)nb * 64 * DM, scr, ln); continue; } r -= IT_IN;
        if (r < IT_UQ) { const int nb = r % 24, kb = r / 24; tr_item(INF(I_WUQ) + (size_t)l * 512 * 1536, 1536, 512, kb * 64, uq_srccol(nb * 64 + ln), INF(I_QN) + l * 512, wt(F, l, WL_UQ) + (size_t)nb * 64 * 512, scr, ln); continue; } r -= IT_UQ;
        if (r < IT_UKV) { const int nb = r % 32, kb = r / 32; tr_item(INF(I_WUKV) + (size_t)l * 256 * 2048, 2048, 256, kb * 64, nb * 64 + ln, INF(I_KVN) + l * 256, wt(F, l, WL_UKV) + (size_t)nb * 64 * 256, scr, ln); continue; } r -= IT_UKV;
        if (r < IT_GLU) { const int nb = r % 8, kb = r / 8; tr_item(INF(I_WGLU) + (size_t)l * 512 * 512, 512, 512, kb * 64, nb * 64 + ln, nullptr, wt(F, l, WL_GLU) + (size_t)nb * 64 * 512, scr, ln); continue; } r -= IT_GLU;
        if (r < IT_OUT) { const int nb = r % 32, kb = r / 32; tr_item(INF(I_WOUT) + (size_t)l * DM * DM, DM, DM, kb * 64, nb * 64 + ln, nullptr, wt(F, l, WL_OUT) + (size_t)nb * 64 * DM, scr, ln); continue; } r -= IT_OUT;
        if (r < IT_UP) { const int nb = r % (DFF2 / 64), kb = r / (DFF2 / 64);
            tr_item(INF(I_WUP) + (size_t)l * DM * DFF2, DFF2, DM, kb * 64, ((nb & 3) < 2 ? (nb >> 2) * 128 + (nb & 3) * 64 : DFF + (nb >> 2) * 128 + ((nb & 3) - 2) * 64) + ln, nullptr, wt(F, l, WL_UP) + (size_t)nb * 64 * DM, scr, ln); continue; } r -= IT_UP;
        { const int nb = r % 32, kb = r / 32; tr_item(INF(I_WDN) + (size_t)l * DFF * DM, DM, DFF, kb * 64, nb * 64 + ln, nullptr, wt(F, l, WL_DN) + (size_t)nb * 64 * DFF, scr, ln); }
    }
    const float* c = INF(I_C);
    for (int it = gw; it < NL * 16 * 48; it += NGW) {
        const int jc = it % 48, kc = (it / 48) % 16, l = it / (48 * 16);
        const int j = jc * 256 + F.lane * 4;
        const float* w = INF(I_WADA) + ((size_t)l * DM + kc * 128) * 12288 + j;
#pragma unroll
        for (int q = 0; q < 8; ++q) { const int idx = q * 64 + F.lane, b = idx >> 7, k = idx & 127; const float cv = c[b * DM + kc * 128 + k]; scr[idx] = cv / (1.f + __expf(-cv)); }
        LDS_WAIT(); asm volatile("" ::: "memory");
        f32x4 acc[NB];
#pragma unroll
        for (int b = 0; b < NB; ++b) acc[b] = (f32x4){0.f, 0.f, 0.f, 0.f};
#pragma unroll 16
        for (int k = 0; k < 128; ++k) {
            const f32x4 wv = *(const f32x4*)(w + (size_t)k * 12288);
#pragma unroll
            for (int b = 0; b < NB; ++b) acc[b] += wv * scr[b * 128 + k];
        }
        float* mp = (float*)(F.ws + WS_MODP);
#pragma unroll
        for (int b = 0; b < NB; ++b) *(f32x4*)(mp + (((size_t)l * 16 + kc) * NB + b) * 12288 + j) = acc[b];
        LDS_WAIT(); asm volatile("" ::: "memory");
    }
    const int gt = F.bid * NTHR + F.tid, NGT = F.G * NTHR;
    const int* pos = (const int*)ldp(F, I_POS);
    for (int i = gt; i < M * 32; i += NGT) {
        const int tok = i >> 5, fi = i & 31;
        const float inv = exp2f(-(float)fi * 0.41524101186092033f);
        const float ang = (float)pos[tok] * inv; float sn, cs; sincosf(ang, &sn, &cs);
        ((float*)(F.ws + WS_COS))[i] = cs; ((float*)(F.ws + WS_SIN))[i] = sn;
    }
    s5_tables_a(F);
    for (int j = gt; j < 512; j += NGT) {
        float lg[NL], mx = -1e30f;
#pragma unroll
        for (int l = 0; l < NL; ++l) { lg[l] = INF(I_LB)[l * 512 + j]; mx = fmaxf(mx, lg[l]); }
        float s = 0.f;
#pragma unroll
        for (int l = 0; l < NL; ++l) { lg[l] = expf(lg[l] - mx); s += lg[l]; }
        float cum = 0.f;
#pragma unroll
        for (int l = 0; l < NL; ++l) { if (l > 0) cum += lg[l] / s; ((float*)(F.ws + WS_LB))[l * 512 + j] = cum; }
    }
}
__device__ __forceinline__ void phase_pre1(Frame& F) {
    const int gt = F.bid * NTHR + F.tid, NGT = F.G * NTHR;
    const float* mp = (const float*)(F.ws + WS_MODP); float* mod = (float*)(F.ws + WS_MOD);
    for (int i = gt; i < NL * NB * 12288; i += NGT) {
        const int j = i % 12288, b = (i / 12288) % NB, l = i / (12288 * NB);
        float s = INF(I_BADA)[l * 12288 + j];
        for (int kc = 0; kc < 16; ++kc) s += mp[(((size_t)l * 16 + kc) * NB + b) * 12288 + j];
        mod[i] = s;
    }
}
__device__ __forceinline__ float bflo(unsigned u) { return __builtin_bit_cast(float, u << 16); }
__device__ __forceinline__ float bfhi(unsigned u) { return __builtin_bit_cast(float, u & 0xffff0000u); }
__device__ __forceinline__ void phase_resnorm(Frame& F, const float* xin32, const bf16* xin16, const bf16* y, const float* gpost, const float* gate  ,
                                              bf16* xout16, float* xout32, const float* gpre, const float* sc, const float* sh, bf16* hout) {
    const int gw = F.bid * NWAVES + F.wave, NGW = F.G * NWAVES, RW = (M + NGW - 1) / NGW;
    int curb = -1; f32x4 pa[8], pg[8], ps[8];
    const int rend = (gw * RW + RW) < M ? (gw * RW + RW) : M;
    for (int row = gw * RW; row < rend; ++row) {
        const int b = row / SEQ;
        if (b != curb) { curb = b;
#pragma unroll
            for (int j = 0; j < 8; ++j) { const int ci = 128 * (j >> 1) + 2 * F.lane + (j & 1);
                if (y) pa[j] = ((const f32x4*)gpost)[ci] * ((const f32x4*)(gate + (size_t)b * 12288))[ci];
                if (hout) { pg[j] = ((const f32x4*)gpre)[ci] * (((const f32x4*)(sc + (size_t)b * 12288))[ci] + 1.f); ps[j] = ((const f32x4*)(sh + (size_t)b * 12288))[ci]; } } }
        f32x4 v[8];
        if (xin32) { const f32x4* xr = (const f32x4*)(xin32 + (size_t)row * DM) + 2 * F.lane;
#pragma unroll
            for (int j = 0; j < 4; ++j) { v[2 * j] = xr[128 * j]; v[2 * j + 1] = xr[128 * j + 1]; }
        } else { const v4u* xr = (const v4u*)(xin16 + (size_t)row * DM) + F.lane;
#pragma unroll
            for (int j = 0; j < 4; ++j) { const v4u w = xr[64 * j]; v[2 * j] = (f32x4){bflo(w.x), bfhi(w.x), bflo(w.y), bfhi(w.y)}; v[2 * j + 1] = (f32x4){bflo(w.z), bfhi(w.z), bflo(w.w), bfhi(w.w)}; }
        }
        if (y) {
            f32x4 yv[8]; float ss = 0.f;
            const v4u* yr = (const v4u*)(y + (size_t)row * DM) + F.lane;
#pragma unroll
            for (int j = 0; j < 4; ++j) { const v4u w = yr[64 * j]; yv[2 * j] = (f32x4){bflo(w.x), bfhi(w.x), bflo(w.y), bfhi(w.y)}; yv[2 * j + 1] = (f32x4){bflo(w.z), bfhi(w.z), bflo(w.w), bfhi(w.w)}; }
#pragma unroll
            for (int j = 0; j < 8; ++j) ss += (yv[j].x * yv[j].x + yv[j].y * yv[j].y) + (yv[j].z * yv[j].z + yv[j].w * yv[j].w);
            const float r = 1.f / sqrtf(wave_sum(ss) * (1.f / DM) + EPS);
#pragma unroll
            for (int j = 0; j < 8; ++j) v[j] += pa[j] * (yv[j] * r);
            if (xout16) { v4u* xo = (v4u*)(xout16 + (size_t)row * DM) + F.lane;
#pragma unroll
                for (int j = 0; j < 4; ++j) xo[64 * j] = (v4u){pk2(v[2 * j].x, v[2 * j].y), pk2(v[2 * j].z, v[2 * j].w), pk2(v[2 * j + 1].x, v[2 * j + 1].y), pk2(v[2 * j + 1].z, v[2 * j + 1].w)};
            } else { f32x4* xo = (f32x4*)(xout32 + (size_t)row * DM) + 2 * F.lane;
#pragma unroll
                for (int j = 0; j < 4; ++j) { xo[128 * j] = v[2 * j]; xo[128 * j + 1] = v[2 * j + 1]; }
            }
        }
        if (hout) {
            float ss = 0.f;
#pragma unroll
            for (int j = 0; j < 8; ++j) ss += (v[j].x * v[j].x + v[j].y * v[j].y) + (v[j].z * v[j].z + v[j].w * v[j].w);
            const float r = 1.f / sqrtf(wave_sum(ss) * (1.f / DM) + EPS);
            v4u* ho = (v4u*)(hout + (size_t)row * DM) + F.lane;
#pragma unroll
            for (int j = 0; j < 4; ++j) { const f32x4 h0 = v[2 * j] * r * pg[2 * j] + ps[2 * j], h1 = v[2 * j + 1] * r * pg[2 * j + 1] + ps[2 * j + 1];
                ho[64 * j] = (v4u){pk2(h0.x, h0.y), pk2(h0.z, h0.w), pk2(h1.x, h1.y), pk2(h1.z, h1.w)}; }
        }
    }
}

__device__ __forceinline__ void phase_mix1(Frame& F, int l) {
    for (int it = F.bid; it < 256; it += F.G) s5_step1_item(F, l, it >> 3, it & 7, (const bf16*)(F.ws + WS_U16), (float*)(F.ws + WS_DS5));
    for (int it = F.bid; it < 1024; it += F.G) hg_step1_item(F, it, (const float*)(F.ws + WS_LOGF), (const bf16*)(F.ws + WS_HV), (bf16*)(F.ws + WS_DST), (float*)(F.ws + WS_BLAST));
}
__device__ __forceinline__ void phase_s5out(Frame& F, int l) {
    for (int it = F.bid; it < 256; it += F.G) s5_step3_item(F, l, it >> 3, it & 7, (const bf16*)(F.ws + WS_U16), (const float*)(F.ws + WS_DS5), (bf16*)(F.ws + WS_YG16));
}
__device__ __forceinline__ void phase_hgout(Frame& F, int l) {
    for (int it = F.bid; it < 1024; it += F.G) hg_step3_item(F, l, it, (const float*)(F.ws + WS_LOGF), (const bf16*)(F.ws + WS_HQ), (const bf16*)(F.ws + WS_HV), (const bf16*)(F.ws + WS_HGT), (const bf16*)(F.ws + WS_SPT), (bf16*)(F.ws + WS_CAT));
}
__device__ __forceinline__ void phase_attn(Frame& F) {
    const bf16* qo = (const bf16*)(F.ws + WS_ACT); const bf16* ko = (const bf16*)(F.ws + WS_ACT + 48 * MiB); const bf16* vo = (const bf16*)(F.ws + WS_ACT + 96 * MiB);
    bf16* cat = (bf16*)(F.ws + WS_CAT);
    const int vcu = (F.G % 8 == 0) ? (F.bid % 8) * (F.G / 8) + F.bid / 8 : F.bid;
    for (int it = vcu; it < NB * NH * 8; it += F.G) {
        const int bh = it >> 3, x = it & 7, b = bh / NH, h = bh % NH;
        for (int pass = 0; pass < 2; ++pass)
            att::attn_block(qo + (size_t)bh * SEQ * DQK, ko + (size_t)bh * SEQ * DQK, vo + (size_t)bh * SEQ * 128, cat + (size_t)b * SEQ * DM + 512 + h * 128, DM, pass ? x : 15 - x, F.lds);
    }
}
__device__ __forceinline__ void fixup_panel(Frame& F, int l, int pm) {
    const float* halo = (const float*)(F.ws + WS_HALO); bf16* act = (bf16*)(F.ws + WS_ACT);
    const float* cw = INF(I_CW) + (size_t)l * 3 * DFF2; const float* cb = INF(I_CB) + (size_t)l * DFF2;
    for (int c = F.tid * 4; c < DFF; c += NTHR * 4) {
        const f32x4 wg0 = *(const f32x4*)(cw + c), wg1 = *(const f32x4*)(cw + DFF2 + c), wg2 = *(const f32x4*)(cw + 2 * DFF2 + c), bg = *(const f32x4*)(cb + c);
        const f32x4 wv0 = *(const f32x4*)(cw + DFF + c), wv1 = *(const f32x4*)(cw + DFF2 + DFF + c), wv2 = *(const f32x4*)(cw + 2 * DFF2 + DFF + c), bv = *(const f32x4*)(cb + DFF + c);
        f32x4 hg[2][4], hv[2][4];
#pragma unroll
        for (int q = 0; q < 2; ++q) { const int blk = pm * 2 + q; const bool first = ((blk * 128) & (SEQ - 1)) == 0; const int pb = first ? blk : blk - 1;
            const float* r0 = halo + (size_t)(blk * 4) * DFF2 + c; const float* rp = halo + (size_t)(pb * 4 + 2) * DFF2 + c;
            hg[q][0] = *(const f32x4*)r0; hv[q][0] = *(const f32x4*)(r0 + DFF); hg[q][1] = *(const f32x4*)(r0 + DFF2); hv[q][1] = *(const f32x4*)(r0 + DFF2 + DFF);
            hg[q][2] = *(const f32x4*)rp; hv[q][2] = *(const f32x4*)(rp + DFF); hg[q][3] = *(const f32x4*)(rp + DFF2); hv[q][3] = *(const f32x4*)(rp + DFF2 + DFF); }
#pragma unroll
        for (int q = 0; q < 2; ++q) { const int blk = pm * 2 + q; const bool first = ((blk * 128) & (SEQ - 1)) == 0;
            const f32x4 z4 = (f32x4){0.f, 0.f, 0.f, 0.f};
            const f32x4 gm1 = first ? z4 : hg[q][3], gm2 = first ? z4 : hg[q][2], vm1 = first ? z4 : hv[q][3], vm2 = first ? z4 : hv[q][2];
            { const f32x4 cg = bg + wg0 * gm2 + wg1 * gm1 + wg2 * hg[q][0], cv = bv + wv0 * vm2 + wv1 * vm1 + wv2 * hv[q][0];
              *(v2u*)(act + (size_t)(blk * 128) * DFF + c) = (v2u){pk2(gelu_tanh(cg.x) * cv.x, gelu_tanh(cg.y) * cv.y), pk2(gelu_tanh(cg.z) * cv.z, gelu_tanh(cg.w) * cv.w)}; }
            { const f32x4 cg = bg + wg0 * gm1 + wg1 * hg[q][0] + wg2 * hg[q][1], cv = bv + wv0 * vm1 + wv1 * hv[q][0] + wv2 * hv[q][1];
              *(v2u*)(act + (size_t)(blk * 128 + 1) * DFF + c) = (v2u){pk2(gelu_tanh(cg.x) * cv.x, gelu_tanh(cg.y) * cv.y), pk2(gelu_tanh(cg.z) * cv.z, gelu_tanh(cg.w) * cv.w)}; }
        }
    }
}

constexpr int PH_PER_LAYER = 10, PH_LAYER0 = 2, PH_FINAL = PH_LAYER0 + NL * PH_PER_LAYER, N_PHASES = PH_FINAL + 1;
__global__ void __launch_bounds__(NTHR, 2) skel_fwd(Args args) {
    extern __shared__ __attribute__((aligned(16))) unsigned char lds[];
    Frame F;
    F.lds = (LAS unsigned char*)lds; F.ldsg = lds;
    F.tid = threadIdx.x; F.lane = F.tid & 63; F.wave = __builtin_amdgcn_readfirstlane(F.tid >> 6);
    F.G = gridDim.x; F.bid = blockIdx.x; F.ws = args.ws; F.in = nullptr;
    const int lo = args.ph_lo, hi = args.ph_hi;
    for (int u = F.tid; u < (LDS_BYTES - CTRL_OFF) / 4; u += NTHR) ((LAS unsigned*)(F.lds + CTRL_OFF))[u] = 0u;
    if (F.tid == 0) { LAS unsigned long long* pt = (LAS unsigned long long*)(F.lds + PTAB_OFF);
#pragma unroll
        for (int i = 0; i < N_IN; ++i) pt[i] = (unsigned long long)args.in[i];
        pt[N_IN] = (unsigned long long)args.ws; }
    __syncthreads();
    XcdBarrier bar; bar.bar = (unsigned*)(F.ws + WS_CTL) + CW_BAR; bar.x = 0; bar.st = nullptr;
    if (hi - lo > 1) bar = xcd_barrier_post((unsigned*)(F.ws + WS_CTL) + CW_BAR, (volatile LAS unsigned*)(F.lds + MISC_OFF) + 8);
#define SEAM(k) do { if (IN(k) && IN((k) + 1)) xcd_barrier(bar); } while (0)
#define IN(k) (lo <= (k) && (k) < hi)
#define REFRESH() do { int t_ = threadIdx.x; asm volatile("" : "+v"(t_)); F.tid = t_; F.lane = t_ & 63; F.wave = __builtin_amdgcn_readfirstlane(t_ >> 6); \
    F.ws = (unsigned char*)ldp(F, N_IN); } while (0)
    if (IN(0)) phase_pre0(F);
    SEAM(0);
    if (IN(1)) { phase_pre1(F); if (F.G != 256) for (int l = 0; l < NL; ++l) s5_tables_b(F, l, F.bid * NTHR + F.tid, F.G * NTHR); }
    SEAM(1);
#define mod ((const float*)(F.ws + WS_MOD))
#define X ((bf16*)(F.ws + WS_X))
#define H ((bf16*)(F.ws + WS_H))
#define T2f ((const bf16*)(F.ws + WS_T2))
#define modl (mod + (size_t)l * NB * 12288)
    for (int l = 0; l < NL; ++l) {
        const int base = PH_LAYER0 + l * PH_PER_LAYER;
        if (IN(base + 0)) { REFRESH();
            if (l == 0) phase_resnorm(F, INF(I_X), nullptr, nullptr, nullptr, nullptr, nullptr, nullptr, INF(I_MPRE), modl + 2048, modl + 0, H);
            else phase_resnorm(F, nullptr, X, T2f, INF(I_FPOST) + (l - 1) * DM, mod + (size_t)(l - 1) * NB * 12288 + 10240, X, nullptr, INF(I_MPRE) + l * DM, modl + 2048, modl + 0, H);
        }
        SEAM(base + 0);
        if (IN(base + 1)) { REFRESH();
            pg8::Gemm g{H, wt(F, l, WL_IN), M, DINP, DM}; pg8::StaticOrder S; S.init(M, DINP, F.G, F.bid);
            pg8::EpiProj E{(bf16*)(F.ws + WS_U16), (bf16*)(F.ws + WS_CQ), (bf16*)(F.ws + WS_CKV), (bf16*)(F.ws + WS_HQ), (bf16*)(F.ws + WS_HV), (bf16*)(F.ws + WS_HGT), (bf16*)(F.ws + WS_ACT + 48 * MiB),
                           (float*)(F.ws + WS_LOGF), (float*)(F.ws + WS_SSQQ), (float*)(F.ws + WS_SSQKV), (const float*)(F.ws + WS_LB) + l * 512, (const float*)(F.ws + WS_COS), (const float*)(F.ws + WS_SIN)};
            pg8::gemm_phase<pg8::EpiProj, pg8::StaticOrder, true, true>(F.lds, g, S, E);
            if (F.G == 256 && F.bid >= 128) { REFRESH(); s5_tables_b(F, l, (F.bid - 128) * NTHR + F.tid, 128 * NTHR); }
        }
        SEAM(base + 1);
        if (IN(base + 2)) { REFRESH(); phase_mix1(F, l); }
        SEAM(base + 2);
        if (IN(base + 3)) { REFRESH();
            { pg8::Gemm g{(const bf16*)(F.ws + WS_CKV), wt(F, l, WL_UKV), M, 2048, 256}; pg8::StaticOrder S; S.init(M, 2048, F.G, F.bid);
              pg8::EpiKV E{(bf16*)(F.ws + WS_ACT + 48 * MiB), (bf16*)(F.ws + WS_ACT + 96 * MiB), (const float*)(F.ws + WS_SSQKV)};
              pg8::gemm_phase<pg8::EpiKV, pg8::StaticOrder, true, true>(F.lds, g, S, E); }
            REFRESH();
            hg_step2(F, (const bf16*)(F.ws + WS_DST), (const float*)(F.ws + WS_BLAST), (bf16*)(F.ws + WS_SPT));
            REFRESH();
            phase_s5out(F, l);
        }
        SEAM(base + 3);
        if (IN(base + 4)) { REFRESH();
            { pg8::Gemm g{(const bf16*)(F.ws + WS_CQ), wt(F, l, WL_UQ), M, 2048, 512, (const bf16*)(F.ws + WS_YG16), 6}; pg8::StaticOrder S; S.init(M, 2048, F.G, F.bid);
              pg8::EpiQGlu E{pg8::EpiQ{(bf16*)(F.ws + WS_ACT), (const float*)(F.ws + WS_SSQQ), (const float*)(F.ws + WS_COS), (const float*)(F.ws + WS_SIN)},
                             pg8::EpiGlu{(const bf16*)(F.ws + WS_YG16), 512, (bf16*)(F.ws + WS_CAT), DM}};
              pg8::gemm_phase<pg8::EpiQGlu, pg8::StaticOrder, true, true>(F.lds, g, S, E); }
            REFRESH();
            phase_hgout(F, l); }
        SEAM(base + 4);
        if (IN(base + 5)) { REFRESH(); phase_attn(F); }
        SEAM(base + 5);
        if (IN(base + 6)) { REFRESH();
            pg8::Gemm g{(const bf16*)(F.ws + WS_CAT), wt(F, l, WL_OUT), M, DM, DM}; pg8::StaticOrder S; S.init(M, DM, F.G, F.bid);
            pg8::EpiBf16<0> E{(bf16*)(F.ws + WS_T2), DM, nullptr, 0, 0, 1.f};
            pg8::gemm_phase<pg8::EpiBf16<0>, pg8::StaticOrder, true, true>(F.lds, g, S, E);
        }
        SEAM(base + 6);
        if (IN(base + 7)) { REFRESH(); phase_resnorm(F, l == 0 ? INF(I_X) : (const float*)nullptr, X, T2f, INF(I_MPOST) + l * DM, modl + 4096, X, nullptr, INF(I_FPRE) + l * DM, modl + 8192, modl + 6144, H); }
        SEAM(base + 7);
        if (IN(base + 8)) { REFRESH();
            pg8::Gemm g{H, wt(F, l, WL_UP), M, DFF2, DM}; pg8::StaticOrder S; S.init(M, DFF2, F.G, F.bid);
            pg8::EpiUp E{(bf16*)(F.ws + WS_ACT), (float*)(F.ws + WS_HALO), INF(I_CW) + (size_t)l * 3 * DFF2, INF(I_CB) + (size_t)l * DFF2};
            pg8::gemm_phase<pg8::EpiUp, pg8::StaticOrder, true, true>(F.lds, g, S, E);
        }
        SEAM(base + 8);
        if (IN(base + 9)) { REFRESH();
            { pg8::StaticOrder S0; S0.init(M, DM, F.G, F.bid); pg8::Unit u0; int last = -1;
              for (int i = 0; S0.next(i, u0); ++i) if (u0.pm != last) { fixup_panel(F, l, u0.pm); last = u0.pm; } }
            asm volatile("s_waitcnt vmcnt(0)" ::: "memory"); __syncthreads();
            REFRESH();
            pg8::Gemm g{(const bf16*)(F.ws + WS_ACT), wt(F, l, WL_DN), M, DM, DFF}; pg8::StaticOrder S; S.init(M, DM, F.G, F.bid);
            pg8::EpiBf16<0> E{(bf16*)(F.ws + WS_T2), DM, nullptr, 0, 0, 1.f};
            pg8::gemm_phase<pg8::EpiBf16<0>, pg8::StaticOrder, true, true>(F.lds, g, S, E);
        }
        SEAM(base + 9);
    }
    if (IN(PH_FINAL)) { REFRESH(); phase_resnorm(F, nullptr, X, T2f, INF(I_FPOST) + (NL - 1) * DM, mod + (size_t)(NL - 1) * NB * 12288 + 10240, nullptr, args.out, nullptr, nullptr, nullptr, nullptr); }
#undef mod
#undef X
#undef H
#undef T2f
#undef modl
#undef IN
}

extern "C" void kernel_launch(void* const* d_in, const int* in_sizes, int n_in, void* d_out, int out_size, void* d_ws, size_t ws_size, hipStream_t stream) {
    static int grid = 0;
    if (grid == 0) {
        if (n_in != N_IN || in_sizes[0] != M * DM || out_size != M * DM || ws_size < WS_END) { fprintf(stderr, "kernel_launch: shape/workspace mismatch (n_in %d, in0 %d, out %d, ws %zu < %zu)\n", n_in, n_in > 0 ? in_sizes[0] : -1, out_size, ws_size, (size_t)WS_END); grid = -1; return; }
        int dev = 0, cus = 0;
        if (hipGetDevice(&dev) != hipSuccess || hipDeviceGetAttribute(&cus, hipDeviceAttributeMultiprocessorCount, dev) != hipSuccess) { grid = -1; return; }
        if (hipFuncSetAttribute((const void*)skel_fwd, hipFuncAttributeMaxDynamicSharedMemorySize, LDS_BYTES) != hipSuccess) { fprintf(stderr, "kernel_launch: hipFuncSetAttribute failed\n"); grid = -1; return; }
        (void)hipGetLastError();
        grid = cus;
    }
    if (grid < 0) return;
    Args a{};
    for (int i = 0; i < N_IN; ++i) a.in[i] = d_in[i];
    a.out = (float*)d_out; a.ws = (unsigned char*)d_ws;
    if (hipMemsetAsync((char*)d_ws + WS_CTL, 0, CTL_ZERO_BYTES, stream) != hipSuccess) { fprintf(stderr, "kernel_launch: memset failed\n"); return; }
#if MK_ONE_LAUNCH
    a.ph_lo = 0; a.ph_hi = N_PHASES;
    hipLaunchKernelGGL(skel_fwd, dim3(grid), dim3(NTHR), LDS_BYTES, stream, a);
#else
    for (int p = 0; p < N_PHASES; ++p) {
        a.ph_lo = p; a.ph_hi = p + 1;
        hipLaunchKernelGGL(skel_fwd, dim3(grid), dim3(NTHR), LDS_BYTES, stream, a);
    }
#endif
}
```

```cpp
#include <hip/hip_runtime.h>
#include <cstdio>
#include <cstdint>
namespace pg8 {
#define PG8_LAS __attribute__((address_space(3)))
typedef unsigned short bf16_t;
typedef short bf16x8 __attribute__((ext_vector_type(8)));
typedef float f32x4 __attribute__((ext_vector_type(4)));
typedef unsigned u32x4 __attribute__((ext_vector_type(4)));
constexpr int BM = 256, BK = 64, HALF = 128, HTB = HALF * BK * 2  , STAGE_BYTES = 8 * HTB, NXCD = 8, WGM = 8;

__host__ __device__ __forceinline__ int lds_byte(int r, int c) { const int st = (r >> 4) * 2 + (c >> 5), rr = r & 15, cc = c & 31, ob = rr * 64 + cc * 2; return st * 1024 + (ob ^ (((ob >> 9) & 1) << 5)); }
__host__ __device__ __forceinline__ void stage_rc(int b, int& R, int& C) { const int st = b / 1024, sb = b % 1024, swz = sb ^ (((sb >> 9) & 1) << 5); R = (st >> 1) * 16 + swz / 64; C = (st & 1) * 32 + (swz % 64) / 2; }
__host__ __device__ __forceinline__ int perm32(int rho) { const int n = rho >> 4, i = rho & 15; return 8 * (i >> 2) + 4 * n + (i & 3); }

__device__ __forceinline__ __amdgpu_buffer_rsrc_t wt_rsrc(const void* base, size_t nbytes) { return __builtin_amdgcn_make_buffer_rsrc((void*)base, 0, (int)nbytes, 0x00020000); }
__device__ __forceinline__ void st16_wt(__amdgpu_buffer_rsrc_t r, size_t byte_off, u32x4 v) { __builtin_amdgcn_raw_buffer_store_b128(v, r, (int)byte_off, 0, 16); }
struct Unit { int pm, pn; };
struct Gemm { const bf16_t* A; const bf16_t* Bt; int M, N, K; const bf16_t* A2 = nullptr; int pn_split = 1 << 30; };

struct StaticOrder {
    int nM, nN, nwg, G, c, wgm;
    __host__ __device__ void init(int M, int N, int G_, int c_, int wgm_ = WGM) { nM = M / BM; nN = N / BM; nwg = nM * nN; G = G_; c = c_; wgm = wgm_; }
    __host__ __device__ __forceinline__ bool next(int i, Unit& u) const {
        const long L = (long)i * G + c; if (L >= nwg) return false;
        int wgid = (int)L; { const int q = nwg / NXCD, r = nwg % NXCD, xcd = wgid % NXCD, off = wgid / NXCD; wgid = (xcd < r ? xcd * (q + 1) : r * (q + 1) + (xcd - r) * q) + off; }
        const int nig = wgm * nN, gid = wgid / nig, fm = gid * wgm, gsz = (nM - fm) < wgm ? (nM - fm) : wgm;
        u.pm = fm + ((wgid % nig) % gsz); u.pn = (wgid % nig) / gsz; return true;
    }
    __device__ __forceinline__ void a_ready(const Unit&) const {}
    __device__ __forceinline__ void done(const Unit&) const {}
};

__device__ __forceinline__ unsigned cvt_pk_bf16(float lo, float hi) { typedef float f2_ __attribute__((ext_vector_type(2))); typedef __bf16 b2_ __attribute__((ext_vector_type(2))); const b2_ r = __builtin_convertvector((f2_){lo, hi}, b2_); return __builtin_bit_cast(unsigned, r); }
typedef float f32x2 __attribute__((ext_vector_type(2)));
__device__ __forceinline__ f32x2 gelu_pk(f32x2 v) {
    const f32x2 av = __builtin_elementwise_abs(v), d = av * 0.2316418882f + 1.0f;
    f32x2 t; t.x = __builtin_amdgcn_rcpf(d.x); t.y = __builtin_amdgcn_rcpf(d.y);
    f32x2 q = t * 0.5307027145f + (-0.7265760135f); q = q * t + 0.7107068705f; q = q * t + (-0.142248368f); q = q * t + 0.127414796f; q = q * t;
    const f32x2 s = (v * v) * (-0.72134752044f);
    f32x2 e; e.x = __builtin_amdgcn_exp2f(s.x); e.y = __builtin_amdgcn_exp2f(s.y);
    const f32x2 m = v * (q * e), r = v - m;
    f32x2 o; o.x = v.x < 0.f ? m.x : r.x; o.y = v.y < 0.f ? m.y : r.y; return o;
}

template <int ACT  > struct EpiBf16 {
    static constexpr bool PERM = true, AFTER_DRAIN = false, PERMA = false; static_assert(ACT == 0 || ACT == 1, "EpiBf16: ACT is 0 (none) or 1 (gelu_pk)");
    bf16_t* O; int ldc; const float* bias; int split_cols; size_t split_stride; float scale0;
    __device__ __forceinline__ void operator()(const f32x4 (&acc)[2][2][4][2], const Unit& u, int wr, int wc, int fr, int fq) const {
        const int row0 = u.pm * BM + wr * 64 + fr; int colt = u.pn * BM; bf16_t* base = O;
        float sc = 1.f; if (split_cols) { const int t = colt / split_cols; base += (size_t)t * split_stride; colt -= t * split_cols; if (t == 0) sc = scale0; }
        const int col0 = colt + wc * 32 + 8 * fq, bcol0 = u.pn * BM + wc * 32 + 8 * fq;
        f32x4 bv[2][2];
#pragma unroll
        for (int bj = 0; bj < 2; ++bj)
#pragma unroll
            for (int n = 0; n < 2; ++n) bv[bj][n] = bias ? *(const f32x4*)(bias + bcol0 + bj * HALF + 4 * n) : (f32x4){0.f, 0.f, 0.f, 0.f};
#pragma unroll
        for (int ai = 0; ai < 2; ++ai)
#pragma unroll
            for (int m = 0; m < 4; ++m) { bf16_t* rowp = base + (size_t)(row0 + ai * HALF + m * 16) * ldc + col0;
#pragma unroll
                for (int bj = 0; bj < 2; ++bj) { f32x4 v0 = acc[ai][bj][m][0] + bv[bj][0], v1 = acc[ai][bj][m][1] + bv[bj][1];
                    if (ACT == 1) { f32x2 a = gelu_pk((f32x2){v0[0], v0[1]}), b = gelu_pk((f32x2){v0[2], v0[3]}), c = gelu_pk((f32x2){v1[0], v1[1]}), d = gelu_pk((f32x2){v1[2], v1[3]});
                        v0 = (f32x4){a.x, a.y, b.x, b.y}; v1 = (f32x4){c.x, c.y, d.x, d.y}; }
                    v0 = v0 * sc; v1 = v1 * sc; u32x4 w; w.x = cvt_pk_bf16(v0[0], v0[1]); w.y = cvt_pk_bf16(v0[2], v0[3]); w.z = cvt_pk_bf16(v1[0], v1[1]); w.w = cvt_pk_bf16(v1[2], v1[3]);
                    *(u32x4*)(rowp + bj * HALF) = w; } }
    }
};
struct EpiF32 {
    static constexpr bool PERM = false, AFTER_DRAIN = false, PERMA = false;
    float* C; int ldc; const float* bias;
    __device__ __forceinline__ void operator()(const f32x4 (&acc)[2][2][4][2], const Unit& u, int wr, int wc, int fr, int fq) const {
        const int row0 = u.pm * BM + wr * 64 + fr, col0 = u.pn * BM + wc * 32 + 4 * fq;
        f32x4 bv[2][2];
#pragma unroll
        for (int bj = 0; bj < 2; ++bj)
#pragma unroll
            for (int n = 0; n < 2; ++n) bv[bj][n] = bias ? *(const f32x4*)(bias + col0 + bj * HALF + n * 16) : (f32x4){0.f, 0.f, 0.f, 0.f};
#pragma unroll
        for (int ai = 0; ai < 2; ++ai)
#pragma unroll
            for (int m = 0; m < 4; ++m) { float* rowp = C + (size_t)(row0 + ai * HALF + m * 16) * ldc + col0;
#pragma unroll
                for (int bj = 0; bj < 2; ++bj)
#pragma unroll
                    for (int n = 0; n < 2; ++n) *(f32x4*)(rowp + bj * HALF + n * 16) = acc[ai][bj][m][n] + bv[bj][n]; }
    }
};
struct EpiGlu {
    static constexpr bool PERM = true, AFTER_DRAIN = false, PERMA = false;
    const bf16_t* Y; int ldy; bf16_t* O; int ldo;
    __device__ __forceinline__ void operator()(const f32x4 (&acc)[2][2][4][2], const Unit& u, int wr, int wc, int fr, int fq) const {
        const int row0 = u.pm * BM + wr * 64 + fr, col0 = u.pn * BM + wc * 32 + 8 * fq;
#pragma unroll
        for (int ai = 0; ai < 2; ++ai)
#pragma unroll
            for (int m = 0; m < 4; ++m) { const size_t row = (size_t)(row0 + ai * HALF + m * 16);
#pragma unroll
                for (int bj = 0; bj < 2; ++bj) { const int col = col0 + bj * HALF;
                    const u32x4 yv = *(const u32x4*)(Y + row * ldy + col); const unsigned yw[4] = {yv.x, yv.y, yv.z, yv.w};
                    const f32x4 v0 = acc[ai][bj][m][0], v1 = acc[ai][bj][m][1]; const float vv[8] = {v0[0], v0[1], v0[2], v0[3], v1[0], v1[1], v1[2], v1[3]};
                    float o[8];
#pragma unroll
                    for (int e = 0; e < 8; ++e) { const float y = __builtin_bit_cast(float, (yw[e >> 1] >> ((e & 1) * 16)) << 16); o[e] = y / (1.f + __expf(-vv[e])); }
                    u32x4 w; w.x = cvt_pk_bf16(o[0], o[1]); w.y = cvt_pk_bf16(o[2], o[3]); w.z = cvt_pk_bf16(o[4], o[5]); w.w = cvt_pk_bf16(o[6], o[7]);
                    *(u32x4*)(O + row * ldo + col) = w; } }
    }
};
struct EpiQ {
    static constexpr bool PERM = true, AFTER_DRAIN = false, PERMA = false;
    bf16_t* Q; const float* ssq; const float* cosT; const float* sinT;
    __device__ __forceinline__ void operator()(const f32x4 (&acc)[2][2][4][2], const Unit& u, int wr, int wc, int fr, int fq) const {
        const int row0 = u.pm * BM + wr * 64 + fr;
#pragma unroll
        for (int ai = 0; ai < 2; ++ai)
#pragma unroll
            for (int m = 0; m < 4; ++m) { const int row = row0 + ai * HALF + m * 16, b = row >> 12, s = row & 4095; const f32x4 sa = *(const f32x4*)(ssq + (size_t)row * 8), sb = *(const f32x4*)(ssq + (size_t)row * 8 + 4); const float r = __builtin_amdgcn_rsqf((((sa[0] + sa[1]) + (sa[2] + sa[3])) + ((sb[0] + sb[1]) + (sb[2] + sb[3]))) * (1.f / 512.f) + 1e-6f) * 0.10411754f;
                if (u.pn < 4) {
#pragma unroll
                    for (int bj = 0; bj < 2; ++bj) { const int h = 2 * u.pn + bj; const f32x4 v0 = acc[ai][bj][m][0] * r, v1 = acc[ai][bj][m][1] * r;
                        u32x4 w; w.x = cvt_pk_bf16(v0[0], v0[1]); w.y = cvt_pk_bf16(v0[2], v0[3]); w.z = cvt_pk_bf16(v1[0], v1[1]); w.w = cvt_pk_bf16(v1[2], v1[3]);
                        *(u32x4*)(Q + ((size_t)(b * 8 + h) * 4096 + s) * 192 + wc * 32 + 8 * fq) = w; }
                } else {
                    const int f0 = ((wc & 1) * 4 + fq) * 4; const f32x4 cs = *(const f32x4*)(cosT + (size_t)row * 32 + f0), sn = *(const f32x4*)(sinT + (size_t)row * 32 + f0);
#pragma unroll
                    for (int bj = 0; bj < 2; ++bj) { const int h = (u.pn - 4) * 4 + bj * 2 + (wc >> 1); const f32x4 x1 = acc[ai][bj][m][0] * r, x2 = acc[ai][bj][m][1] * r;
                        const f32x4 o1 = x1 * cs - x2 * sn, o2 = x2 * cs + x1 * sn;
                        bf16_t* qp = Q + ((size_t)(b * 8 + h) * 4096 + s) * 192 + 128 + f0;
                        typedef unsigned u32x2 __attribute__((ext_vector_type(2)));
                        *(u32x2*)qp = (u32x2){cvt_pk_bf16(o1[0], o1[1]), cvt_pk_bf16(o1[2], o1[3])};
                        *(u32x2*)(qp + 32) = (u32x2){cvt_pk_bf16(o2[0], o2[1]), cvt_pk_bf16(o2[2], o2[3])}; }
                } }
    }
};
struct EpiKV {
    static constexpr bool PERM = true, AFTER_DRAIN = false, PERMA = false;
    bf16_t* Kf; bf16_t* V; const float* ssq;
    __device__ __forceinline__ void operator()(const f32x4 (&acc)[2][2][4][2], const Unit& u, int wr, int wc, int fr, int fq) const {
        const int row0 = u.pm * BM + wr * 64 + fr, h = u.pn, d = wc * 32 + 8 * fq;
#pragma unroll
        for (int ai = 0; ai < 2; ++ai)
#pragma unroll
            for (int m = 0; m < 4; ++m) { const int row = row0 + ai * HALF + m * 16, b = row >> 12, s = row & 4095; const f32x4 sa = *(const f32x4*)(ssq + (size_t)row * 4); const float r = __builtin_amdgcn_rsqf(((sa[0] + sa[1]) + (sa[2] + sa[3])) * (1.f / 256.f) + 1e-6f);
#pragma unroll
                for (int bj = 0; bj < 2; ++bj) { const f32x4 v0 = acc[ai][bj][m][0] * r, v1 = acc[ai][bj][m][1] * r;
                    u32x4 w; w.x = cvt_pk_bf16(v0[0], v0[1]); w.y = cvt_pk_bf16(v0[2], v0[3]); w.z = cvt_pk_bf16(v1[0], v1[1]); w.w = cvt_pk_bf16(v1[2], v1[3]);
                    bf16_t* dst = bj ? V + ((size_t)(b * 8 + h) * 4096 + s) * 128 + d : Kf + ((size_t)(b * 8 + h) * 4096 + s) * 192 + d;
                    *(u32x4*)dst = w; } }
    }
};
__device__ __forceinline__ f32x4 dpp_shr1(f32x4 v) { f32x4 o;
#pragma unroll
    for (int i = 0; i < 4; ++i) { const float f_ = v[i]; o[i] = __int_as_float(__builtin_amdgcn_update_dpp(0, __float_as_int(f_), 0x111, 0xf, 0xf, true)); }
    return o; }
__device__ __forceinline__ float gelu_tanh1(float x) { const float t = 0.7978845608028654f * (x + 0.044715f * x * x * x); return x * __builtin_amdgcn_rcpf(1.f + __builtin_amdgcn_exp2f(-2.885390081777927f * t)); }
struct EpiUp {
    static constexpr bool PERM = true, AFTER_DRAIN = false, PERMA = true;
    bf16_t* ACT; float* HALO; const float* cw; const float* cb;
    __device__ __forceinline__ void operator()(const f32x4 (&acc)[2][2][4][2], const Unit& u, int wr, int wc, int fr, int fq) const {
        const int ch0 = u.pn * 128 + wc * 32 + 8 * fq, prow = u.pm * BM + (wr * 16 + fr) * 8, blk = u.pm * 2 + wr;
        unsigned pk[8][2];
#pragma unroll
        for (int n = 0; n < 2; ++n) {
            const int c = ch0 + 4 * n;
            const f32x4 wg0 = *(const f32x4*)(cw + c), wg1 = *(const f32x4*)(cw + 11008 + c), wg2 = *(const f32x4*)(cw + 22016 + c), bg = *(const f32x4*)(cb + c);
            const f32x4 wv0 = *(const f32x4*)(cw + 5504 + c), wv1 = *(const f32x4*)(cw + 11008 + 5504 + c), wv2 = *(const f32x4*)(cw + 22016 + 5504 + c), bv = *(const f32x4*)(cb + 5504 + c);
#define XG(j) acc[(j) >> 2][0][(j) & 3][n]
#define XV(j) acc[(j) >> 2][1][(j) & 3][n]
            const f32x4 gm1 = dpp_shr1(XG(7)), gm2 = dpp_shr1(XG(6)), vm1 = dpp_shr1(XV(7)), vm2 = dpp_shr1(XV(6));
            if (fr == 0) { float* hp = HALO + (size_t)(blk * 4) * 11008 + c; *(f32x4*)hp = XG(0); *(f32x4*)(hp + 11008) = XG(1); *(f32x4*)(hp + 5504) = XV(0); *(f32x4*)(hp + 11008 + 5504) = XV(1); }
            if (fr == 15) { float* hp = HALO + (size_t)(blk * 4 + 2) * 11008 + c; *(f32x4*)hp = XG(6); *(f32x4*)(hp + 11008) = XG(7); *(f32x4*)(hp + 5504) = XV(6); *(f32x4*)(hp + 11008 + 5504) = XV(7); }
#pragma unroll
            for (int j = 0; j < 8; ++j) {
                const f32x4 g2 = (j >= 2) ? XG(j >= 2 ? j - 2 : 0) : (j == 0 ? gm2 : gm1), g1 = (j >= 1) ? XG(j >= 1 ? j - 1 : 0) : gm1;
                const f32x4 v2 = (j >= 2) ? XV(j >= 2 ? j - 2 : 0) : (j == 0 ? vm2 : vm1), v1 = (j >= 1) ? XV(j >= 1 ? j - 1 : 0) : vm1;
                const f32x4 cg = bg + wg0 * g2 + wg1 * g1 + wg2 * XG(j), cv = bv + wv0 * v2 + wv1 * v1 + wv2 * XV(j);
                const unsigned p0 = cvt_pk_bf16(gelu_tanh1(cg[0]) * cv[0], gelu_tanh1(cg[1]) * cv[1]), p1 = cvt_pk_bf16(gelu_tanh1(cg[2]) * cv[2], gelu_tanh1(cg[3]) * cv[3]);
                if (n == 0) { pk[j][0] = p0; pk[j][1] = p1; }
                else if (!(fr == 0 && j < 2)) *(u32x4*)(ACT + (size_t)(prow + j) * 5504 + ch0) = (u32x4){pk[j][0], pk[j][1], p0, p1};
            }
#undef XG
#undef XV
        }
    }
};
struct EpiProj {
    static constexpr bool PERM = true, AFTER_DRAIN = false, PERMA = false;
    bf16_t *U16, *CQ, *CKV, *HQ, *HV, *HGT, *KF; float* LOGF; float* ssq_q; float* ssq_kv; const float* lb; const float* cosT; const float* sinT;
    __device__ __forceinline__ void operator()(const f32x4 (&acc)[2][2][4][2], const Unit& u, int wr, int wc, int fr, int fq) const {
        const int row0 = u.pm * BM + wr * 64 + fr, col8 = wc * 32 + 8 * fq, pn = u.pn;
        if (pn == 13) {
            if (wc < 2) { const int f0 = (wc * 4 + fq) * 4;
#pragma unroll
                for (int ai = 0; ai < 2; ++ai)
#pragma unroll
                    for (int m = 0; m < 4; ++m) { const int row = row0 + ai * HALF + m * 16, b = row >> 12, s = row & 4095;
                        const f32x4 cs = *(const f32x4*)(cosT + (size_t)row * 32 + f0), sn = *(const f32x4*)(sinT + (size_t)row * 32 + f0);
                        const f32x4 x1 = acc[ai][0][m][0], x2 = acc[ai][0][m][1]; const f32x4 o1 = x1 * cs - x2 * sn, o2 = x2 * cs + x1 * sn;
                        typedef unsigned u32x2 __attribute__((ext_vector_type(2)));
                        const u32x2 w1 = (u32x2){cvt_pk_bf16(o1[0], o1[1]), cvt_pk_bf16(o1[2], o1[3])}, w2 = (u32x2){cvt_pk_bf16(o2[0], o2[1]), cvt_pk_bf16(o2[2], o2[3])};
#pragma unroll
                        for (int h = 0; h < 8; ++h) { bf16_t* kp = KF + ((size_t)(b * 8 + h) * 4096 + s) * 192 + 128 + f0; *(u32x2*)kp = w1; *(u32x2*)(kp + 32) = w2; } } }
            return;
        }
        if (pn == 7 || pn == 8) {
            const int cbase = (pn - 7) * 256;
#pragma unroll
            for (int bj = 0; bj < 2; ++bj) { const int col = cbase + bj * HALF + col8; const f32x4 l0 = *(const f32x4*)(lb + col), l1 = *(const f32x4*)(lb + col + 4);
#pragma unroll
                for (int ai = 0; ai < 2; ++ai)
#pragma unroll
                    for (int m = 0; m < 4; ++m) { const size_t row = (size_t)(row0 + ai * HALF + m * 16); f32x4 o0, o1;
#pragma unroll
                        for (int e = 0; e < 4; ++e) { const float z0 = acc[ai][bj][m][0][e], z1 = acc[ai][bj][m][1][e];
                            o0[e] = __logf(l0[e] + (1.f - l0[e]) * __builtin_amdgcn_rcpf(1.f + __expf(-z0))); o1[e] = __logf(l1[e] + (1.f - l1[e]) * __builtin_amdgcn_rcpf(1.f + __expf(-z1))); }
                        *(f32x4*)(LOGF + row * 512 + col) = o0; *(f32x4*)(LOGF + row * 512 + col + 4) = o1; } }
            return;
        }
        bf16_t* base; int ld, cbase, nslot = 0, slot0 = 0; bool act = false; float* ssq = nullptr;
        if (pn < 2) { base = U16; ld = 512; cbase = pn * 256; }
        else if (pn < 4) { base = CQ; ld = 512; cbase = (pn - 2) * 256; ssq = ssq_q; nslot = 8; slot0 = (pn - 2) * 4; }
        else if (pn == 4) { base = CKV; ld = 256; cbase = 0; ssq = ssq_kv; nslot = 4; }
        else if (pn < 7) { base = HQ; ld = 512; cbase = (pn - 5) * 256; act = true; }
        else if (pn < 11) { base = HV; ld = 512; cbase = (pn - 9) * 256; }
        else { base = HGT; ld = 512; cbase = (pn - 11) * 256; act = true; }
#pragma unroll
        for (int ai = 0; ai < 2; ++ai)
#pragma unroll
            for (int m = 0; m < 4; ++m) { const size_t row = (size_t)(row0 + ai * HALF + m * 16); float ss = 0.f;
#pragma unroll
                for (int bj = 0; bj < 2; ++bj) { f32x4 v0 = acc[ai][bj][m][0], v1 = acc[ai][bj][m][1];
                    ss += (v0[0] * v0[0] + v0[1] * v0[1]) + (v0[2] * v0[2] + v0[3] * v0[3]) + (v1[0] * v1[0] + v1[1] * v1[1]) + (v1[2] * v1[2] + v1[3] * v1[3]);
                    if (act) {
#pragma unroll
                        for (int e = 0; e < 4; ++e) { v0[e] = v0[e] * __builtin_amdgcn_rcpf(1.f + __expf(-v0[e])); v1[e] = v1[e] * __builtin_amdgcn_rcpf(1.f + __expf(-v1[e])); } }
                    u32x4 w; w.x = cvt_pk_bf16(v0[0], v0[1]); w.y = cvt_pk_bf16(v0[2], v0[3]); w.z = cvt_pk_bf16(v1[0], v1[1]); w.w = cvt_pk_bf16(v1[2], v1[3]);
                    *(u32x4*)(base + row * ld + cbase + bj * HALF + col8) = w; }
                if (ssq) { ss += __shfl_xor(ss, 16); ss += __shfl_xor(ss, 32); if (fq == 0) ssq[row * nslot + slot0 + wc] = ss; } }
    }
};
struct EpiQGlu {
    static constexpr bool PERM = true, AFTER_DRAIN = false, PERMA = false;
    EpiQ q; EpiGlu glu;
    __device__ __forceinline__ void operator()(const f32x4 (&acc)[2][2][4][2], const Unit& u, int wr, int wc, int fr, int fq) const {
        if (u.pn < 6) q(acc, u, wr, wc, fr, fq);
        else { Unit v; v.pm = u.pm; v.pn = u.pn - 6; glu(acc, v, wr, wc, fr, fq); }
    }
};
template <class Epi, class Sched, bool ALIGN_EPI = false, bool SP2 = false>
__device__ __forceinline__ void gemm_phase(PG8_LAS unsigned char* lds, const Gemm g, const Sched& S, const Epi& E) {
    int tid_ = threadIdx.x; asm volatile("" : "+v"(tid_));
    const int tid = tid_, wid = __builtin_amdgcn_readfirstlane(tid >> 6), lane = tid & 63, wr = wid >> 2, wc = wid & 3, fr = lane & 15, fq = lane >> 4;
    const int K = g.K, nt = K / BK;
    unsigned voffA[2], voffB[2];
#pragma unroll
    for (int i = 0; i < 2; ++i) { int R, C; stage_rc(tid * 16 + i * 8192, R, C); const int Rb = Epi::PERM ? ((R & ~31) + perm32(R & 31)) : R;
        const int Ra = Epi::PERMA ? (((R >> 6) & 1) * 128 + (R & 15) * 8 + ((R >> 4) & 3)) : R;
        voffA[i] = (unsigned)(Ra * K + C) * 2u; voffB[i] = (unsigned)(Rb * K + C) * 2u; }
    const size_t kstep = (size_t)(BK * 2);
    const size_t hstep = (size_t)HALF * K * 2;
    const size_t hstepA = Epi::PERMA ? (size_t)4 * K * 2 : hstep;
    const size_t tstep = 2 * hstep;
    const unsigned ldsw = (unsigned)wid * 1024u;
    const int aoff = lds_byte(wr * 64 + fr, fq * 8), boff = lds_byte(wc * 32 + fr, fq * 8);
#define PG8_SA(b, h) (((b) * 2 + (h)) * HTB)
#define PG8_SB(b, h) ((4 + (b) * 2 + (h)) * HTB)
#define PG8_STAGE(bufoff, gbase, voff) do { _Pragma("unroll") for (int _i = 0; _i < 2; ++_i) \
        __builtin_amdgcn_global_load_lds((const unsigned*)((const char*)(gbase) + (voff)[_i]), (PG8_LAS unsigned*)(lds + (bufoff) + ldsw + _i * 8192), 16, 0, 0); } while (0)
#define PG8_LDA(dst, b, h) do { _Pragma("unroll") for (int m = 0; m < 4; ++m) _Pragma("unroll") for (int k = 0; k < 2; ++k) dst[m][k] = *(const PG8_LAS bf16x8*)(lds + PG8_SA(b, h) + aoff + m * 2048 + k * 1024); } while (0)
#define PG8_LDB(dst, b, h) do { _Pragma("unroll") for (int n = 0; n < 2; ++n) _Pragma("unroll") for (int k = 0; k < 2; ++k) dst[n][k] = *(const PG8_LAS bf16x8*)(lds + PG8_SB(b, h) + boff + n * 2048 + k * 1024); } while (0)
#define PG8_MMA(ai, bj, At, Bt) do { __builtin_amdgcn_s_setprio(1); _Pragma("unroll") for (int m = 0; m < 4; ++m) _Pragma("unroll") for (int n = 0; n < 2; ++n) _Pragma("unroll") for (int k = 0; k < 2; ++k) \
        acc[ai][bj][m][n] = __builtin_amdgcn_mfma_f32_16x16x32_bf16(Bt[n][k], At[m][k], acc[ai][bj][m][n], 0, 0, 0); __builtin_amdgcn_s_setprio(0); } while (0)
#define PG8_WAIT_V(n) asm volatile("s_waitcnt vmcnt(" #n ")" ::: "memory")
#define PG8_WAIT_L(n) asm volatile("s_waitcnt lgkmcnt(" #n ")" ::: "memory")
#define PG8_BAR __builtin_amdgcn_s_barrier()
#define PG8_SCHED __builtin_amdgcn_sched_barrier(0)
    Unit cur, nxt; int ui = 0;
    if (!S.next(0, cur)) return;
    f32x4 acc[2][2][4][2];
#pragma unroll
    for (int a = 0; a < 2; ++a)
#pragma unroll
        for (int b = 0; b < 2; ++b)
#pragma unroll
            for (int m = 0; m < 4; ++m)
#pragma unroll
                for (int n = 0; n < 2; ++n) acc[a][b][m][n] = (f32x4){0.f, 0.f, 0.f, 0.f};
    bf16x8 At[4][2], B0[2][2], B1[2][2];
    const char* cA = (const char*)(cur.pn >= g.pn_split ? g.A2 : g.A) + (size_t)cur.pm * tstep; const char* cB = (const char*)g.Bt + (size_t)cur.pn * tstep;
    S.a_ready(cur);
    if constexpr (SP2) {
        PG8_STAGE(PG8_SB(0, 0), cB, voffB); PG8_STAGE(PG8_SB(0, 1), cB + hstep, voffB); PG8_STAGE(PG8_SA(0, 0), cA, voffA); PG8_STAGE(PG8_SA(0, 1), cA + hstepA, voffA);
        if (wr == 1) PG8_BAR;
        PG8_WAIT_V(2); PG8_BAR;
        PG8_STAGE(PG8_SB(1, 0), cB + kstep, voffB); PG8_STAGE(PG8_SA(1, 0), cA + kstep, voffA); PG8_STAGE(PG8_SB(1, 1), cB + hstep + kstep, voffB);
        PG8_WAIT_V(6); PG8_BAR;
    } else {
        PG8_STAGE(PG8_SB(0, 0), cB, voffB); PG8_STAGE(PG8_SA(0, 0), cA, voffA); PG8_STAGE(PG8_SB(0, 1), cB + hstep, voffB); PG8_STAGE(PG8_SA(0, 1), cA + hstepA, voffA);
        if (wr == 1) PG8_BAR;
        PG8_WAIT_V(4); PG8_BAR;
        PG8_STAGE(PG8_SB(1, 0), cB + kstep, voffB); PG8_STAGE(PG8_SA(1, 0), cA + kstep, voffA); PG8_STAGE(PG8_SB(1, 1), cB + hstep + kstep, voffB);
        PG8_WAIT_V(6); PG8_BAR;
    }
    for (;;) {
        const bool has_next = S.next(ui + 1, nxt);
        const char* nA = has_next ? (const char*)(nxt.pn >= g.pn_split ? g.A2 : g.A) + (size_t)nxt.pm * tstep : cA; const char* nB = has_next ? (const char*)g.Bt + (size_t)nxt.pn * tstep : cB;
        for (int t = 0; t < nt; t += 2) {
            const bool last = (t == nt - 2);
            const char* a1 = cA + (size_t)(t + 1) * kstep;
            const char* a2 = last ? nA : cA + (size_t)(t + 2) * kstep; const char* b2 = last ? nB : cB + (size_t)(t + 2) * kstep;
            const char* a3 = a2 + kstep; const char* b3 = b2 + kstep;
            if (last && has_next) S.a_ready(nxt);
            if constexpr (SP2) {
            PG8_LDB(B0, 0, 0); PG8_LDB(B1, 0, 1); PG8_SCHED; PG8_LDA(At, 0, 0); PG8_STAGE(PG8_SA(1, 1), a1 + hstepA, voffA);
            PG8_WAIT_V(8); PG8_WAIT_L(0); PG8_BAR; PG8_MMA(0, 0, At, B0); PG8_MMA(0, 1, At, B1); PG8_BAR; PG8_SCHED;
            PG8_LDA(At, 0, 1); PG8_STAGE(PG8_SB(0, 0), b2, voffB); PG8_STAGE(PG8_SB(0, 1), b2 + hstep, voffB); PG8_STAGE(PG8_SA(0, 0), a2, voffA);
            PG8_WAIT_V(8); PG8_WAIT_L(0); PG8_BAR; PG8_MMA(1, 0, At, B0); PG8_MMA(1, 1, At, B1); PG8_BAR; PG8_SCHED;
            PG8_LDB(B0, 1, 0); PG8_LDB(B1, 1, 1); PG8_SCHED; PG8_LDA(At, 1, 0); PG8_STAGE(PG8_SA(0, 1), a2 + hstepA, voffA);
            PG8_WAIT_V(8); PG8_WAIT_L(0); PG8_BAR; PG8_MMA(0, 0, At, B0); PG8_MMA(0, 1, At, B1); PG8_BAR; PG8_SCHED;
            PG8_LDA(At, 1, 1); PG8_STAGE(PG8_SB(1, 0), b3, voffB); PG8_STAGE(PG8_SB(1, 1), b3 + hstep, voffB); PG8_STAGE(PG8_SA(1, 0), a3, voffA);
            PG8_WAIT_V(8); PG8_WAIT_L(0); PG8_BAR; PG8_MMA(1, 0, At, B0); PG8_MMA(1, 1, At, B1); PG8_BAR; PG8_SCHED;
            } else {
            PG8_LDB(B0, 0, 0); PG8_SCHED; PG8_LDA(At, 0, 0); PG8_STAGE(PG8_SA(1, 1), a1 + hstepA, voffA);
            PG8_WAIT_L(8); PG8_BAR; PG8_WAIT_L(0); PG8_MMA(0, 0, At, B0); PG8_BAR; PG8_SCHED;
            PG8_LDB(B1, 0, 1); PG8_STAGE(PG8_SB(0, 0), b2, voffB);
            PG8_BAR; PG8_WAIT_L(0); PG8_MMA(0, 1, At, B1); PG8_BAR;
            PG8_LDA(At, 0, 1); PG8_STAGE(PG8_SA(0, 0), a2, voffA);
            PG8_BAR; PG8_WAIT_L(0); PG8_MMA(1, 0, At, B0); PG8_BAR; PG8_SCHED;
            PG8_STAGE(PG8_SB(0, 1), b2 + hstep, voffB);
            PG8_WAIT_V(6); PG8_BAR; PG8_MMA(1, 1, At, B1); PG8_BAR;
            PG8_LDB(B0, 1, 0); PG8_SCHED; PG8_LDA(At, 1, 0); PG8_STAGE(PG8_SA(0, 1), a2 + hstepA, voffA);
            PG8_WAIT_L(8); PG8_BAR; PG8_WAIT_L(0); PG8_MMA(0, 0, At, B0); PG8_BAR; PG8_SCHED;
            PG8_LDB(B1, 1, 1); PG8_STAGE(PG8_SB(1, 0), b3, voffB);
            PG8_BAR; PG8_WAIT_L(0); PG8_MMA(0, 1, At, B1); PG8_BAR;
            PG8_LDA(At, 1, 1); PG8_STAGE(PG8_SA(1, 0), a3, voffA);
            PG8_BAR; PG8_WAIT_L(0); PG8_MMA(1, 0, At, B0); PG8_BAR; PG8_SCHED;
            PG8_STAGE(PG8_SB(1, 1), b3 + hstep, voffB);
            PG8_WAIT_V(6); PG8_BAR; PG8_MMA(1, 1, At, B1); PG8_BAR;
            }
        }
        if constexpr (ALIGN_EPI) { if (wr == 0) PG8_BAR; }
        if constexpr (!Epi::AFTER_DRAIN) { E(acc, cur, wr, wc, fr, fq); S.done(cur); }
        if (!has_next) break;
#pragma unroll
        for (int a = 0; a < 2; ++a)
#pragma unroll
            for (int b = 0; b < 2; ++b)
#pragma unroll
                for (int m = 0; m < 4; ++m)
#pragma unroll
                    for (int n = 0; n < 2; ++n) acc[a][b][m][n] = (f32x4){0.f, 0.f, 0.f, 0.f};
        cur = nxt; cA = nA; cB = nB; ++ui;
        if constexpr (ALIGN_EPI) { if (wr == 1) PG8_BAR; }
    }
    PG8_WAIT_V(0);
    if constexpr (!ALIGN_EPI) { if (wr == 0) PG8_BAR; }
    PG8_BAR;
    if constexpr (Epi::AFTER_DRAIN) { E.fused(acc, cur, wr, wc, fr, fq, lds, wid, lane); S.done(cur); }
#undef PG8_SA
#undef PG8_SB
#undef PG8_STAGE
#undef PG8_LDA
#undef PG8_LDB
#undef PG8_MMA
#undef PG8_WAIT_V
#undef PG8_WAIT_L
#undef PG8_BAR
#undef PG8_SCHED
}
}
constexpr int NB = 4, SEQ = 4096, DM = 2048, NL = 4, M = NB * SEQ;
constexpr int DIN = 3392, DINP = 3584;
constexpr int NH = 8, DQK = 192, QRANK = 512, KVRANK = 256;
constexpr int DFF = 5504, DFF2 = 11008;
constexpr float EPS = 1e-6f;
constexpr int PC_S5 = 0, PC_CQ = 512, PC_CKV = 1024, PC_HQ = 1280, PC_HF = 1792, PC_HI = 2304, PC_HG = 2816, PC_KR = 3328;
constexpr int NWAVES = 8, NTHR = 512;
constexpr int LDS_BYTES = 147456, RING_BYTES = 131072, CTRL_OFF = LDS_BYTES - 2048, MISC_OFF = CTRL_OFF + 320;

enum { I_X = 0, I_C, I_POS, I_WIN, I_LRE, I_LIM, I_LDT, I_BRE, I_BIM, I_CRE, I_CIM, I_S5D, I_WGLU, I_QN, I_WUQ, I_KVN, I_WUKV, I_LB, I_HGN, I_WOUT,
       I_MPRE, I_MPOST, I_FPRE, I_FPOST, I_WUP, I_CW, I_CB, I_WDN, I_WADA, I_BADA, N_IN };

constexpr size_t MiB = 1u << 20;
#ifndef MK_ONE_LAUNCH
#define MK_ONE_LAUNCH 1
#endif
constexpr size_t WS_CTL = 0, CTL_ZERO_BYTES = 1 * MiB;
constexpr int CW_BAR = 4096;
constexpr size_t WS_MODP = 1 * MiB;
constexpr size_t WS_MOD = 13 * MiB;
constexpr size_t WS_COS = 14 * MiB, WS_SIN = 16 * MiB;
constexpr size_t WS_LB = 18 * MiB;
constexpr size_t WS_RSTDQ = 18 * MiB + 65536, WS_RSTDKV = 18 * MiB + 2 * 65536;
constexpr size_t WS_W = 19 * MiB;
constexpr size_t WL_IN = 0, WL_UQ = WL_IN + (size_t)DINP * DM * 2, WL_GLU = WL_UQ + (size_t)1536 * 512 * 2  , WL_UKV = WL_GLU + (size_t)512 * 512 * 2,
                 WL_OUT = WL_UKV + (size_t)2048 * 256 * 2, WL_UP = WL_OUT + (size_t)DM * DM * 2, WL_DN = WL_UP + (size_t)DFF2 * DM * 2, WL_SIZE = WL_DN + (size_t)DM * DFF * 2;
static_assert(WL_SIZE == 93847552, "weight bytes per layer");
constexpr size_t WS_X = 378 * MiB;
constexpr size_t WS_H = 506 * MiB;
constexpr size_t WS_T1 = 570 * MiB;
constexpr size_t WS_T2 = 914 * MiB;
constexpr size_t WS_ACT = 1138 * MiB;
constexpr size_t WS_CAT = 1310 * MiB;
constexpr size_t WS_MISC = 1374 * MiB;
constexpr size_t WS_CQ = WS_MISC, WS_CKV = WS_MISC + 16 * MiB, WS_YG16 = WS_MISC + 24 * MiB, WS_DS5 = WS_MISC + 40 * MiB, WS_HP = WS_MISC + 44 * MiB, WS_BLAST = WS_MISC + 46 * MiB;
constexpr size_t WS_U16 = WS_T1, WS_HQ = WS_T1 + 16 * MiB, WS_LOGF = WS_T1 + 32 * MiB, WS_HV = WS_T1 + 64 * MiB, WS_HGT = WS_T1 + 80 * MiB;
constexpr size_t WS_SSQQ = WS_MISC + 47 * MiB, WS_SSQKV = WS_MISC + 47 * MiB + 512 * 1024;
constexpr size_t WS_DST = WS_T1 + 224 * MiB;
constexpr size_t WS_S5T = WS_T1 + 96 * MiB;
constexpr size_t WS_HALO = WS_T1 + 310 * MiB;
constexpr size_t WS_SPT = WS_ACT + 128 * MiB;
constexpr size_t WS_PW = 1510 * MiB;
constexpr size_t WS_BBAR = 1515 * MiB;
constexpr size_t WS_END = 1516 * MiB;
static_assert(WS_W + NL * WL_SIZE <= WS_X, "weights fit");

#define GAS __attribute__((address_space(1)))
#define LAS __attribute__((address_space(3)))
typedef unsigned short bf16;
typedef unsigned v4u __attribute__((ext_vector_type(4)));
typedef unsigned v2u __attribute__((ext_vector_type(2)));
typedef float f32x4 __attribute__((ext_vector_type(4)));
typedef GAS unsigned gu32;
#define RLX_AGENT __ATOMIC_RELAXED, __HIP_MEMORY_SCOPE_AGENT
#define LDS_WAIT() asm volatile("s_waitcnt lgkmcnt(0)" ::: "memory")
__device__ __forceinline__ unsigned f2bf(float f) { unsigned u = __builtin_bit_cast(unsigned, f); return (u + 0x7fffu + ((u >> 16) & 1u)) >> 16; }
__device__ __forceinline__ unsigned pk2(float lo, float hi) { return f2bf(lo) | (f2bf(hi) << 16); }
__device__ __forceinline__ float bf2f(unsigned short b) { return __builtin_bit_cast(float, ((unsigned)b) << 16); }
__device__ __forceinline__ float wave_sum(float v) {
#pragma unroll
    for (int o = 1; o < 64; o <<= 1) v += __shfl_xor(v, o);
    return v;
}
__device__ __forceinline__ float sigmoidf_(float x) { return 1.f / (1.f + __expf(-x)); }
__device__ __forceinline__ float siluf_(float x) { return x / (1.f + __expf(-x)); }
__device__ __forceinline__ float gelu_tanh(float x) { const float t = 0.7978845608028654f * (x + 0.044715f * x * x * x); return x / (1.f + __expf(-2.f * t)); }
#define XB_TMO      128
#define XB_XCNT(j)  (256  + 64 * (j))
#define XB_XSUB(j)  (1280 + 64 * (j))
#define XB_XGEN(j)  (2304 + 64 * (j))
#define XB_TOP      3328
#define XB_TOPGEN   3392
#define XCD_BAR_WORDS 3456
#define XB_SPIN_CAP (1u << 18)

__device__ __forceinline__ unsigned xb_ld(unsigned* p)              { return __hip_atomic_load(p, __ATOMIC_RELAXED, __HIP_MEMORY_SCOPE_AGENT); }
__device__ __forceinline__ unsigned xb_add(unsigned* p, unsigned v) { return __hip_atomic_fetch_add(p, v, __ATOMIC_RELAXED, __HIP_MEMORY_SCOPE_AGENT); }
__device__ __forceinline__ unsigned xb_xcc_id() { return (unsigned)__builtin_amdgcn_s_getreg((3 << 11) | 20) & 0xFu; }
#define XB_SPIN(cond, bar) do { unsigned _sp = 0; while (cond) { __builtin_amdgcn_s_sleep(1); \
    if ((++_sp & 255u) == 0u) { if (xb_ld(&(bar)[XB_TMO])) break; if (_sp > XB_SPIN_CAP) { atomicAdd(&(bar)[XB_TMO], 1u); break; } } } } while (0)

struct XcdBarrier {
    unsigned* bar; unsigned x;
    volatile LAS unsigned* st;
};

__device__ __forceinline__ XcdBarrier xcd_barrier_post(unsigned* bar, volatile LAS unsigned* st) {
    XcdBarrier b; b.bar = bar; b.x = xb_xcc_id(); b.st = st;
    if (threadIdx.x == 0) (void)xb_add(&bar[XB_XCNT(b.x)], 1u);
    return b;
}
__device__ __forceinline__ void xcd_barrier_complete(unsigned* bar, unsigned x, unsigned& nloc, unsigned& nx) {
    const unsigned G = gridDim.x * gridDim.y * gridDim.z;
    unsigned sum, cnt, mine, sp = 0u;
    for (;;) {
        sum = 0u; cnt = 0u; mine = 0u;
#pragma unroll
        for (unsigned j = 0; j < 16; ++j) { const unsigned c = xb_ld(&bar[XB_XCNT(j)]); sum += c; cnt += (c > 0u) ? 1u : 0u; mine = (j == x) ? c : mine; }
        if (sum == G) break;
        __builtin_amdgcn_s_sleep(1);
        if ((++sp & 255u) == 0u) { if (xb_ld(&bar[XB_TMO])) break; if (sp > XB_SPIN_CAP) { atomicAdd(&bar[XB_TMO], 1u); break; } }
    }
    nloc = mine > 0u ? mine : 1u; nx = cnt > 0u ? cnt : 1u;
}

__device__ __forceinline__ void xcd_barrier(const XcdBarrier& b) {
    asm volatile("s_waitcnt vmcnt(0)" ::: "memory");
    __syncthreads();
    if (threadIdx.x == 0) {
        unsigned* bar = b.bar;
        __builtin_amdgcn_s_waitcnt(0);
        unsigned nloc = b.st[0], nx = b.st[1];
        if (nloc == 0u) { xcd_barrier_complete(bar, b.x, nloc, nx); b.st[0] = nloc; b.st[1] = nx; }
        const unsigned old = xb_add(&bar[XB_XSUB(b.x)], 1u);
        const unsigned gen = old / nloc;
        if (old + 1u == (gen + 1u) * nloc) {
            __builtin_amdgcn_fence(__ATOMIC_RELEASE, "agent");
            asm volatile("s_waitcnt vmcnt(0)" ::: "memory");
            const unsigned og = xb_add(&bar[XB_TOP], 1u);
            const unsigned tg = og / nx;
            if (og + 1u == (tg + 1u) * nx) xb_add(&bar[XB_TOPGEN], 1u);
            else XB_SPIN(xb_ld(&bar[XB_TOPGEN]) == tg, bar);
            __builtin_amdgcn_fence(__ATOMIC_ACQUIRE, "agent");
            xb_add(&bar[XB_XGEN(b.x)], 1u);
            asm volatile("s_waitcnt vmcnt(0)" ::: "memory");
        } else {
            XB_SPIN(xb_ld(&bar[XB_XGEN(b.x)]) == gen, bar);
            __builtin_amdgcn_fence(__ATOMIC_ACQUIRE, "agent");
            asm volatile("s_waitcnt vmcnt(0)" ::: "memory");
        }
    }
    __syncthreads();
}
namespace att {
typedef short bf16x8 __attribute__((ext_vector_type(8)));
typedef short s16x4 __attribute__((ext_vector_type(4)));
typedef float f32x16 __attribute__((ext_vector_type(16)));
typedef float f32x4 __attribute__((ext_vector_type(4)));
typedef unsigned u32x4 __attribute__((ext_vector_type(4)));
constexpr int DQ = 192, DVV = 128, QBLK = 32, KVBLK = 64, QB = 256;
constexpr int SHM_V = KVBLK * DVV * 2, SHM_K = KVBLK * DQ * 2;
constexpr int LDS_V = 0, LDS_K = 3 * SHM_V, LDS_WS = LDS_K + 2 * SHM_K, LDS_OST = LDS_WS + 8 * 64 * 4, ATT_LDS = LDS_OST;
constexpr float SCALE = 0.07216878364870322f;
constexpr float QSCALE = SCALE * 1.4426950408889634f;
constexpr float THR2 = 8.f * 1.4426950408889634f;
#define SBAR() __builtin_amdgcn_sched_barrier(0)
__device__ __forceinline__ int v_st(int k, int c) { const int kk = (k & ~0xC) | ((k & 4) << 1) | ((k & 8) >> 1); return ((kk >> 3) * 4 + (c >> 5)) * 512 + ((kk & 7) * 32 + (c & 31)) * 2; }
__device__ __forceinline__ int v_rd_base(int lane) { return ((lane & 3) << 3) | (((lane >> 2) & 3) << 6) | (((lane >> 4) & 1) << 5) | (((lane >> 5) & 1) << 8); }
constexpr int v_rd_off(int d0, int ks, int half) { return d0 * 512 + ks * 4096 + half * 2048; }
__device__ __forceinline__ int crow(int r, int hi) { return (r & 3) + 8 * (r >> 2) + 4 * hi; }
__device__ __forceinline__ unsigned cvtpk(float lo, float hi) { typedef float f2_ __attribute__((ext_vector_type(2))); typedef __bf16 b2_ __attribute__((ext_vector_type(2))); const b2_ r = __builtin_convertvector((f2_){lo, hi}, b2_); return __builtin_bit_cast(unsigned, r); }
__device__ __forceinline__ int k_off(int row, int chunk  ) { return (chunk >> 3) * 8192 + row * 128 + ((((chunk & 7) ^ ((row >> 1) & 7))) << 4); }

__device__ __forceinline__ void mask_tile(f32x16& p0, f32x16& p1, int dq) {
    const float NEG = -__builtin_inff();
#pragma unroll
    for (int r = 0; r < 16; ++r) { const int c = (r & 3) + 8 * (r >> 2);
        if (dq - c < 0) p0[r] = NEG;
        if (dq - c - 32 < 0) p1[r] = NEG; }
}
__device__ __forceinline__ void partialSM(f32x16& p0, f32x16& p1, float& m_reg, float bs, float& alpha) {
    float pmax = p0[0];
#pragma unroll
    for (int r = 1; r < 16; ++r) pmax = fmaxf(pmax, p0[r]);
#pragma unroll
    for (int r = 0; r < 16; ++r) pmax = fmaxf(pmax, p1[r]);
    { auto rr = __builtin_amdgcn_permlane32_swap(__float_as_uint(pmax), __float_as_uint(pmax), false, false);
      pmax = fmaxf(__uint_as_float(rr[0]), __uint_as_float(rr[1])); }
    if (__builtin_expect(__all(pmax + bs - m_reg <= THR2), 1)) { alpha = 1.f; }
    else { const float mn = fmaxf(m_reg, pmax + bs); alpha = __builtin_amdgcn_exp2f(m_reg - mn); const float off = bs - mn; m_reg = mn;
#pragma unroll
        for (int r = 0; r < 16; ++r) { p0[r] += off; p1[r] += off; } }
#pragma unroll
    for (int r = 0; r < 16; ++r) p0[r] = __builtin_amdgcn_exp2f(p0[r]);
#pragma unroll
    for (int r = 0; r < 16; ++r) p1[r] = __builtin_amdgcn_exp2f(p1[r]);
}
__device__ __forceinline__ void finishSM(f32x16& p0, f32x16& p1, float alpha, float& l_reg, bf16x8& pa0, bf16x8& pa1, bf16x8& pa2, bf16x8& pa3) {
    float ps = 0;
#pragma unroll
    for (int r = 0; r < 16; ++r) ps += p0[r];
#pragma unroll
    for (int r = 0; r < 16; ++r) ps += p1[r];
    { auto rr = __builtin_amdgcn_permlane32_swap(__float_as_uint(ps), __float_as_uint(ps), false, false);
      ps = __uint_as_float(rr[0]) + __uint_as_float(rr[1]); }
    l_reg = l_reg * alpha + ps;
#define PK4(P, B_, OUT) do { unsigned a0 = cvtpk(P[B_+0], P[B_+1]), a1 = cvtpk(P[B_+2], P[B_+3]);                          \
        unsigned b0 = cvtpk(P[B_+4], P[B_+5]), b1 = cvtpk(P[B_+6], P[B_+7]);                                             \
        auto r0 = __builtin_amdgcn_permlane32_swap(a0, b0, false, false); auto r1 = __builtin_amdgcn_permlane32_swap(a1, b1, false, false); \
        u32x4 w = {r0[0], r1[0], r0[1], r1[1]}; OUT = *reinterpret_cast<bf16x8*>(&w); } while (0)
    PK4(p0, 0, pa0); PK4(p0, 8, pa1); PK4(p1, 0, pa2); PK4(p1, 8, pa3);
#undef PK4
}
__device__ __forceinline__ void qkt(f32x16& p0, f32x16& p1, const LAS unsigned char* lds, int kbuf, int r32, int hi, const bf16x8* qr, float init) {
#pragma unroll
    for (int r = 0; r < 16; ++r) { p0[r] = init; p1[r] = init; }
    const int e = hi ^ ((r32 >> 1) & 7);
    int kb[4];
#pragma unroll
    for (int j = 0; j < 4; ++j) kb[j] = (int)(uintptr_t)lds + kbuf + r32 * 128 + ((((j << 1) ^ e)) << 4);
#define KRD(dst, d0_, h_) asm volatile("ds_read_b128 %0, %1 offset:%2" : "=&v"(dst) : "v"(kb[(d0_) & 3]), "i"(((d0_) >> 2) * 8192 + (h_) * 4096) : "memory")
    bf16x8 ka[3][2];
    KRD(ka[0][0], 0, 0); KRD(ka[0][1], 0, 1); KRD(ka[1][0], 1, 0); KRD(ka[1][1], 1, 1);
#pragma unroll
    for (int d0 = 0; d0 < 12; ++d0) {
        if (d0 + 2 < 12) { KRD(ka[(d0 + 2) % 3][0], d0 + 2, 0); KRD(ka[(d0 + 2) % 3][1], d0 + 2, 1); asm volatile("s_waitcnt lgkmcnt(4)" ::: "memory"); }
        else if (d0 == 10) asm volatile("s_waitcnt lgkmcnt(2)" ::: "memory");
        else asm volatile("s_waitcnt lgkmcnt(0)" ::: "memory");
        SBAR();
        p0 = __builtin_amdgcn_mfma_f32_32x32x16_bf16(ka[d0 % 3][0], qr[d0], p0, 0, 0, 0);
        p1 = __builtin_amdgcn_mfma_f32_32x32x16_bf16(ka[d0 % 3][1], qr[d0], p1, 0, 0, 0);
        SBAR(); }
#undef KRD
}
__device__ __forceinline__ void pv_tile(f32x16* o, int vb0, bf16x8 pa0, bf16x8 pa1, bf16x8 pa2, bf16x8 pa3) {
#define TRRD(dst, off) asm volatile("ds_read_b64_tr_b16 %0, %1 offset:%2" : "=&v"(dst) : "v"(vb0), "i"(off) : "memory")
#define PV_D0(d0) do { s16x4 l0, l1, l2, l3, h0, h1, h2, h3; constexpr int b_ = v_rd_off(d0, 0, 0); \
        TRRD(l0, b_); TRRD(h0, b_ + 2048); TRRD(l1, b_ + 4096); TRRD(h1, b_ + 6144); TRRD(l2, b_ + 8192); TRRD(h2, b_ + 10240); TRRD(l3, b_ + 12288); TRRD(h3, b_ + 14336); \
        asm volatile("s_waitcnt lgkmcnt(0)" ::: "memory"); SBAR();   \
        o[d0] = __builtin_amdgcn_mfma_f32_32x32x16_bf16(pa0, (bf16x8){l0[0], l0[1], l0[2], l0[3], h0[0], h0[1], h0[2], h0[3]}, o[d0], 0, 0, 0);   \
        o[d0] = __builtin_amdgcn_mfma_f32_32x32x16_bf16(pa1, (bf16x8){l1[0], l1[1], l1[2], l1[3], h1[0], h1[1], h1[2], h1[3]}, o[d0], 0, 0, 0);   \
        o[d0] = __builtin_amdgcn_mfma_f32_32x32x16_bf16(pa2, (bf16x8){l2[0], l2[1], l2[2], l2[3], h2[0], h2[1], h2[2], h2[3]}, o[d0], 0, 0, 0);   \
        o[d0] = __builtin_amdgcn_mfma_f32_32x32x16_bf16(pa3, (bf16x8){l3[0], l3[1], l3[2], l3[3], h3[0], h3[1], h3[2], h3[3]}, o[d0], 0, 0, 0); } while (0)
    PV_D0(0); PV_D0(1); PV_D0(2); PV_D0(3);
#undef PV_D0
#undef TRRD
}
__device__ __forceinline__ void attn_block(const unsigned short* Q, const unsigned short* K, const unsigned short* V, unsigned short* O, int opitch, int qb, LAS unsigned char* lds) {
    int tid_ = threadIdx.x; asm volatile("" : "+v"(tid_));
    const int tid = tid_, wid = __builtin_amdgcn_readfirstlane(tid >> 6), lane = tid & 63, r32 = lane & 31, hi = lane >> 5;
    const int P0 = qb * QB, NT = (P0 + QB) / KVBLK;
    const int qlo = P0 + wid * QBLK, qpos = qlo + r32;
    LAS float* wsf = (LAS float*)(lds + LDS_WS) + wid * 64; LAS float* li_l = wsf; LAS float* al_l = wsf + 32;
    int voff[2], koff[3];
#pragma unroll
    for (int i = 0; i < 2; ++i) { const int P = (wid * 2 + i) * 1024 + lane * 16, sub = P >> 9, within = P & 511, kk = (sub >> 2) * 8 + (within >> 6);
        const int k = (kk & ~0xC) | ((kk & 4) << 1) | ((kk & 8) >> 1), c = (sub & 3) * 32 + ((within & 63) >> 1); voff[i] = k * DVV + c; }
#pragma unroll
    for (int i = 0; i < 3; ++i) { const int P = (wid * 3 + i) * 1024 + lane * 16, sblk = P >> 13, rem = P & 8191, row = rem >> 7, cc = ((rem & 127) >> 4) ^ ((row >> 1) & 7); koff[i] = row * DQ + sblk * 64 + cc * 8; }
    bf16x8 qr[12];
#pragma unroll
    for (int d0 = 0; d0 < 12; ++d0) qr[d0] = *(const bf16x8*)(Q + (size_t)(P0 + wid * QBLK + r32) * DQ + d0 * 16 + hi * 8);
#define SDMA(kb0, kbuf, vbuf) do { \
        _Pragma("unroll") for (int i = 0; i < 2; ++i) __builtin_amdgcn_global_load_lds((const unsigned*)(V + (size_t)(kb0) * DVV + voff[i]), (LAS unsigned*)(lds + LDS_V + (vbuf) * SHM_V + (wid * 2 + i) * 1024), 16, 0, 0); \
        _Pragma("unroll") for (int i = 0; i < 3; ++i) __builtin_amdgcn_global_load_lds((const unsigned*)(K + (size_t)(kb0) * DQ + koff[i]), (LAS unsigned*)(lds + LDS_K + (kbuf) * SHM_K + (wid * 3 + i) * 1024), 16, 0, 0); } while (0)
    __syncthreads();
    SDMA(0, 0, 0);
    asm volatile("s_waitcnt vmcnt(0)" ::: "memory"); __syncthreads();
    float m_reg = -1e30f, l_reg = 0.f; f32x16 o[4] = {};
    const int vbase = (int)(uintptr_t)(lds + LDS_V) + v_rd_base(lane);
    const bool late = wid >= 4;
    f32x16 p0, p1; float bs = 0.f; bool pend = false; int pt = 0;
#define SMPV() do { float alpha; bf16x8 pa0, pa1, pa2, pa3; \
        partialSM(p0, p1, m_reg, bs, alpha); finishSM(p0, p1, alpha, l_reg, pa0, pa1, pa2, pa3); \
        if (__any(alpha < 1.f)) { if (hi == 0) al_l[r32] = alpha; asm volatile("s_waitcnt lgkmcnt(0)" ::: "memory"); \
            _Pragma("unroll") for (int d_ = 0; d_ < 4; ++d_) _Pragma("unroll") for (int r = 0; r < 16; ++r) o[d_][r] *= al_l[crow(r, hi)]; } \
        pv_tile(o, vbase + (pt % 3) * SHM_V, pa0, pa1, pa2, pa3); pend = false; } while (0)
    for (int t = 0; t <= NT; ++t) {
        if (t + 1 < NT) SDMA((t + 1) * KVBLK, (t & 1) ^ 1, (t + 1) % 3);
        if (late && pend) SMPV();
        if (t < NT && t * KVBLK <= qlo + QBLK - 1) {
            bs = m_reg > -1e29f ? m_reg : 0.f;
            qkt(p0, p1, lds, LDS_K + (t & 1) * SHM_K, r32, hi, qr, -bs);
            if (t * KVBLK + KVBLK - 1 > qlo) mask_tile(p0, p1, qpos - t * KVBLK - 4 * hi);
            pend = true; pt = t; }
        if (!late && pend) SMPV();
        asm volatile("s_waitcnt vmcnt(0)" ::: "memory"); __syncthreads();
    }
#undef SMPV
    if (hi == 0) li_l[r32] = l_reg; asm volatile("s_waitcnt lgkmcnt(0)" ::: "memory");
    unsigned short* Ow = O + (size_t)(P0 + wid * QBLK) * opitch;
#pragma unroll
    for (int r = 0; r < 16; ++r) { const int orow = crow(r, hi); const float rl = __builtin_amdgcn_rcpf(li_l[orow]);
#pragma unroll
        for (int d0 = 0; d0 < 4; ++d0) { const float v = o[d0][r] * rl; const float vn = __shfl_xor(v, 1);
            if ((r32 & 1) == 0) *(unsigned*)(Ow + (size_t)orow * opitch + d0 * 32 + r32) = cvtpk(v, vn); } }
#undef SDMA
}
#undef SBAR
}
struct Args { const void* in[N_IN]; float* out; unsigned char* ws; int ph_lo, ph_hi; };
struct Frame {
    LAS unsigned char* lds; unsigned char* ldsg;
    int tid, lane, wave, G, bid;
    unsigned char* ws;
    const void* const* in;
};
constexpr int PTAB_OFF = CTRL_OFF + 1024;
__device__ __forceinline__ const void* ldp(const Frame& F, int i) {
    const unsigned long long v = ((const LAS unsigned long long*)(F.lds + PTAB_OFF))[i];
    const unsigned lo = __builtin_amdgcn_readfirstlane((unsigned)v), hi = __builtin_amdgcn_readfirstlane((unsigned)(v >> 32));
    return (const void*)(const GAS void*)(((unsigned long long)hi << 32) | lo); }
#define INF(i) ((const float*)ldp(F, i))
__device__ __forceinline__ bf16* wt(const Frame& F, int l, size_t off) { return (bf16*)(F.ws + WS_W + (size_t)l * WL_SIZE + off); }

__device__ __forceinline__ void tr_item(const float* W, int ldw, int K, int k0, int sc, const float* kscale, bf16* dst  , LAS float* scr, int lane) {
    float v[64];
    const float* src = W + (size_t)k0 * ldw + (sc >= 0 ? sc : 0);
#pragma unroll
    for (int i = 0; i < 64; ++i) v[i] = sc >= 0 ? src[(size_t)i * ldw] : 0.f;
#pragma unroll
    for (int i = 0; i < 64; ++i) scr[i * 65 + lane] = v[i];
    LDS_WAIT(); asm volatile("" ::: "memory");
    const int c = lane & 7;
    f32x4 ks0 = (f32x4){1.f, 1.f, 1.f, 1.f}, ks1 = ks0;
    if (kscale) { ks0 = *(const f32x4*)(kscale + k0 + 8 * c); ks1 = *(const f32x4*)(kscale + k0 + 8 * c + 4); }
#pragma unroll
    for (int j = 0; j < 8; ++j) { const int n = (lane >> 3) + 8 * j; const LAS float* s = scr + (8 * c) * 65 + n;
        v4u o; o.x = pk2(s[0 * 65] * ks0.x, s[1 * 65] * ks0.y); o.y = pk2(s[2 * 65] * ks0.z, s[3 * 65] * ks0.w); o.z = pk2(s[4 * 65] * ks1.x, s[5 * 65] * ks1.y); o.w = pk2(s[6 * 65] * ks1.z, s[7 * 65] * ks1.w);
        *(v4u*)(dst + (size_t)n * K + k0 + 8 * c) = o; }
    LDS_WAIT(); asm volatile("" ::: "memory");
}
__device__ __forceinline__ int uq_srccol(int n) {
    if (n < 1024) return (n >> 7) * 192 + (n & 127);
    const int r = n - 1024, h = r >> 6, pos = r & 63, i = pos >> 3, e = pos & 7, f = 4 * i + (e & 3);
    return h * 192 + 128 + (e < 4 ? f : 32 + f);
}
__device__ __forceinline__ int win_srccol(int n) {
    if (n < 1280) return n;
    if (n < 3328) return n + 64;
    if (n < 3392) { const int pos = n - 3328, i = pos >> 3, e = pos & 7, f = 4 * i + (e & 3); return 1280 + (e < 4 ? f : 32 + f); }
    return -1;
}

namespace mx {
typedef short bf16x8 __attribute__((ext_vector_type(8)));
typedef float f32x16 __attribute__((ext_vector_type(16)));
__device__ __forceinline__ int crow(int r, int hi) { return (r & 3) + 8 * (r >> 2) + 4 * hi; }
__device__ __forceinline__ unsigned cvtpk(float lo, float hi) { typedef float f2_ __attribute__((ext_vector_type(2))); typedef __bf16 b2_ __attribute__((ext_vector_type(2))); const b2_ r = __builtin_convertvector((f2_){lo, hi}, b2_); return __builtin_bit_cast(unsigned, r); }
__device__ __forceinline__ bf16x8 pack8g(const float* p) { const f32x4 a = *(const f32x4*)p, b = *(const f32x4*)(p + 4); v4u w = {cvtpk(a.x, a.y), cvtpk(a.z, a.w), cvtpk(b.x, b.y), cvtpk(b.z, b.w)}; return *reinterpret_cast<bf16x8*>(&w); }
__device__ __forceinline__ bf16x8 pack8f(const float* v) { v4u w = {cvtpk(v[0], v[1]), cvtpk(v[2], v[3]), cvtpk(v[4], v[5]), cvtpk(v[6], v[7])}; return *reinterpret_cast<bf16x8*>(&w); }
#define MX_MFMA(a, b, c) __builtin_amdgcn_mfma_f32_32x32x16_bf16(a, b, c, 0, 0, 0)
__device__ __forceinline__ void acc_to_A(const f32x16& p, bf16x8& lo, bf16x8& hi) {
#define PK4(P, B_, OUT) do { unsigned a0 = cvtpk(P[B_+0], P[B_+1]), a1 = cvtpk(P[B_+2], P[B_+3]);                          \
        unsigned b0 = cvtpk(P[B_+4], P[B_+5]), b1 = cvtpk(P[B_+6], P[B_+7]);                                             \
        auto r0 = __builtin_amdgcn_permlane32_swap(a0, b0, false, false); auto r1 = __builtin_amdgcn_permlane32_swap(a1, b1, false, false); \
        v4u w = {r0[0], r1[0], r0[1], r1[1]}; OUT = *reinterpret_cast<bf16x8*>(&w); } while (0)
    PK4(p, 0, lo); PK4(p, 8, hi);
#undef PK4
}
}

constexpr size_t S5T_WIN = 0, S5T_KT = S5T_WIN + 128 * 1024 * 2, S5T_WOUT = S5T_KT + 65 * 256 * 2, S5T_L64 = S5T_WOUT + 1024 * 128 * 2, S5T_PW = S5T_L64 + 512, S5T_SIZE = S5T_PW + 65 * 64 * 8 + 256;
static_assert(S5T_SIZE % 16 == 0, "table alignment");
__device__ __forceinline__ void s5_tables_a(Frame& F) {
    const int gt = F.bid * NTHR + F.tid, NGT = F.G * NTHR;
    for (int i = gt; i < NL * 32 * 65 * 64; i += NGT) {
        const int p = i & 63, j = (i >> 6) % 65, lg = i / (65 * 64);
        const float lre = INF(I_LRE)[lg * 64 + p], lim = INF(I_LIM)[lg * 64 + p];
        const float dt = expf(INF(I_LDT)[lg]);
        const float er = expf(lre * dt * (float)j); float sn, cs; sincosf(lim * dt * (float)j, &sn, &cs);
        ((float2*)(F.ws + WS_PW))[i] = make_float2(er * cs, er * sn);
    }
    for (int i = gt; i < NL * 32 * 64 * 16; i += NGT) {
        const int lgp = i >> 4, lg = i >> 10;
        const float lre = INF(I_LRE)[lgp], lim = INF(I_LIM)[lgp];
        const float dt = expf(INF(I_LDT)[lg]);
        const float er = expf(lre * dt); float sn, cs; sincosf(lim * dt, &sn, &cs);
        const float nr = er * cs - 1.f, ni = er * sn, den = lre * lre + lim * lim;
        const float cr = (nr * lre + ni * lim) / den, ci = (ni * lre - nr * lim) / den;
        const float xr = INF(I_BRE)[i], xi = INF(I_BIM)[i];
        ((float2*)(F.ws + WS_BBAR))[i] = make_float2(cr * xr - ci * xi, cr * xi + ci * xr);
    }
}
__device__ __forceinline__ void s5_tables_b(Frame& F, int l, int gt, int NGT) {
    const float2* pwl = (const float2*)(F.ws + WS_PW) + (size_t)l * 32 * 65 * 64;
    const float2* bbl = (const float2*)(F.ws + WS_BBAR) + (size_t)l * 32 * 64 * 16;
    const float* crl = INF(I_CRE) + (size_t)l * 32 * 16 * 64; const float* cil = INF(I_CIM) + (size_t)l * 32 * 16 * 64;
    for (int i = gt; i < 32 * 128 * 128; i += NGT) {
        const int k0 = (i & 127) * 8, n = (i >> 7) & 127, g = i >> 14;
        const int p = n & 63, ri = n >> 6, s = k0 >> 4, c0 = k0 & 15;
        const float2 w = pwl[(g * 65 + 63 - s) * 64 + p]; const f32x4* bp = (const f32x4*)(bbl + (g * 64 + p) * 16 + c0); float o[8];
#pragma unroll
        for (int q = 0; q < 4; ++q) { const f32x4 b2 = bp[q];
            o[2 * q] = ri ? (w.x * b2.y + w.y * b2.x) : (w.x * b2.x - w.y * b2.y); o[2 * q + 1] = ri ? (w.x * b2.w + w.y * b2.z) : (w.x * b2.z - w.y * b2.w); }
        *(v4u*)((bf16*)(F.ws + WS_S5T + (size_t)(l * 32 + g) * S5T_SIZE + S5T_WIN) + n * 1024 + k0) = (v4u){pk2(o[0], o[1]), pk2(o[2], o[3]), pk2(o[4], o[5]), pk2(o[6], o[7])};
    }
    for (int i = gt; i < 32 * 1024 * 16; i += NGT) {
        const int k0 = (i & 15) * 8, n = (i >> 4) & 1023, g = i >> 14;
        const int p0 = k0 & 63, ri = k0 >> 6, t = n >> 4, c = n & 15;
        const f32x4* wp = (const f32x4*)(pwl + (g * 65 + t + 1) * 64 + p0); const f32x4* crp = (const f32x4*)(crl + (g * 16 + c) * 64 + p0); const f32x4* cip = (const f32x4*)(cil + (g * 16 + c) * 64 + p0);
        const f32x4 cr0 = crp[0], cr1 = crp[1], ci0 = cip[0], ci1 = cip[1]; const float cr[8] = {cr0[0], cr0[1], cr0[2], cr0[3], cr1[0], cr1[1], cr1[2], cr1[3]}, ci[8] = {ci0[0], ci0[1], ci0[2], ci0[3], ci1[0], ci1[1], ci1[2], ci1[3]};
        float o[8];
#pragma unroll
        for (int q = 0; q < 4; ++q) { const f32x4 w2 = wp[q];
            o[2 * q] = ri ? -(cr[2 * q] * w2.y + ci[2 * q] * w2.x) : (cr[2 * q] * w2.x - ci[2 * q] * w2.y);
            o[2 * q + 1] = ri ? -(cr[2 * q + 1] * w2.w + ci[2 * q + 1] * w2.z) : (cr[2 * q + 1] * w2.z - ci[2 * q + 1] * w2.w); }
        *(v4u*)((bf16*)(F.ws + WS_S5T + (size_t)(l * 32 + g) * S5T_SIZE + S5T_WOUT) + n * 128 + k0) = (v4u){pk2(o[0], o[1]), pk2(o[2], o[3]), pk2(o[4], o[5]), pk2(o[6], o[7])};
    }
    for (int i = gt; i < 32 * 64; i += NGT) { const int p = i & 63, g = i >> 6; const float2 w = pwl[(g * 65 + 64) * 64 + p];
        float* l64 = (float*)(F.ws + WS_S5T + (size_t)(l * 32 + g) * S5T_SIZE + S5T_L64); l64[p] = w.x; l64[64 + p] = w.y; }
    for (int i = gt; i < 32 * 65 * 16; i += NGT) {
        const int cc0 = (i & 3) * 4, c0 = ((i >> 2) & 3) * 4, li = (i >> 4) % 65, g = i / (65 * 16);
        float acc[4][4];
#pragma unroll
        for (int a = 0; a < 4; ++a)
#pragma unroll
            for (int b = 0; b < 4; ++b) acc[a][b] = 0.f;
        if (li > 0) {
            for (int p = 0; p < 64; ++p) {
                const float2 w = pwl[(g * 65 + li - 1) * 64 + p];
                float2 bv[4]; float cr[4], ci[4];
#pragma unroll
                for (int b = 0; b < 4; ++b) bv[b] = bbl[(g * 64 + p) * 16 + cc0 + b];
#pragma unroll
                for (int a = 0; a < 4; ++a) { cr[a] = crl[(g * 16 + c0 + a) * 64 + p]; ci[a] = cil[(g * 16 + c0 + a) * 64 + p]; }
#pragma unroll
                for (int a = 0; a < 4; ++a) { const float er = cr[a] * w.x - ci[a] * w.y, ei = cr[a] * w.y + ci[a] * w.x;
#pragma unroll
                    for (int b = 0; b < 4; ++b) acc[a][b] += er * bv[b].x - ei * bv[b].y; }
            }
        }
        bf16* kt = (bf16*)(F.ws + WS_S5T + (size_t)(l * 32 + g) * S5T_SIZE + S5T_KT) + li * 256;
#pragma unroll
        for (int a = 0; a < 4; ++a) *(v2u*)(kt + (c0 + a) * 16 + cc0) = (v2u){pk2(acc[a][0], acc[a][1]), pk2(acc[a][2], acc[a][3])};
    }
}
__device__ __forceinline__ void s5_step1_item(Frame& F, int l, int g, int rb, const bf16* u16, float* dS) {
    const int lane = F.lane, w = F.wave, c32 = lane & 31, hi = lane >> 5, cb = w & 3, kh = w >> 2;
    const int R = rb * 32 + c32, b = R >> 6, n = R & 63;
    const bf16* arow = u16 + ((size_t)b * SEQ + n * 64) * 512 + g * 16 + 8 * hi;
    const bf16* brow = (const bf16*)(F.ws + WS_S5T + (size_t)(l * 32 + g) * S5T_SIZE + S5T_WIN) + (size_t)(cb * 32 + c32) * 1024 + 8 * hi;
    mx::f32x16 acc = {};
#pragma unroll 8
    for (int s = kh * 32; s < kh * 32 + 32; ++s) {
        const mx::bf16x8 a = *(const mx::bf16x8*)(arow + (size_t)s * 512), bb = *(const mx::bf16x8*)(brow + s * 16);
        acc = MX_MFMA(a, bb, acc);
    }
    LAS float* red = (LAS float*)F.lds;
    __syncthreads();
    if (kh == 1) {
#pragma unroll
        for (int r = 0; r < 16; ++r) red[(cb * 16 + r) * 64 + lane] = acc[r]; }
    __syncthreads();
    if (kh == 0) {
#pragma unroll
        for (int r = 0; r < 16; ++r) { const float v = acc[r] + red[(cb * 16 + r) * 64 + lane];
            dS[((size_t)g * 256 + rb * 32 + mx::crow(r, hi)) * 128 + cb * 32 + c32] = v; } }
}
__device__ __forceinline__ void s5_step3_item(Frame& F, int l, int g, int rb, const bf16* u16, const float* dS, bf16* yg16) {
    const int lane = F.lane, w = F.wave, c32 = lane & 31, hi = lane >> 5;
    LAS unsigned char* Ul = F.lds;
    LAS unsigned char* Kl = F.lds + 32 * 2064;
    __syncthreads();
    for (int i = F.tid; i < 32 * 128; i += NTHR) {
        const int ch = i & 1, s = (i >> 1) & 63, r = i >> 7; const int R = rb * 32 + r, b = R >> 6, n = R & 63;
        *(LAS v4u*)(Ul + r * 2064 + s * 32 + ch * 16) = *(const v4u*)(u16 + ((size_t)b * SEQ + n * 64 + s) * 512 + g * 16 + ch * 8); }
    { const v4u* kt = (const v4u*)(F.ws + WS_S5T + (size_t)(l * 32 + g) * S5T_SIZE + S5T_KT);
      for (int i = F.tid; i < 65 * 32; i += NTHR) *(LAS v4u*)(Kl + i * 16) = kt[i]; }
    LAS unsigned char* Hl = Kl + 65 * 512;
    if (F.tid < 64) {
        const int p = F.tid, bq = rb >> 1, n0 = (rb & 1) * 32;
        const float* l64 = (const float*)(F.ws + WS_S5T + (size_t)(l * 32 + g) * S5T_SIZE + S5T_L64);
        const float lr = l64[p], li = l64[64 + p];
        const float* dp = dS + ((size_t)g * 256 + bq * 64) * 128 + p;
        float hr = 0.f, hi2 = 0.f;
        for (int nb = 0; nb < n0 + 32; nb += 16) {
            float dr[16], di[16];
#pragma unroll
            for (int j = 0; j < 16; ++j) { dr[j] = dp[(size_t)(nb + j) * 128]; di[j] = dp[(size_t)(nb + j) * 128 + 64]; }
#pragma unroll
            for (int j = 0; j < 16; ++j) { const int n = nb + j;
                if (n >= n0) { *(LAS bf16*)(Hl + (n - n0) * 272 + p * 2) = (bf16)f2bf(hr); *(LAS bf16*)(Hl + (n - n0) * 272 + 128 + p * 2) = (bf16)f2bf(hi2); }
                const float nr = lr * hr - li * hi2 + dr[j], ni = lr * hi2 + li * hr + di[j]; hr = nr; hi2 = ni; }
        }
    }
    __syncthreads();
    const bf16* wo = (const bf16*)(F.ws + WS_S5T + (size_t)(l * 32 + g) * S5T_SIZE + S5T_WOUT);
    mx::bf16x8 hf[8];
#pragma unroll
    for (int ks = 0; ks < 8; ++ks) hf[ks] = *(const LAS mx::bf16x8*)(Hl + c32 * 272 + ks * 32 + hi * 16);
    const float* Dv = INF(I_S5D) + l * 512 + g * 16;
#pragma unroll 1
    for (int jj = 0; jj < 4; ++jj) {
        const int j = (jj == 0) ? w : (jj == 1) ? 15 - w : (jj == 2) ? 16 + w : 31 - w;
        const int tcol = 2 * j + (c32 >> 4), ccol = c32 & 15;
        mx::f32x16 acc = {};
#pragma unroll
        for (int ks = 0; ks < 8; ++ks) { const mx::bf16x8 bb = *(const mx::bf16x8*)(wo + (size_t)(j * 32 + c32) * 128 + ks * 16 + 8 * hi); acc = MX_MFMA(bb, hf[ks], acc); }
        const LAS unsigned char* ab = Ul + c32 * 2064 + hi * 16;
        const LAS unsigned char* kb = Kl + (tcol + 1) * 512 + ccol * 32 + hi * 16;
        { mx::bf16x8 a = *(const LAS mx::bf16x8*)ab, bb = *(const LAS mx::bf16x8*)kb;
          const int ns = 2 * j + 2;
          for (int s = 0; s < ns; ++s) {
              const int sn = s + 1 < ns ? s + 1 : s;
              const mx::bf16x8 an = *(const LAS mx::bf16x8*)(ab + sn * 32), bn = *(const LAS mx::bf16x8*)(kb - sn * 512);
              acc = MX_MFMA(bb, a, acc); a = an; bb = bn; } }
        { const int Rr = rb * 32 + c32, b = Rr >> 6, nch = Rr & 63; const size_t tok0 = (size_t)b * SEQ + nch * 64 + 2 * j;
#pragma unroll
          for (int tk = 0; tk < 2; ++tk) {
              const bf16* up = u16 + (tok0 + tk) * 512 + g * 16 + 4 * hi; const float* dp = Dv + 4 * hi;
              unsigned pkx[2], pky[2];
#pragma unroll
              for (int kk = 0; kk < 2; ++kk) { const int k = 2 * tk + kk; const v2u uw = *(const v2u*)(up + 8 * kk); const f32x4 dv4 = *(const f32x4*)(dp + 8 * kk);
                  const float u0 = bf2f((unsigned short)uw.x), u1 = bf2f((unsigned short)(uw.x >> 16)), u2 = bf2f((unsigned short)uw.y), u3 = bf2f((unsigned short)(uw.y >> 16));
                  pkx[kk] = mx::cvtpk(gelu_tanh(acc[4 * k] + dv4[0] * u0), gelu_tanh(acc[4 * k + 1] + dv4[1] * u1));
                  pky[kk] = mx::cvtpk(gelu_tanh(acc[4 * k + 2] + dv4[2] * u2), gelu_tanh(acc[4 * k + 3] + dv4[3] * u3)); }
              auto rx = __builtin_amdgcn_permlane32_swap(pkx[0], pkx[1], false, false); auto ry = __builtin_amdgcn_permlane32_swap(pky[0], pky[1], false, false);
              *(v4u*)(yg16 + (tok0 + tk) * 512 + g * 16 + 8 * hi) = (v4u){rx[0], ry[0], rx[1], ry[1]}; } }
    }
}

__device__ __forceinline__ void hg_gate_loads(int h, const float* logf, size_t row0, int k, int seg, float (&g)[16]) {
#pragma unroll
    for (int j = 0; j < 16; ++j) g[j] = logf[(row0 + seg * 16 + j) * 512 + h * 128 + k];
}
__device__ __forceinline__ void hg_gate_scan(Frame& F, int k, int seg, const float (&g)[16], float (&bcum)[16], float (&kk)[16], float& bmid, float& blast) {
    LAS float* tot = (LAS float*)(F.lds + 120 * 1024);
    float run = 0.f;
#pragma unroll
    for (int j = 0; j < 16; ++j) { kk[j] = 1.f - __expf(g[j]); run += g[j]; bcum[j] = run; }
    tot[seg * 128 + k] = run;
    __syncthreads();
    float pre = 0.f;
    for (int s2 = 0; s2 < seg; ++s2) pre += tot[s2 * 128 + k];
#pragma unroll
    for (int j = 0; j < 16; ++j) bcum[j] += pre;
    if (seg == 1) tot[512 + k] = bcum[15];
    if (seg == 3) tot[640 + k] = bcum[15];
    __syncthreads();
    bmid = tot[512 + k]; blast = tot[640 + k];
}
__device__ __forceinline__ void hg_step1_item(Frame& F, int chunk  , const float* logf, const bf16* hv, bf16* dST, float* blastg) {
    const int bh = chunk >> 6, n = chunk & 63, b = bh >> 2, h = bh & 3;
    const size_t row0 = (size_t)b * SEQ + n * 64;
    const int k = F.tid & 127, seg = F.tid >> 7;
    LAS unsigned char* klT = F.lds;
    LAS unsigned char* vT = F.lds + 128 * 144;
    __syncthreads();
    float g[16], bc[16], kk[16], bmid, blast; bf16 vraw[16];
    hg_gate_loads(h, logf, row0, k, seg, g);
#pragma unroll
    for (int j = 0; j < 16; ++j) vraw[j] = hv[(row0 + seg * 16 + j) * 512 + h * 128 + k];
    hg_gate_scan(F, k, seg, g, bc, kk, bmid, blast);
    float tmp[16];
#pragma unroll
    for (int j = 0; j < 16; ++j) tmp[j] = kk[j] * __expf(blast - bc[j]);
    *(LAS mx::bf16x8*)(klT + k * 144 + seg * 32) = mx::pack8f(tmp); *(LAS mx::bf16x8*)(klT + k * 144 + seg * 32 + 16) = mx::pack8f(tmp + 8);
#pragma unroll
    for (int j = 0; j < 16; ++j) *(LAS bf16*)(vT + k * 144 + (seg * 16 + j) * 2) = vraw[j];
    if (seg == 0) blastg[(size_t)chunk * 128 + k] = blast;
    __syncthreads();
    const int lane = F.lane, w = F.wave, c32 = lane & 31, hi = lane >> 5, vb = w & 3, kb2 = w >> 2;
    mx::f32x16 a0 = {}, a1 = {};
#pragma unroll
    for (int ks = 0; ks < 4; ++ks) {
        const mx::bf16x8 av = *(const LAS mx::bf16x8*)(vT + (vb * 32 + c32) * 144 + ks * 32 + hi * 16);
        const mx::bf16x8 b0 = *(const LAS mx::bf16x8*)(klT + (kb2 * 64 + c32) * 144 + ks * 32 + hi * 16);
        const mx::bf16x8 b1 = *(const LAS mx::bf16x8*)(klT + (kb2 * 64 + 32 + c32) * 144 + ks * 32 + hi * 16);
        a0 = MX_MFMA(b0, av, a0); a1 = MX_MFMA(b1, av, a1);
    }
    bf16* dst = dST + (size_t)chunk * 16384 + (size_t)(vb * 32 + c32) * 128 + kb2 * 64 + 8 * hi;
#pragma unroll
    for (int q = 0; q < 4; q += 2) {
        { const unsigned ax = mx::cvtpk(a0[4 * q], a0[4 * q + 1]), ay = mx::cvtpk(a0[4 * q + 2], a0[4 * q + 3]), bx = mx::cvtpk(a0[4 * q + 4], a0[4 * q + 5]), by = mx::cvtpk(a0[4 * q + 6], a0[4 * q + 7]);
          auto rx = __builtin_amdgcn_permlane32_swap(ax, bx, false, false); auto ry = __builtin_amdgcn_permlane32_swap(ay, by, false, false);
          *(v4u*)(dst + 8 * q) = (v4u){rx[0], ry[0], rx[1], ry[1]}; }
        { const unsigned ax = mx::cvtpk(a1[4 * q], a1[4 * q + 1]), ay = mx::cvtpk(a1[4 * q + 2], a1[4 * q + 3]), bx = mx::cvtpk(a1[4 * q + 4], a1[4 * q + 5]), by = mx::cvtpk(a1[4 * q + 6], a1[4 * q + 7]);
          auto rx = __builtin_amdgcn_permlane32_swap(ax, bx, false, false); auto ry = __builtin_amdgcn_permlane32_swap(ay, by, false, false);
          *(v4u*)(dst + 32 + 8 * q) = (v4u){rx[0], ry[0], rx[1], ry[1]}; }
    }
}
__device__ __forceinline__ void hg_step2(Frame& F, const bf16* dST, const float* blastg, bf16* SpT) {
    typedef float f32x2 __attribute__((ext_vector_type(2)));
    const int gt = F.bid * NTHR + F.tid, NGT = F.G * NTHR;
    for (int i = gt; i < 16 * 8192; i += NGT) {
        const int k2 = (i & 63) * 2, bh = i >> 13, vk = (i & 8191) * 2;
        f32x2 S = (f32x2){0.f, 0.f};
        unsigned dA[16], dB[16]; f32x2 blA[16], blB[16];
#define H2_LOAD(d, bl, n0) do { _Pragma("unroll") for (int j = 0; j < 16; ++j) { const size_t ch = (size_t)bh * 64 + (n0) + j; d[j] = *(const unsigned*)(dST + ch * 16384 + vk); bl[j] = *(const f32x2*)(blastg + ch * 128 + k2); } } while (0)
#define H2_PROC(d, bl, n0) do { _Pragma("unroll") for (int j = 0; j < 16; ++j) { const size_t ch = (size_t)bh * 64 + (n0) + j; \
            *(unsigned*)(SpT + ch * 16384 + vk) = pk2(S.x, S.y); \
            S.x = __expf(bl[j].x) * S.x + bf2f((unsigned short)d[j]); S.y = __expf(bl[j].y) * S.y + bf2f((unsigned short)(d[j] >> 16)); } } while (0)
        H2_LOAD(dA, blA, 0); H2_LOAD(dB, blB, 16);
        H2_PROC(dA, blA, 0); H2_LOAD(dA, blA, 32);
        H2_PROC(dB, blB, 16); H2_LOAD(dB, blB, 48);
        H2_PROC(dA, blA, 32); H2_PROC(dB, blB, 48);
#undef H2_LOAD
#undef H2_PROC
    }
}
__device__ __forceinline__ void hg_step3_item(Frame& F, int l, int chunk, const float* logf, const bf16* hq, const bf16* hv, const bf16* hgt, const bf16* SpT, bf16* cat) {
    const int bh = chunk >> 6, n = chunk & 63, b = bh >> 2, h = bh & 3;
    const size_t row0 = (size_t)b * SEQ + n * 64;
    const int k = F.tid & 127, seg = F.tid >> 7;
    LAS unsigned char* qm = F.lds;
    LAS unsigned char* km = qm + 64 * 272;
    LAS unsigned char* vT = km + 64 * 272;
    LAS unsigned char* sp = vT + 128 * 144;
    LAS float* ot = (LAS float*)(sp + 128 * 272);
    LAS float* tot = (LAS float*)(F.lds + 120 * 1024);
    __syncthreads();
    float g[16], bc[16], kk[16], bmid, blast; bf16 qraw[16], vraw[16]; v4u spraw[4];
    hg_gate_loads(h, logf, row0, k, seg, g);
#pragma unroll
    for (int j = 0; j < 16; ++j) { qraw[j] = hq[(row0 + seg * 16 + j) * 512 + h * 128 + k]; vraw[j] = hv[(row0 + seg * 16 + j) * 512 + h * 128 + k]; }
    { const bf16* src = SpT + (size_t)chunk * 16384 + (F.tid >> 2) * 128 + (F.tid & 3) * 32;
#pragma unroll
      for (int q4 = 0; q4 < 4; ++q4) spraw[q4] = *(const v4u*)(src + q4 * 8); }
    hg_gate_scan(F, k, seg, g, bc, kk, bmid, blast);
#pragma unroll
    for (int j = 0; j < 16; ++j) { const int t = seg * 16 + j; const float qv = bf2f(qraw[j]);
        *(LAS bf16*)(qm + t * 272 + k * 2) = (bf16)f2bf(qv * __expf(bc[j] - bmid));
        *(LAS bf16*)(km + t * 272 + k * 2) = (bf16)f2bf(kk[j] * __expf(bmid - bc[j])); }
#pragma unroll
    for (int j = 0; j < 16; ++j) *(LAS bf16*)(vT + k * 144 + (seg * 16 + j) * 2) = vraw[j];
    {
      const int v = F.tid >> 2, k0 = (F.tid & 3) * 32;
#pragma unroll
      for (int q4 = 0; q4 < 4; ++q4) { const v4u raw = spraw[q4]; const unsigned rw[4] = {raw.x, raw.y, raw.z, raw.w}; float tmp[8];
#pragma unroll
          for (int e = 0; e < 8; ++e) tmp[e] = bf2f((unsigned short)(rw[e >> 1] >> ((e & 1) * 16))) * __expf(tot[512 + k0 + q4 * 8 + e]);
          *(LAS mx::bf16x8*)(sp + v * 272 + (k0 + q4 * 8) * 2) = mx::pack8f(tmp); } }
    __syncthreads();
    const int lane = F.lane, w = F.wave, c32 = lane & 31, hi = lane >> 5, tb = w & 1, vb = w >> 1;
    mx::f32x16 o = {};
#pragma unroll
    for (int ks = 0; ks < 8; ++ks) {
        const mx::bf16x8 a = *(const LAS mx::bf16x8*)(qm + (tb * 32 + c32) * 272 + ks * 32 + hi * 16);
        const mx::bf16x8 bb = *(const LAS mx::bf16x8*)(sp + (vb * 32 + c32) * 272 + ks * 32 + hi * 16);
        o = MX_MFMA(a, bb, o);
    }
    for (int sb = 0; sb <= tb; ++sb) {
        mx::f32x16 p = {};
#pragma unroll
        for (int ks = 0; ks < 8; ++ks) {
            const mx::bf16x8 a = *(const LAS mx::bf16x8*)(km + (sb * 32 + c32) * 272 + ks * 32 + hi * 16);
            const mx::bf16x8 bb = *(const LAS mx::bf16x8*)(qm + (tb * 32 + c32) * 272 + ks * 32 + hi * 16);
            p = MX_MFMA(a, bb, p);
        }
        if (sb == tb) {
#pragma unroll
            for (int r = 0; r < 16; ++r) if (mx::crow(r, hi) > c32) p[r] = 0.f; }
        mx::bf16x8 plo, phi; mx::acc_to_A(p, plo, phi);
        const mx::bf16x8 v0 = *(const LAS mx::bf16x8*)(vT + (vb * 32 + c32) * 144 + sb * 64 + hi * 16);
        const mx::bf16x8 v1 = *(const LAS mx::bf16x8*)(vT + (vb * 32 + c32) * 144 + sb * 64 + 32 + hi * 16);
        o = MX_MFMA(plo, v0, o); o = MX_MFMA(phi, v1, o);
    }
#pragma unroll
    for (int r = 0; r < 16; ++r) ot[(tb * 32 + mx::crow(r, hi)) * 132 + vb * 32 + c32] = o[r];
    __syncthreads();
    { const int t = F.tid >> 3, cg = F.tid & 7; float vals[16]; float ss = 0.f;
#pragma unroll
      for (int e = 0; e < 16; ++e) { vals[e] = ot[t * 132 + cg * 16 + e]; ss += vals[e] * vals[e]; }
      ss += __shfl_xor(ss, 1); ss += __shfl_xor(ss, 2); ss += __shfl_xor(ss, 4);
      const float r = 1.f / sqrtf(ss * (1.f / 128.f) + EPS);
      const bf16* gp = hgt + (row0 + t) * 512 + h * 128 + cg * 16; const float* gn = INF(I_HGN) + l * 128 + cg * 16;
      const v4u gw0 = *(const v4u*)gp, gw1 = *(const v4u*)(gp + 8); const unsigned gw[8] = {gw0.x, gw0.y, gw0.z, gw0.w, gw1.x, gw1.y, gw1.z, gw1.w};
#pragma unroll
      for (int e = 0; e < 16; ++e) vals[e] = vals[e] * r * gn[e] * bf2f((unsigned short)(gw[e >> 1] >> ((e & 1) * 16)));
      bf16* op = cat + (row0 + t) * DM + 1536 + h * 128 + cg * 16;
      *(mx::bf16x8*)op = mx::pack8f(vals); *(mx::bf16x8*)(op + 8) = mx::pack8f(vals + 8); }
}

__device__ __forceinline__ void phase_pre0(Frame& F) {
    LAS float* scr = (LAS float*)(F.lds + F.wave * 16640);
    const int gw = F.bid * NWAVES + F.wave, NGW = F.G * NWAVES;
    constexpr int IT_IN = 32 * (DINP / 64), IT_UQ = 8 * 24, IT_UKV = 4 * 32, IT_GLU = 8 * 8, IT_OUT = 32 * 32, IT_UP = 32 * (DFF2 / 64), IT_DN = (DFF / 64) * 32;
    constexpr int IT_L = IT_IN + IT_UQ + IT_UKV + IT_GLU + IT_OUT + IT_UP + IT_DN;
    for (int it = gw; it < NL * IT_L; it += NGW) {
        const int l = it / IT_L; int r = it % IT_L; const int ln = F.lane;
        if (r < IT_IN) { const int nb = r % (DINP / 64), kb = r / (DINP / 64); tr_item(INF(I_WIN) + (size_t)l * DM * DIN, DIN, DM, kb * 64, win_srccol(nb * 64 + ln), nullptr, wt(F, l, WL_IN) + (size_t)nb * 64 * DM, scr, ln); continue; } r -= IT_IN;
        if (r < IT_UQ) { const int nb = r % 24, kb = r / 24; tr_item(INF(I_WUQ) + (size_t)l * 512 * 1536, 1536, 512, kb * 64, uq_srccol(nb * 64 + ln), INF(I_QN) + l * 512, wt(F, l, WL_UQ) + (size_t)nb * 64 * 512, scr, ln); continue; } r -= IT_UQ;
        if (r < IT_UKV) { const int nb = r % 32, kb = r / 32; tr_item(INF(I_WUKV) + (size_t)l * 256 * 2048, 2048, 256, kb * 64, nb * 64 + ln, INF(I_KVN) + l * 256, wt(F, l, WL_UKV) + (size_t)nb * 64 * 256, scr, ln); continue; } r -= IT_UKV;
        if (r < IT_GLU) { const int nb = r % 8, kb = r / 8; tr_item(INF(I_WGLU) + (size_t)l * 512 * 512, 512, 512, kb * 64, nb * 64 + ln, nullptr, wt(F, l, WL_GLU) + (size_t)nb * 64 * 512, scr, ln); continue; } r -= IT_GLU;
        if (r < IT_OUT) { const int nb = r % 32, kb = r / 32; tr_item(INF(I_WOUT) + (size_t)l * DM * DM, DM, DM, kb * 64, nb * 64 + ln, nullptr, wt(F, l, WL_OUT) + (size_t)nb * 64 * DM, scr, ln); continue; } r -= IT_OUT;
        if (r < IT_UP) { const int nb = r % (DFF2 / 64), kb = r / (DFF2 / 64);
            tr_item(INF(I_WUP) + (size_t)l * DM * DFF2, DFF2, DM, kb * 64, ((nb & 3) < 2 ? (nb >> 2) * 128 + (nb & 3) * 64 : DFF + (nb >> 2) * 128 + ((nb & 3) - 2) * 64) + ln, nullptr, wt(F, l, WL_UP) + (size_t)nb * 64 * DM, scr, ln); continue; } r -= IT_UP;
        { const int nb = r % 32, kb = r / 32; tr_item(INF(I_WDN) + (size_t)l * DFF * DM, DM, DFF, kb * 64, nb * 64 + ln, nullptr, wt(F, l, WL_DN) + (size_t)nb * 64 * DFF, scr, ln); }
    }
    const float* c = INF(I_C);
    for (int it = gw; it < NL * 16 * 48; it += NGW) {
        const int jc = it % 48, kc = (it / 48) % 16, l = it / (48 * 16);
        const int j = jc * 256 + F.lane * 4;
        const float* w = INF(I_WADA) + ((size_t)l * DM + kc * 128) * 12288 + j;
#pragma unroll
        for (int q = 0; q < 8; ++q) { const int idx = q * 64 + F.lane, b = idx >> 7, k = idx & 127; const float cv = c[b * DM + kc * 128 + k]; scr[idx] = cv / (1.f + __expf(-cv)); }
        LDS_WAIT(); asm volatile("" ::: "memory");
        f32x4 acc[NB];
#pragma unroll
        for (int b = 0; b < NB; ++b) acc[b] = (f32x4){0.f, 0.f, 0.f, 0.f};
#pragma unroll 16
        for (int k = 0; k < 128; ++k) {
            const f32x4 wv = *(const f32x4*)(w + (size_t)k * 12288);
#pragma unroll
            for (int b = 0; b < NB; ++b) acc[b] += wv * scr[b * 128 + k];
        }
        float* mp = (float*)(F.ws + WS_MODP);
#pragma unroll
        for (int b = 0; b < NB; ++b) *(f32x4*)(mp + (((size_t)l * 16 + kc) * NB + b) * 12288 + j) = acc[b];
        LDS_WAIT(); asm volatile("" ::: "memory");
    }
    const int gt = F.bid * NTHR + F.tid, NGT = F.G * NTHR;
    const int* pos = (const int*)ldp(F, I_POS);
    for (int i = gt; i < M * 32; i += NGT) {
        const int tok = i >> 5, fi = i & 31;
        const float inv = exp2f(-(float)fi * 0.41524101186092033f);
        const float ang = (float)pos[tok] * inv; float sn, cs; sincosf(ang, &sn, &cs);
        ((float*)(F.ws + WS_COS))[i] = cs; ((float*)(F.ws + WS_SIN))[i] = sn;
    }
    s5_tables_a(F);
    for (int j = gt; j < 512; j += NGT) {
        float lg[NL], mx = -1e30f;
#pragma unroll
        for (int l = 0; l < NL; ++l) { lg[l] = INF(I_LB)[l * 512 + j]; mx = fmaxf(mx, lg[l]); }
        float s = 0.f;
#pragma unroll
        for (int l = 0; l < NL; ++l) { lg[l] = expf(lg[l] - mx); s += lg[l]; }
        float cum = 0.f;
#pragma unroll
        for (int l = 0; l < NL; ++l) { if (l > 0) cum += lg[l] / s; ((float*)(F.ws + WS_LB))[l * 512 + j] = cum; }
    }
}
__device__ __forceinline__ void phase_pre1(Frame& F) {
    const int gt = F.bid * NTHR + F.tid, NGT = F.G * NTHR;
    const float* mp = (const float*)(F.ws + WS_MODP); float* mod = (float*)(F.ws + WS_MOD);
    for (int i = gt; i < NL * NB * 12288; i += NGT) {
        const int j = i % 12288, b = (i / 12288) % NB, l = i / (12288 * NB);
        float s = INF(I_BADA)[l * 12288 + j];
        for (int kc = 0; kc < 16; ++kc) s += mp[(((size_t)l * 16 + kc) * NB + b) * 12288 + j];
        mod[i] = s;
    }
}
__device__ __forceinline__ float bflo(unsigned u) { return __builtin_bit_cast(float, u << 16); }
__device__ __forceinline__ float bfhi(unsigned u) { return __builtin_bit_cast(float, u & 0xffff0000u); }
__device__ __forceinline__ void phase_resnorm(Frame& F, const float* xin32, const bf16* xin16, const bf16* y, const float* gpost, const float* gate  ,
                                              bf16* xout16, float* xout32, const float* gpre, const float* sc, const float* sh, bf16* hout) {
    const int gw = F.bid * NWAVES + F.wave, NGW = F.G * NWAVES, RW = (M + NGW - 1) / NGW;
    int curb = -1; f32x4 pa[8], pg[8], ps[8];
    const int rend = (gw * RW + RW) < M ? (gw * RW + RW) : M;
    for (int row = gw * RW; row < rend; ++row) {
        const int b = row / SEQ;
        if (b != curb) { curb = b;
#pragma unroll
            for (int j = 0; j < 8; ++j) { const int ci = 128 * (j >> 1) + 2 * F.lane + (j & 1);
                if (y) pa[j] = ((const f32x4*)gpost)[ci] * ((const f32x4*)(gate + (size_t)b * 12288))[ci];
                if (hout) { pg[j] = ((const f32x4*)gpre)[ci] * (((const f32x4*)(sc + (size_t)b * 12288))[ci] + 1.f); ps[j] = ((const f32x4*)(sh + (size_t)b * 12288))[ci]; } } }
        f32x4 v[8];
        if (xin32) { const f32x4* xr = (const f32x4*)(xin32 + (size_t)row * DM) + 2 * F.lane;
#pragma unroll
            for (int j = 0; j < 4; ++j) { v[2 * j] = xr[128 * j]; v[2 * j + 1] = xr[128 * j + 1]; }
        } else { const v4u* xr = (const v4u*)(xin16 + (size_t)row * DM) + F.lane;
#pragma unroll
            for (int j = 0; j < 4; ++j) { const v4u w = xr[64 * j]; v[2 * j] = (f32x4){bflo(w.x), bfhi(w.x), bflo(w.y), bfhi(w.y)}; v[2 * j + 1] = (f32x4){bflo(w.z), bfhi(w.z), bflo(w.w), bfhi(w.w)}; }
        }
        if (y) {
            f32x4 yv[8]; float ss = 0.f;
            const v4u* yr = (const v4u*)(y + (size_t)row * DM) + F.lane;
#pragma unroll
            for (int j = 0; j < 4; ++j) { const v4u w = yr[64 * j]; yv[2 * j] = (f32x4){bflo(w.x), bfhi(w.x), bflo(w.y), bfhi(w.y)}; yv[2 * j + 1] = (f32x4){bflo(w.z), bfhi(w.z), bflo(w.w), bfhi(w.w)}; }
#pragma unroll
            for (int j = 0; j < 8; ++j) ss += (yv[j].x * yv[j].x + yv[j].y * yv[j].y) + (yv[j].z * yv[j].z + yv[j].w * yv[j].w);
            const float r = 1.f / sqrtf(wave_sum(ss) * (1.f / DM) + EPS);
#pragma unroll
            for (int j = 0; j < 8; ++j) v[j] += pa[j] * (yv[j] * r);
            if (xout16) { v4u* xo = (v4u*)(xout16 + (size_t)row * DM) + F.lane;
#pragma unroll
                for (int j = 0; j < 4; ++j) xo[64 * j] = (v4u){pk2(v[2 * j].x, v[2 * j].y), pk2(v[2 * j].z, v[2 * j].w), pk2(v[2 * j + 1].x, v[2 * j + 1].y), pk2(v[2 * j + 1].z, v[2 * j + 1].w)};
            } else { f32x4* xo = (f32x4*)(xout32 + (size_t)row * DM) + 2 * F.lane;
#pragma unroll
                for (int j = 0; j < 4; ++j) { xo[128 * j] = v[2 * j]; xo[128 * j + 1] = v[2 * j + 1]; }
            }
        }
        if (hout) {
            float ss = 0.f;
#pragma unroll
            for (int j = 0; j < 8; ++j) ss += (v[j].x * v[j].x + v[j].y * v[j].y) + (v[j].z * v[j].z + v[j].w * v[j].w);
            const float r = 1.f / sqrtf(wave_sum(ss) * (1.f / DM) + EPS);
            v4u* ho = (v4u*)(hout + (size_t)row * DM) + F.lane;
#pragma unroll
            for (int j = 0; j < 4; ++j) { const f32x4 h0 = v[2 * j] * r * pg[2 * j] + ps[2 * j], h1 = v[2 * j + 1] * r * pg[2 * j + 1] + ps[2 * j + 1];
                ho[64 * j] = (v4u){pk2(h0.x, h0.y), pk2(h0.z, h0.w), pk2(h1.x, h1.y), pk2(h1.z, h1.w)}; }
        }
    }
}

__device__ __forceinline__ void phase_mix1(Frame& F, int l) {
    for (int it = F.bid; it < 256; it += F.G) s5_step1_item(F, l, it >> 3, it & 7, (const bf16*)(F.ws + WS_U16), (float*)(F.ws + WS_DS5));
    for (int it = F.bid; it < 1024; it += F.G) hg_step1_item(F, it, (const float*)(F.ws + WS_LOGF), (const bf16*)(F.ws + WS_HV), (bf16*)(F.ws + WS_DST), (float*)(F.ws + WS_BLAST));
}
__device__ __forceinline__ void phase_s5out(Frame& F, int l) {
    for (int it = F.bid; it < 256; it += F.G) s5_step3_item(F, l, it >> 3, it & 7, (const bf16*)(F.ws + WS_U16), (const float*)(F.ws + WS_DS5), (bf16*)(F.ws + WS_YG16));
}
__device__ __forceinline__ void phase_hgout(Frame& F, int l) {
    for (int it = F.bid; it < 1024; it += F.G) hg_step3_item(F, l, it, (const float*)(F.ws + WS_LOGF), (const bf16*)(F.ws + WS_HQ), (const bf16*)(F.ws + WS_HV), (const bf16*)(F.ws + WS_HGT), (const bf16*)(F.ws + WS_SPT), (bf16*)(F.ws + WS_CAT));
}
__device__ __forceinline__ void phase_attn(Frame& F) {
    const bf16* qo = (const bf16*)(F.ws + WS_ACT); const bf16* ko = (const bf16*)(F.ws + WS_ACT + 48 * MiB); const bf16* vo = (const bf16*)(F.ws + WS_ACT + 96 * MiB);
    bf16* cat = (bf16*)(F.ws + WS_CAT);
    const int vcu = (F.G % 8 == 0) ? (F.bid % 8) * (F.G / 8) + F.bid / 8 : F.bid;
    for (int it = vcu; it < NB * NH * 8; it += F.G) {
        const int bh = it >> 3, x = it & 7, b = bh / NH, h = bh % NH;
        for (int pass = 0; pass < 2; ++pass)
            att::attn_block(qo + (size_t)bh * SEQ * DQK, ko + (size_t)bh * SEQ * DQK, vo + (size_t)bh * SEQ * 128, cat + (size_t)b * SEQ * DM + 512 + h * 128, DM, pass ? x : 15 - x, F.lds);
    }
}
__device__ __forceinline__ void fixup_panel(Frame& F, int l, int pm) {
    const float* halo = (const float*)(F.ws + WS_HALO); bf16* act = (bf16*)(F.ws + WS_ACT);
    const float* cw = INF(I_CW) + (size_t)l * 3 * DFF2; const float* cb = INF(I_CB) + (size_t)l * DFF2;
    for (int c = F.tid * 4; c < DFF; c += NTHR * 4) {
        const f32x4 wg0 = *(const f32x4*)(cw + c), wg1 = *(const f32x4*)(cw + DFF2 + c), wg2 = *(const f32x4*)(cw + 2 * DFF2 + c), bg = *(const f32x4*)(cb + c);
        const f32x4 wv0 = *(const f32x4*)(cw + DFF + c), wv1 = *(const f32x4*)(cw + DFF2 + DFF + c), wv2 = *(const f32x4*)(cw + 2 * DFF2 + DFF + c), bv = *(const f32x4*)(cb + DFF + c);
        f32x4 hg[2][4], hv[2][4];
#pragma unroll
        for (int q = 0; q < 2; ++q) { const int blk = pm * 2 + q; const bool first = ((blk * 128) & (SEQ - 1)) == 0; const int pb = first ? blk : blk - 1;
            const float* r0 = halo + (size_t)(blk * 4) * DFF2 + c; const float* rp = halo + (size_t)(pb * 4 + 2) * DFF2 + c;
            hg[q][0] = *(const f32x4*)r0; hv[q][0] = *(const f32x4*)(r0 + DFF); hg[q][1] = *(const f32x4*)(r0 + DFF2); hv[q][1] = *(const f32x4*)(r0 + DFF2 + DFF);
            hg[q][2] = *(const f32x4*)rp; hv[q][2] = *(const f32x4*)(rp + DFF); hg[q][3] = *(const f32x4*)(rp + DFF2); hv[q][3] = *(const f32x4*)(rp + DFF2 + DFF); }
#pragma unroll
        for (int q = 0; q < 2; ++q) { const int blk = pm * 2 + q; const bool first = ((blk * 128) & (SEQ - 1)) == 0;
            const f32x4 z4 = (f32x4){0.f, 0.f, 0.f, 0.f};
            const f32x4 gm1 = first ? z4 : hg[q][3], gm2 = first ? z4 : hg[q][2], vm1 = first ? z4 : hv[q][3], vm2 = first ? z4 : hv[q][2];
            { const f32x4 cg = bg + wg0 * gm2 + wg1 * gm1 + wg2 * hg[q][0], cv = bv + wv0 * vm2 + wv1 * vm1 + wv2 * hv[q][0];
              *(v2u*)(act + (size_t)(blk * 128) * DFF + c) = (v2u){pk2(gelu_tanh(cg.x) * cv.x, gelu_tanh(cg.y) * cv.y), pk2(gelu_tanh(cg.z) * cv.z, gelu_tanh(cg.w) * cv.w)}; }
            { const f32x4 cg = bg + wg0 * gm1 + wg1 * hg[q][0] + wg2 * hg[q][1], cv = bv + wv0 * vm1 + wv1 * hv[q][0] + wv2 * hv[q][1];
              *(v2u*)(act + (size_t)(blk * 128 + 1) * DFF + c) = (v2u){pk2(gelu_tanh(cg.x) * cv.x, gelu_tanh(cg.y) * cv.y), pk2(gelu_tanh(cg.z) * cv.z, gelu_tanh(cg.w) * cv.w)}; }
        }
    }
}

constexpr int PH_PER_LAYER = 10, PH_LAYER0 = 2, PH_FINAL = PH_LAYER0 + NL * PH_PER_LAYER, N_PHASES = PH_FINAL + 1;
__global__ void __launch_bounds__(NTHR, 2) skel_fwd(Args args) {
    extern __shared__ __attribute__((aligned(16))) unsigned char lds[];
    Frame F;
    F.lds = (LAS unsigned char*)lds; F.ldsg = lds;
    F.tid = threadIdx.x; F.lane = F.tid & 63; F.wave = __builtin_amdgcn_readfirstlane(F.tid >> 6);
    F.G = gridDim.x; F.bid = blockIdx.x; F.ws = args.ws; F.in = nullptr;
    const int lo = args.ph_lo, hi = args.ph_hi;
    for (int u = F.tid; u < (LDS_BYTES - CTRL_OFF) / 4; u += NTHR) ((LAS unsigned*)(F.lds + CTRL_OFF))[u] = 0u;
    if (F.tid == 0) { LAS unsigned long long* pt = (LAS unsigned long long*)(F.lds + PTAB_OFF);
#pragma unroll
        for (int i = 0; i < N_IN; ++i) pt[i] = (unsigned long long)args.in[i];
        pt[N_IN] = (unsigned long long)args.ws; }
    __syncthreads();
    XcdBarrier bar; bar.bar = (unsigned*)(F.ws + WS_CTL) + CW_BAR; bar.x = 0; bar.st = nullptr;
    if (hi - lo > 1) bar = xcd_barrier_post((unsigned*)(F.ws + WS_CTL) + CW_BAR, (volatile LAS unsigned*)(F.lds + MISC_OFF) + 8);
#define SEAM(k) do { if (IN(k) && IN((k) + 1)) xcd_barrier(bar); } while (0)
#define IN(k) (lo <= (k) && (k) < hi)
#define REFRESH() do { int t_ = threadIdx.x; asm volatile("" : "+v"(t_)); F.tid = t_; F.lane = t_ & 63; F.wave = __builtin_amdgcn_readfirstlane(t_ >> 6); \
    F.ws = (unsigned char*)ldp(F, N_IN); } while (0)
    if (IN(0)) phase_pre0(F);
    SEAM(0);
    if (IN(1)) { phase_pre1(F); if (F.G != 256) for (int l = 0; l < NL; ++l) s5_tables_b(F, l, F.bid * NTHR + F.tid, F.G * NTHR); }
    SEAM(1);
#define mod ((const float*)(F.ws + WS_MOD))
#define X ((bf16*)(F.ws + WS_X))
#define H ((bf16*)(F.ws + WS_H))
#define T2f ((const bf16*)(F.ws + WS_T2))
#define modl (mod + (size_t)l * NB * 12288)
    for (int l = 0; l < NL; ++l) {
        const int base = PH_LAYER0 + l * PH_PER_LAYER;
        if (IN(base + 0)) { REFRESH();
            if (l == 0) phase_resnorm(F, INF(I_X), nullptr, nullptr, nullptr, nullptr, nullptr, nullptr, INF(I_MPRE), modl + 2048, modl + 0, H);
            else phase_resnorm(F, nullptr, X, T2f, INF(I_FPOST) + (l - 1) * DM, mod + (size_t)(l - 1) * NB * 12288 + 10240, X, nullptr, INF(I_MPRE) + l * DM, modl + 2048, modl + 0, H);
        }
        SEAM(base + 0);
        if (IN(base + 1)) { REFRESH();
            pg8::Gemm g{H, wt(F, l, WL_IN), M, DINP, DM}; pg8::StaticOrder S; S.init(M, DINP, F.G, F.bid);
            pg8::EpiProj E{(bf16*)(F.ws + WS_U16), (bf16*)(F.ws + WS_CQ), (bf16*)(F.ws + WS_CKV), (bf16*)(F.ws + WS_HQ), (bf16*)(F.ws + WS_HV), (bf16*)(F.ws + WS_HGT), (bf16*)(F.ws + WS_ACT + 48 * MiB),
                           (float*)(F.ws + WS_LOGF), (float*)(F.ws + WS_SSQQ), (float*)(F.ws + WS_SSQKV), (const float*)(F.ws + WS_LB) + l * 512, (const float*)(F.ws + WS_COS), (const float*)(F.ws + WS_SIN)};
            pg8::gemm_phase<pg8::EpiProj, pg8::StaticOrder, true, true>(F.lds, g, S, E);
            if (F.G == 256 && F.bid >= 128) { REFRESH(); s5_tables_b(F, l, (F.bid - 128) * NTHR + F.tid, 128 * NTHR); }
        }
        SEAM(base + 1);
        if (IN(base + 2)) { REFRESH(); phase_mix1(F, l); }
        SEAM(base + 2);
        if (IN(base + 3)) { REFRESH();
            { pg8::Gemm g{(const bf16*)(F.ws + WS_CKV), wt(F, l, WL_UKV), M, 2048, 256}; pg8::StaticOrder S; S.init(M, 2048, F.G, F.bid);
              pg8::EpiKV E{(bf16*)(F.ws + WS_ACT + 48 * MiB), (bf16*)(F.ws + WS_ACT + 96 * MiB), (const float*)(F.ws + WS_SSQKV)};
              pg8::gemm_phase<pg8::EpiKV, pg8::StaticOrder, true, true>(F.lds, g, S, E); }
            REFRESH();
            hg_step2(F, (const bf16*)(F.ws + WS_DST), (const float*)(F.ws + WS_BLAST), (bf16*)(F.ws + WS_SPT));
            REFRESH();
            phase_s5out(F, l);
        }
        SEAM(base + 3);
        if (IN(base + 4)) { REFRESH();
            { pg8::Gemm g{(const bf16*)(F.ws + WS_CQ), wt(F, l, WL_UQ), M, 2048, 512, (const bf16*)(F.ws + WS_YG16), 6}; pg8::StaticOrder S; S.init(M, 2048, F.G, F.bid);
              pg8::EpiQGlu E{pg8::EpiQ{(bf16*)(F.ws + WS_ACT), (const float*)(F.ws + WS_SSQQ), (const float*)(F.ws + WS_COS), (const float*)(F.ws + WS_SIN)},
                             pg8::EpiGlu{(const bf16*)(F.ws + WS_YG16), 512, (bf16*)(F.ws + WS_CAT), DM}};
              pg8::gemm_phase<pg8::EpiQGlu, pg8::StaticOrder, true, true>(F.lds, g, S, E); }
            REFRESH();
            phase_hgout(F, l); }
        SEAM(base + 4);
        if (IN(base + 5)) { REFRESH(); phase_attn(F); }
        SEAM(base + 5);
        if (IN(base + 6)) { REFRESH();
            pg8::Gemm g{(const bf16*)(F.ws + WS_CAT), wt(F, l, WL_OUT), M, DM, DM}; pg8::StaticOrder S; S.init(M, DM, F.G, F.bid);
            pg8::EpiBf16<0> E{(bf16*)(F.ws + WS_T2), DM, nullptr, 0, 0, 1.f};
            pg8::gemm_phase<pg8::EpiBf16<0>, pg8::StaticOrder, true, true>(F.lds, g, S, E);
        }
        SEAM(base + 6);
        if (IN(base + 7)) { REFRESH(); phase_resnorm(F, l == 0 ? INF(I_X) : (const float*)nullptr, X, T2f, INF(I_MPOST) + l * DM, modl + 4096, X, nullptr, INF(I_FPRE) + l * DM, modl + 8192, modl + 6144, H); }
        SEAM(base + 7);
        if (IN(base + 8)) { REFRESH();
            pg8::Gemm g{H, wt(F, l, WL_UP), M, DFF2, DM}; pg8::StaticOrder S; S.init(M, DFF2, F.G, F.bid);
            pg8::EpiUp E{(bf16*)(F.ws + WS_ACT), (float*)(F.ws + WS_HALO), INF(I_CW) + (size_t)l * 3 * DFF2, INF(I_CB) + (size_t)l * DFF2};
            pg8::gemm_phase<pg8::EpiUp, pg8::StaticOrder, true, true>(F.lds, g, S, E);
        }
        SEAM(base + 8);
        if (IN(base + 9)) { REFRESH();
            { pg8::StaticOrder S0; S0.init(M, DM, F.G, F.bid, 4); pg8::Unit u0; int last = -1;
              for (int i = 0; S0.next(i, u0); ++i) if (u0.pm != last) { fixup_panel(F, l, u0.pm); last = u0.pm; } }
            asm volatile("s_waitcnt vmcnt(0)" ::: "memory"); __syncthreads();
            REFRESH();
            pg8::Gemm g{(const bf16*)(F.ws + WS_ACT), wt(F, l, WL_DN), M, DM, DFF}; pg8::StaticOrder S; S.init(M, DM, F.G, F.bid, 4);
            pg8::EpiBf16<0> E{(bf16*)(F.ws + WS_T2), DM, nullptr, 0, 0, 1.f};
            pg8::gemm_phase<pg8::EpiBf16<0>, pg8::StaticOrder, true, true>(F.lds, g, S, E);
        }
        SEAM(base + 9);
    }
    if (IN(PH_FINAL)) { REFRESH(); phase_resnorm(F, nullptr, X, T2f, INF(I_FPOST) + (NL - 1) * DM, mod + (size_t)(NL - 1) * NB * 12288 + 10240, nullptr, args.out, nullptr, nullptr, nullptr, nullptr); }
#undef mod
#undef X
#undef H
#undef T2f
#undef modl
#undef IN
}

extern "C" void kernel_launch(void* const* d_in, const int* in_sizes, int n_in, void* d_out, int out_size, void* d_ws, size_t ws_size, hipStream_t stream) {
    static int grid = 0;
    if (grid == 0) {
        if (n_in != N_IN || in_sizes[0] != M * DM || out_size != M * DM || ws_size < WS_END) { fprintf(stderr, "kernel_launch: shape/workspace mismatch (n_in %d, in0 %d, out %d, ws %zu < %zu)\n", n_in, n_in > 0 ? in_sizes[0] : -1, out_size, ws_size, (size_t)WS_END); grid = -1; return; }
        int dev = 0, cus = 0;
        if (hipGetDevice(&dev) != hipSuccess || hipDeviceGetAttribute(&cus, hipDeviceAttributeMultiprocessorCount, dev) != hipSuccess) { grid = -1; return; }
        if (hipFuncSetAttribute((const void*)skel_fwd, hipFuncAttributeMaxDynamicSharedMemorySize, LDS_BYTES) != hipSuccess) { fprintf(stderr, "kernel_launch: hipFuncSetAttribute failed\n"); grid = -1; return; }
        (void)hipGetLastError();
        grid = cus;
    }
    if (grid < 0) return;
    Args a{};
    for (int i = 0; i < N_IN; ++i) a.in[i] = d_in[i];
    a.out = (float*)d_out; a.ws = (unsigned char*)d_ws;
    if (hipMemsetAsync((char*)d_ws + WS_CTL, 0, CTL_ZERO_BYTES, stream) != hipSuccess) { fprintf(stderr, "kernel_launch: memset failed\n"); return; }
#if MK_ONE_LAUNCH
    a.ph_lo = 0; a.ph_hi = N_PHASES;
    hipLaunchKernelGGL(skel_fwd, dim3(grid), dim3(NTHR), LDS_BYTES, stream, a);
#else
    for (int p = 0; p < N_PHASES; ++p) {
        a.ph_lo = p; a.ph_hi = p + 1;
        hipLaunchKernelGGL(skel_fwd, dim3(grid), dim3(NTHR), LDS_BYTES, stream, a);
    }
#endif
}
```

```cpp
#include <hip/hip_runtime.h>
#include <cstdio>
#include <cstdint>
namespace pg8 {
#define PG8_LAS __attribute__((address_space(3)))
typedef unsigned short bf16_t;
typedef short bf16x8 __attribute__((ext_vector_type(8)));
typedef float f32x4 __attribute__((ext_vector_type(4)));
typedef unsigned u32x4 __attribute__((ext_vector_type(4)));
constexpr int BM = 256, BK = 64, HALF = 128, HTB = HALF * BK * 2  , STAGE_BYTES = 8 * HTB, NXCD = 8, WGM = 8;

__host__ __device__ __forceinline__ int lds_byte(int r, int c) { const int st = (r >> 4) * 2 + (c >> 5), rr = r & 15, cc = c & 31, ob = rr * 64 + cc * 2; return st * 1024 + (ob ^ (((ob >> 9) & 1) << 5)); }
__host__ __device__ __forceinline__ void stage_rc(int b, int& R, int& C) { const int st = b / 1024, sb = b % 1024, swz = sb ^ (((sb >> 9) & 1) << 5); R = (st >> 1) * 16 + swz / 64; C = (st & 1) * 32 + (swz % 64) / 2; }
__host__ __device__ __forceinline__ int perm32(int rho) { const int n = rho >> 4, i = rho & 15; return 8 * (i >> 2) + 4 * n + (i & 3); }

__device__ __forceinline__ __amdgpu_buffer_rsrc_t wt_rsrc(const void* base, size_t nbytes) { return __builtin_amdgcn_make_buffer_rsrc((void*)base, 0, (int)nbytes, 0x00020000); }
__device__ __forceinline__ void st16_wt(__amdgpu_buffer_rsrc_t r, size_t byte_off, u32x4 v) { __builtin_amdgcn_raw_buffer_store_b128(v, r, (int)byte_off, 0, 16); }
struct Unit { int pm, pn; };
struct Gemm { const bf16_t* A; const bf16_t* Bt; int M, N, K; const bf16_t* A2 = nullptr; int pn_split = 1 << 30; };

struct StaticOrder {
    int nM, nN, nwg, G, c, wgm;
    __host__ __device__ void init(int M, int N, int G_, int c_, int wgm_ = WGM) { nM = M / BM; nN = N / BM; nwg = nM * nN; G = G_; c = c_; wgm = wgm_; }
    __host__ __device__ __forceinline__ bool next(int i, Unit& u) const {
        const long L = (long)i * G + c; if (L >= nwg) return false;
        int wgid = (int)L; { const int q = nwg / NXCD, r = nwg % NXCD, xcd = wgid % NXCD, off = wgid / NXCD; wgid = (xcd < r ? xcd * (q + 1) : r * (q + 1) + (xcd - r) * q) + off; }
        const int nig = wgm * nN, gid = wgid / nig, fm = gid * wgm, gsz = (nM - fm) < wgm ? (nM - fm) : wgm;
        u.pm = fm + ((wgid % nig) % gsz); u.pn = (wgid % nig) / gsz; return true;
    }
    __device__ __forceinline__ void a_ready(const Unit&) const {}
    __device__ __forceinline__ void done(const Unit&) const {}
};

__device__ __forceinline__ unsigned cvt_pk_bf16(float lo, float hi) { typedef float f2_ __attribute__((ext_vector_type(2))); typedef __bf16 b2_ __attribute__((ext_vector_type(2))); const b2_ r = __builtin_convertvector((f2_){lo, hi}, b2_); return __builtin_bit_cast(unsigned, r); }
typedef float f32x2 __attribute__((ext_vector_type(2)));
__device__ __forceinline__ f32x2 gelu_pk(f32x2 v) {
    const f32x2 av = __builtin_elementwise_abs(v), d = av * 0.2316418882f + 1.0f;
    f32x2 t; t.x = __builtin_amdgcn_rcpf(d.x); t.y = __builtin_amdgcn_rcpf(d.y);
    f32x2 q = t * 0.5307027145f + (-0.7265760135f); q = q * t + 0.7107068705f; q = q * t + (-0.142248368f); q = q * t + 0.127414796f; q = q * t;
    const f32x2 s = (v * v) * (-0.72134752044f);
    f32x2 e; e.x = __builtin_amdgcn_exp2f(s.x); e.y = __builtin_amdgcn_exp2f(s.y);
    const f32x2 m = v * (q * e), r = v - m;
    f32x2 o; o.x = v.x < 0.f ? m.x : r.x; o.y = v.y < 0.f ? m.y : r.y; return o;
}

template <int ACT  > struct EpiBf16 {
    static constexpr bool PERM = true, AFTER_DRAIN = false, PERMA = false; static_assert(ACT == 0 || ACT == 1, "EpiBf16: ACT is 0 (none) or 1 (gelu_pk)");
    bf16_t* O; int ldc; const float* bias; int split_cols; size_t split_stride; float scale0;
    __device__ __forceinline__ void operator()(const f32x4 (&acc)[2][2][4][2], const Unit& u, int wr, int wc, int fr, int fq) const {
        const int row0 = u.pm * BM + wr * 64 + fr; int colt = u.pn * BM; bf16_t* base = O;
        float sc = 1.f; if (split_cols) { const int t = colt / split_cols; base += (size_t)t * split_stride; colt -= t * split_cols; if (t == 0) sc = scale0; }
        const int col0 = colt + wc * 32 + 8 * fq, bcol0 = u.pn * BM + wc * 32 + 8 * fq;
        f32x4 bv[2][2];
#pragma unroll
        for (int bj = 0; bj < 2; ++bj)
#pragma unroll
            for (int n = 0; n < 2; ++n) bv[bj][n] = bias ? *(const f32x4*)(bias + bcol0 + bj * HALF + 4 * n) : (f32x4){0.f, 0.f, 0.f, 0.f};
#pragma unroll
        for (int ai = 0; ai < 2; ++ai)
#pragma unroll
            for (int m = 0; m < 4; ++m) { bf16_t* rowp = base + (size_t)(row0 + ai * HALF + m * 16) * ldc + col0;
#pragma unroll
                for (int bj = 0; bj < 2; ++bj) { f32x4 v0 = acc[ai][bj][m][0] + bv[bj][0], v1 = acc[ai][bj][m][1] + bv[bj][1];
                    if (ACT == 1) { f32x2 a = gelu_pk((f32x2){v0[0], v0[1]}), b = gelu_pk((f32x2){v0[2], v0[3]}), c = gelu_pk((f32x2){v1[0], v1[1]}), d = gelu_pk((f32x2){v1[2], v1[3]});
                        v0 = (f32x4){a.x, a.y, b.x, b.y}; v1 = (f32x4){c.x, c.y, d.x, d.y}; }
                    v0 = v0 * sc; v1 = v1 * sc; u32x4 w; w.x = cvt_pk_bf16(v0[0], v0[1]); w.y = cvt_pk_bf16(v0[2], v0[3]); w.z = cvt_pk_bf16(v1[0], v1[1]); w.w = cvt_pk_bf16(v1[2], v1[3]);
                    *(u32x4*)(rowp + bj * HALF) = w; } }
    }
};
struct EpiF32 {
    static constexpr bool PERM = false, AFTER_DRAIN = false, PERMA = false;
    float* C; int ldc; const float* bias;
    __device__ __forceinline__ void operator()(const f32x4 (&acc)[2][2][4][2], const Unit& u, int wr, int wc, int fr, int fq) const {
        const int row0 = u.pm * BM + wr * 64 + fr, col0 = u.pn * BM + wc * 32 + 4 * fq;
        f32x4 bv[2][2];
#pragma unroll
        for (int bj = 0; bj < 2; ++bj)
#pragma unroll
            for (int n = 0; n < 2; ++n) bv[bj][n] = bias ? *(const f32x4*)(bias + col0 + bj * HALF + n * 16) : (f32x4){0.f, 0.f, 0.f, 0.f};
#pragma unroll
        for (int ai = 0; ai < 2; ++ai)
#pragma unroll
            for (int m = 0; m < 4; ++m) { float* rowp = C + (size_t)(row0 + ai * HALF + m * 16) * ldc + col0;
#pragma unroll
                for (int bj = 0; bj < 2; ++bj)
#pragma unroll
                    for (int n = 0; n < 2; ++n) *(f32x4*)(rowp + bj * HALF + n * 16) = acc[ai][bj][m][n] + bv[bj][n]; }
    }
};
struct EpiGlu {
    static constexpr bool PERM = true, AFTER_DRAIN = false, PERMA = false;
    const bf16_t* Y; int ldy; bf16_t* O; int ldo;
    __device__ __forceinline__ void operator()(const f32x4 (&acc)[2][2][4][2], const Unit& u, int wr, int wc, int fr, int fq) const {
        const int row0 = u.pm * BM + wr * 64 + fr, col0 = u.pn * BM + wc * 32 + 8 * fq;
#pragma unroll
        for (int ai = 0; ai < 2; ++ai)
#pragma unroll
            for (int m = 0; m < 4; ++m) { const size_t row = (size_t)(row0 + ai * HALF + m * 16);
#pragma unroll
                for (int bj = 0; bj < 2; ++bj) { const int col = col0 + bj * HALF;
                    const u32x4 yv = *(const u32x4*)(Y + row * ldy + col); const unsigned yw[4] = {yv.x, yv.y, yv.z, yv.w};
                    const f32x4 v0 = acc[ai][bj][m][0], v1 = acc[ai][bj][m][1]; const float vv[8] = {v0[0], v0[1], v0[2], v0[3], v1[0], v1[1], v1[2], v1[3]};
                    float o[8];
#pragma unroll
                    for (int e = 0; e < 8; ++e) { const float y = __builtin_bit_cast(float, (yw[e >> 1] >> ((e & 1) * 16)) << 16); o[e] = y / (1.f + __expf(-vv[e])); }
                    u32x4 w; w.x = cvt_pk_bf16(o[0], o[1]); w.y = cvt_pk_bf16(o[2], o[3]); w.z = cvt_pk_bf16(o[4], o[5]); w.w = cvt_pk_bf16(o[6], o[7]);
                    *(u32x4*)(O + row * ldo + col) = w; } }
    }
};
struct EpiQ {
    static constexpr bool PERM = true, AFTER_DRAIN = false, PERMA = false;
    bf16_t* Q; const float* ssq; const float* cosT; const float* sinT;
    __device__ __forceinline__ void operator()(const f32x4 (&acc)[2][2][4][2], const Unit& u, int wr, int wc, int fr, int fq) const {
        const int row0 = u.pm * BM + wr * 64 + fr;
#pragma unroll
        for (int ai = 0; ai < 2; ++ai)
#pragma unroll
            for (int m = 0; m < 4; ++m) { const int row = row0 + ai * HALF + m * 16, b = row >> 12, s = row & 4095; const f32x4 sa = *(const f32x4*)(ssq + (size_t)row * 8), sb = *(const f32x4*)(ssq + (size_t)row * 8 + 4); const float r = __builtin_amdgcn_rsqf((((sa[0] + sa[1]) + (sa[2] + sa[3])) + ((sb[0] + sb[1]) + (sb[2] + sb[3]))) * (1.f / 512.f) + 1e-6f) * 0.10411754f;
                if (u.pn < 4) {
#pragma unroll
                    for (int bj = 0; bj < 2; ++bj) { const int h = 2 * u.pn + bj; const f32x4 v0 = acc[ai][bj][m][0] * r, v1 = acc[ai][bj][m][1] * r;
                        u32x4 w; w.x = cvt_pk_bf16(v0[0], v0[1]); w.y = cvt_pk_bf16(v0[2], v0[3]); w.z = cvt_pk_bf16(v1[0], v1[1]); w.w = cvt_pk_bf16(v1[2], v1[3]);
                        *(u32x4*)(Q + ((size_t)(b * 8 + h) * 4096 + s) * 192 + wc * 32 + 8 * fq) = w; }
                } else {
                    const int f0 = ((wc & 1) * 4 + fq) * 4; const f32x4 cs = *(const f32x4*)(cosT + (size_t)row * 32 + f0), sn = *(const f32x4*)(sinT + (size_t)row * 32 + f0);
#pragma unroll
                    for (int bj = 0; bj < 2; ++bj) { const int h = (u.pn - 4) * 4 + bj * 2 + (wc >> 1); const f32x4 x1 = acc[ai][bj][m][0] * r, x2 = acc[ai][bj][m][1] * r;
                        const f32x4 o1 = x1 * cs - x2 * sn, o2 = x2 * cs + x1 * sn;
                        bf16_t* qp = Q + ((size_t)(b * 8 + h) * 4096 + s) * 192 + 128 + f0;
                        typedef unsigned u32x2 __attribute__((ext_vector_type(2)));
                        *(u32x2*)qp = (u32x2){cvt_pk_bf16(o1[0], o1[1]), cvt_pk_bf16(o1[2], o1[3])};
                        *(u32x2*)(qp + 32) = (u32x2){cvt_pk_bf16(o2[0], o2[1]), cvt_pk_bf16(o2[2], o2[3])}; }
                } }
    }
};
struct EpiKV {
    static constexpr bool PERM = true, AFTER_DRAIN = false, PERMA = false;
    bf16_t* Kf; bf16_t* V; const float* ssq;
    __device__ __forceinline__ void operator()(const f32x4 (&acc)[2][2][4][2], const Unit& u, int wr, int wc, int fr, int fq) const {
        const int row0 = u.pm * BM + wr * 64 + fr, h = u.pn, d = wc * 32 + 8 * fq;
#pragma unroll
        for (int ai = 0; ai < 2; ++ai)
#pragma unroll
            for (int m = 0; m < 4; ++m) { const int row = row0 + ai * HALF + m * 16, b = row >> 12, s = row & 4095; const f32x4 sa = *(const f32x4*)(ssq + (size_t)row * 4); const float r = __builtin_amdgcn_rsqf(((sa[0] + sa[1]) + (sa[2] + sa[3])) * (1.f / 256.f) + 1e-6f);
#pragma unroll
                for (int bj = 0; bj < 2; ++bj) { const f32x4 v0 = acc[ai][bj][m][0] * r, v1 = acc[ai][bj][m][1] * r;
                    u32x4 w; w.x = cvt_pk_bf16(v0[0], v0[1]); w.y = cvt_pk_bf16(v0[2], v0[3]); w.z = cvt_pk_bf16(v1[0], v1[1]); w.w = cvt_pk_bf16(v1[2], v1[3]);
                    bf16_t* dst = bj ? V + ((size_t)(b * 8 + h) * 4096 + s) * 128 + d : Kf + ((size_t)(b * 8 + h) * 4096 + s) * 192 + d;
                    *(u32x4*)dst = w; } }
    }
};
__device__ __forceinline__ f32x4 dpp_shr1(f32x4 v) { f32x4 o;
#pragma unroll
    for (int i = 0; i < 4; ++i) { const float f_ = v[i]; o[i] = __int_as_float(__builtin_amdgcn_update_dpp(0, __float_as_int(f_), 0x111, 0xf, 0xf, true)); }
    return o; }
__device__ __forceinline__ float gelu_tanh1(float x) { const float t = 0.7978845608028654f * (x + 0.044715f * x * x * x); return x * __builtin_amdgcn_rcpf(1.f + __builtin_amdgcn_exp2f(-2.885390081777927f * t)); }
struct EpiUp {
    static constexpr bool PERM = true, AFTER_DRAIN = false, PERMA = true;
    bf16_t* ACT; float* HALO; const float* cw; const float* cb;
    __device__ __forceinline__ void operator()(const f32x4 (&acc)[2][2][4][2], const Unit& u, int wr, int wc, int fr, int fq) const {
        const int ch0 = u.pn * 128 + wc * 32 + 8 * fq, prow = u.pm * BM + (wr * 16 + fr) * 8, blk = u.pm * 2 + wr;
        unsigned pk[8][2];
#pragma unroll
        for (int n = 0; n < 2; ++n) {
            const int c = ch0 + 4 * n;
            const f32x4 wg0 = *(const f32x4*)(cw + c), wg1 = *(const f32x4*)(cw + 11008 + c), wg2 = *(const f32x4*)(cw + 22016 + c), bg = *(const f32x4*)(cb + c);
            const f32x4 wv0 = *(const f32x4*)(cw + 5504 + c), wv1 = *(const f32x4*)(cw + 11008 + 5504 + c), wv2 = *(const f32x4*)(cw + 22016 + 5504 + c), bv = *(const f32x4*)(cb + 5504 + c);
#define XG(j) acc[(j) >> 2][0][(j) & 3][n]
#define XV(j) acc[(j) >> 2][1][(j) & 3][n]
            const f32x4 gm1 = dpp_shr1(XG(7)), gm2 = dpp_shr1(XG(6)), vm1 = dpp_shr1(XV(7)), vm2 = dpp_shr1(XV(6));
            if (fr == 0) { float* hp = HALO + (size_t)(blk * 4) * 11008 + c; *(f32x4*)hp = XG(0); *(f32x4*)(hp + 11008) = XG(1); *(f32x4*)(hp + 5504) = XV(0); *(f32x4*)(hp + 11008 + 5504) = XV(1); }
            if (fr == 15) { float* hp = HALO + (size_t)(blk * 4 + 2) * 11008 + c; *(f32x4*)hp = XG(6); *(f32x4*)(hp + 11008) = XG(7); *(f32x4*)(hp + 5504) = XV(6); *(f32x4*)(hp + 11008 + 5504) = XV(7); }
#pragma unroll
            for (int j = 0; j < 8; ++j) {
                const f32x4 g2 = (j >= 2) ? XG(j >= 2 ? j - 2 : 0) : (j == 0 ? gm2 : gm1), g1 = (j >= 1) ? XG(j >= 1 ? j - 1 : 0) : gm1;
                const f32x4 v2 = (j >= 2) ? XV(j >= 2 ? j - 2 : 0) : (j == 0 ? vm2 : vm1), v1 = (j >= 1) ? XV(j >= 1 ? j - 1 : 0) : vm1;
                const f32x4 cg = bg + wg0 * g2 + wg1 * g1 + wg2 * XG(j), cv = bv + wv0 * v2 + wv1 * v1 + wv2 * XV(j);
                const unsigned p0 = cvt_pk_bf16(gelu_tanh1(cg[0]) * cv[0], gelu_tanh1(cg[1]) * cv[1]), p1 = cvt_pk_bf16(gelu_tanh1(cg[2]) * cv[2], gelu_tanh1(cg[3]) * cv[3]);
                if (n == 0) { pk[j][0] = p0; pk[j][1] = p1; }
                else if (!(fr == 0 && j < 2)) *(u32x4*)(ACT + (size_t)(prow + j) * 5504 + ch0) = (u32x4){pk[j][0], pk[j][1], p0, p1};
            }
#undef XG
#undef XV
        }
    }
};
struct EpiProj {
    static constexpr bool PERM = true, AFTER_DRAIN = false, PERMA = false;
    bf16_t *U16, *CQ, *CKV, *HQ, *HV, *HGT, *KF; float* LOGF; float* ssq_q; float* ssq_kv; const float* lb; const float* cosT; const float* sinT;
    __device__ __forceinline__ void operator()(const f32x4 (&acc)[2][2][4][2], const Unit& u, int wr, int wc, int fr, int fq) const {
        const int row0 = u.pm * BM + wr * 64 + fr, col8 = wc * 32 + 8 * fq, pn = u.pn;
        if (pn == 13) {
            if (wc < 2) { const int f0 = (wc * 4 + fq) * 4;
#pragma unroll
                for (int ai = 0; ai < 2; ++ai)
#pragma unroll
                    for (int m = 0; m < 4; ++m) { const int row = row0 + ai * HALF + m * 16, b = row >> 12, s = row & 4095;
                        const f32x4 cs = *(const f32x4*)(cosT + (size_t)row * 32 + f0), sn = *(const f32x4*)(sinT + (size_t)row * 32 + f0);
                        const f32x4 x1 = acc[ai][0][m][0], x2 = acc[ai][0][m][1]; const f32x4 o1 = x1 * cs - x2 * sn, o2 = x2 * cs + x1 * sn;
                        typedef unsigned u32x2 __attribute__((ext_vector_type(2)));
                        const u32x2 w1 = (u32x2){cvt_pk_bf16(o1[0], o1[1]), cvt_pk_bf16(o1[2], o1[3])}, w2 = (u32x2){cvt_pk_bf16(o2[0], o2[1]), cvt_pk_bf16(o2[2], o2[3])};
#pragma unroll
                        for (int h = 0; h < 8; ++h) { bf16_t* kp = KF + ((size_t)(b * 8 + h) * 4096 + s) * 192 + 128 + f0; *(u32x2*)kp = w1; *(u32x2*)(kp + 32) = w2; } } }
            return;
        }
        if (pn == 7 || pn == 8) {
            const int cbase = (pn - 7) * 256;
#pragma unroll
            for (int bj = 0; bj < 2; ++bj) { const int col = cbase + bj * HALF + col8; const f32x4 l0 = *(const f32x4*)(lb + col), l1 = *(const f32x4*)(lb + col + 4);
#pragma unroll
                for (int ai = 0; ai < 2; ++ai)
#pragma unroll
                    for (int m = 0; m < 4; ++m) { const size_t row = (size_t)(row0 + ai * HALF + m * 16); f32x4 o0, o1;
#pragma unroll
                        for (int e = 0; e < 4; ++e) { const float z0 = acc[ai][bj][m][0][e], z1 = acc[ai][bj][m][1][e];
                            o0[e] = __logf(l0[e] + (1.f - l0[e]) * __builtin_amdgcn_rcpf(1.f + __expf(-z0))); o1[e] = __logf(l1[e] + (1.f - l1[e]) * __builtin_amdgcn_rcpf(1.f + __expf(-z1))); }
                        *(f32x4*)(LOGF + row * 512 + col) = o0; *(f32x4*)(LOGF + row * 512 + col + 4) = o1; } }
            return;
        }
        bf16_t* base; int ld, cbase, nslot = 0, slot0 = 0; bool act = false; float* ssq = nullptr;
        if (pn < 2) { base = U16; ld = 512; cbase = pn * 256; }
        else if (pn < 4) { base = CQ; ld = 512; cbase = (pn - 2) * 256; ssq = ssq_q; nslot = 8; slot0 = (pn - 2) * 4; }
        else if (pn == 4) { base = CKV; ld = 256; cbase = 0; ssq = ssq_kv; nslot = 4; }
        else if (pn < 7) { base = HQ; ld = 512; cbase = (pn - 5) * 256; act = true; }
        else if (pn < 11) { base = HV; ld = 512; cbase = (pn - 9) * 256; }
        else { base = HGT; ld = 512; cbase = (pn - 11) * 256; act = true; }
#pragma unroll
        for (int ai = 0; ai < 2; ++ai)
#pragma unroll
            for (int m = 0; m < 4; ++m) { const size_t row = (size_t)(row0 + ai * HALF + m * 16); float ss = 0.f;
#pragma unroll
                for (int bj = 0; bj < 2; ++bj) { f32x4 v0 = acc[ai][bj][m][0], v1 = acc[ai][bj][m][1];
                    ss += (v0[0] * v0[0] + v0[1] * v0[1]) + (v0[2] * v0[2] + v0[3] * v0[3]) + (v1[0] * v1[0] + v1[1] * v1[1]) + (v1[2] * v1[2] + v1[3] * v1[3]);
                    if (act) {
#pragma unroll
                        for (int e = 0; e < 4; ++e) { v0[e] = v0[e] * __builtin_amdgcn_rcpf(1.f + __expf(-v0[e])); v1[e] = v1[e] * __builtin_amdgcn_rcpf(1.f + __expf(-v1[e])); } }
                    u32x4 w; w.x = cvt_pk_bf16(v0[0], v0[1]); w.y = cvt_pk_bf16(v0[2], v0[3]); w.z = cvt_pk_bf16(v1[0], v1[1]); w.w = cvt_pk_bf16(v1[2], v1[3]);
                    *(u32x4*)(base + row * ld + cbase + bj * HALF + col8) = w; }
                if (ssq) { const int ln_ = fq * 16 + fr; ss += __builtin_bit_cast(float, __builtin_amdgcn_ds_bpermute((ln_ ^ 16) << 2, __builtin_bit_cast(int, ss))); ss += __builtin_bit_cast(float, __builtin_amdgcn_ds_bpermute((ln_ ^ 32) << 2, __builtin_bit_cast(int, ss))); if (fq == 0) ssq[row * nslot + slot0 + wc] = ss; } }
    }
};
struct EpiQGlu {
    static constexpr bool PERM = true, AFTER_DRAIN = false, PERMA = false;
    EpiQ q; EpiGlu glu;
    __device__ __forceinline__ void operator()(const f32x4 (&acc)[2][2][4][2], const Unit& u, int wr, int wc, int fr, int fq) const {
        if (u.pn < 6) q(acc, u, wr, wc, fr, fq);
        else { Unit v; v.pm = u.pm; v.pn = u.pn - 6; glu(acc, v, wr, wc, fr, fq); }
    }
};
template <class Epi, class Sched, bool ALIGN_EPI = false, bool SP2 = false>
__device__ __forceinline__ void gemm_phase(PG8_LAS unsigned char* lds, const Gemm g, const Sched& S, const Epi& E) {
    int tid_ = threadIdx.x; asm volatile("" : "+v"(tid_));
    const int tid = tid_, wid = __builtin_amdgcn_readfirstlane(tid >> 6), lane = tid & 63, wr = wid >> 2, wc = wid & 3, fr = lane & 15, fq = lane >> 4;
    const int K = g.K, nt = K / BK;
    unsigned voffA[2], voffB[2];
#pragma unroll
    for (int i = 0; i < 2; ++i) { int R, C; stage_rc(tid * 16 + i * 8192, R, C); const int Rb = Epi::PERM ? ((R & ~31) + perm32(R & 31)) : R;
        const int Ra = Epi::PERMA ? (((R >> 6) & 1) * 128 + (R & 15) * 8 + ((R >> 4) & 3)) : R;
        voffA[i] = (unsigned)(Ra * K + C) * 2u; voffB[i] = (unsigned)(Rb * K + C) * 2u; }
    const size_t kstep = (size_t)(BK * 2);
    const size_t hstep = (size_t)HALF * K * 2;
    const size_t hstepA = Epi::PERMA ? (size_t)4 * K * 2 : hstep;
    const size_t tstep = 2 * hstep;
    const unsigned ldsw = (unsigned)wid * 1024u;
    const int aoff = lds_byte(wr * 64 + fr, fq * 8), boff = lds_byte(wc * 32 + fr, fq * 8);
#define PG8_SA(b, h) (((b) * 2 + (h)) * HTB)
#define PG8_SB(b, h) ((4 + (b) * 2 + (h)) * HTB)
#define PG8_STAGE(bufoff, gbase, voff) do { _Pragma("unroll") for (int _i = 0; _i < 2; ++_i) \
        __builtin_amdgcn_global_load_lds((const unsigned*)((const char*)(gbase) + (voff)[_i]), (PG8_LAS unsigned*)(lds + (bufoff) + ldsw + _i * 8192), 16, 0, 0); } while (0)
#define PG8_LDA(dst, b, h) do { _Pragma("unroll") for (int m = 0; m < 4; ++m) _Pragma("unroll") for (int k = 0; k < 2; ++k) dst[m][k] = *(const PG8_LAS bf16x8*)(lds + PG8_SA(b, h) + aoff + m * 2048 + k * 1024); } while (0)
#define PG8_LDB(dst, b, h) do { _Pragma("unroll") for (int n = 0; n < 2; ++n) _Pragma("unroll") for (int k = 0; k < 2; ++k) dst[n][k] = *(const PG8_LAS bf16x8*)(lds + PG8_SB(b, h) + boff + n * 2048 + k * 1024); } while (0)
#define PG8_MMA(ai, bj, At, Bt) do { __builtin_amdgcn_s_setprio(1); _Pragma("unroll") for (int m = 0; m < 4; ++m) _Pragma("unroll") for (int n = 0; n < 2; ++n) _Pragma("unroll") for (int k = 0; k < 2; ++k) \
        acc[ai][bj][m][n] = __builtin_amdgcn_mfma_f32_16x16x32_bf16(Bt[n][k], At[m][k], acc[ai][bj][m][n], 0, 0, 0); __builtin_amdgcn_s_setprio(0); } while (0)
#define PG8_WAIT_V(n) asm volatile("s_waitcnt vmcnt(" #n ")" ::: "memory")
#define PG8_WAIT_L(n) asm volatile("s_waitcnt lgkmcnt(" #n ")" ::: "memory")
#define PG8_BAR __builtin_amdgcn_s_barrier()
#define PG8_SCHED __builtin_amdgcn_sched_barrier(0)
    Unit cur, nxt; int ui = 0;
    if (!S.next(0, cur)) return;
    f32x4 acc[2][2][4][2];
#pragma unroll
    for (int a = 0; a < 2; ++a)
#pragma unroll
        for (int b = 0; b < 2; ++b)
#pragma unroll
            for (int m = 0; m < 4; ++m)
#pragma unroll
                for (int n = 0; n < 2; ++n) acc[a][b][m][n] = (f32x4){0.f, 0.f, 0.f, 0.f};
    bf16x8 At[4][2], B0[2][2], B1[2][2];
    const char* cA = (const char*)(cur.pn >= g.pn_split ? g.A2 : g.A) + (size_t)cur.pm * tstep; const char* cB = (const char*)g.Bt + (size_t)cur.pn * tstep;
    S.a_ready(cur);
    if constexpr (SP2) {
        PG8_STAGE(PG8_SB(0, 0), cB, voffB); PG8_STAGE(PG8_SB(0, 1), cB + hstep, voffB); PG8_STAGE(PG8_SA(0, 0), cA, voffA); PG8_STAGE(PG8_SA(0, 1), cA + hstepA, voffA);
        if (wr == 1) PG8_BAR;
        PG8_WAIT_V(2); PG8_BAR;
        PG8_STAGE(PG8_SB(1, 0), cB + kstep, voffB); PG8_STAGE(PG8_SA(1, 0), cA + kstep, voffA); PG8_STAGE(PG8_SB(1, 1), cB + hstep + kstep, voffB);
        PG8_WAIT_V(6); PG8_BAR;
    } else {
        PG8_STAGE(PG8_SB(0, 0), cB, voffB); PG8_STAGE(PG8_SA(0, 0), cA, voffA); PG8_STAGE(PG8_SB(0, 1), cB + hstep, voffB); PG8_STAGE(PG8_SA(0, 1), cA + hstepA, voffA);
        if (wr == 1) PG8_BAR;
        PG8_WAIT_V(4); PG8_BAR;
        PG8_STAGE(PG8_SB(1, 0), cB + kstep, voffB); PG8_STAGE(PG8_SA(1, 0), cA + kstep, voffA); PG8_STAGE(PG8_SB(1, 1), cB + hstep + kstep, voffB);
        PG8_WAIT_V(6); PG8_BAR;
    }
    for (;;) {
        const bool has_next = S.next(ui + 1, nxt);
        const char* nA = has_next ? (const char*)(nxt.pn >= g.pn_split ? g.A2 : g.A) + (size_t)nxt.pm * tstep : cA; const char* nB = has_next ? (const char*)g.Bt + (size_t)nxt.pn * tstep : cB;
        for (int t = 0; t < nt; t += 2) {
            const bool last = (t == nt - 2);
            const char* a1 = cA + (size_t)(t + 1) * kstep;
            const char* a2 = last ? nA : cA + (size_t)(t + 2) * kstep; const char* b2 = last ? nB : cB + (size_t)(t + 2) * kstep;
            const char* a3 = a2 + kstep; const char* b3 = b2 + kstep;
            if (last && has_next) S.a_ready(nxt);
            if constexpr (SP2) {
            PG8_LDB(B0, 0, 0); PG8_LDB(B1, 0, 1); PG8_SCHED; PG8_LDA(At, 0, 0); PG8_STAGE(PG8_SA(1, 1), a1 + hstepA, voffA);
            PG8_WAIT_V(8); PG8_WAIT_L(0); PG8_BAR; PG8_MMA(0, 0, At, B0); PG8_MMA(0, 1, At, B1); PG8_BAR; PG8_SCHED;
            PG8_LDA(At, 0, 1); PG8_STAGE(PG8_SB(0, 0), b2, voffB); PG8_STAGE(PG8_SB(0, 1), b2 + hstep, voffB); PG8_STAGE(PG8_SA(0, 0), a2, voffA);
            PG8_WAIT_V(8); PG8_WAIT_L(0); PG8_BAR; PG8_MMA(1, 0, At, B0); PG8_MMA(1, 1, At, B1); PG8_BAR; PG8_SCHED;
            PG8_LDB(B0, 1, 0); PG8_LDB(B1, 1, 1); PG8_SCHED; PG8_LDA(At, 1, 0); PG8_STAGE(PG8_SA(0, 1), a2 + hstepA, voffA);
            PG8_WAIT_V(8); PG8_WAIT_L(0); PG8_BAR; PG8_MMA(0, 0, At, B0); PG8_MMA(0, 1, At, B1); PG8_BAR; PG8_SCHED;
            PG8_LDA(At, 1, 1); PG8_STAGE(PG8_SB(1, 0), b3, voffB); PG8_STAGE(PG8_SB(1, 1), b3 + hstep, voffB); PG8_STAGE(PG8_SA(1, 0), a3, voffA);
            PG8_WAIT_V(8); PG8_WAIT_L(0); PG8_BAR; PG8_MMA(1, 0, At, B0); PG8_MMA(1, 1, At, B1); PG8_BAR; PG8_SCHED;
            } else {
            PG8_LDB(B0, 0, 0); PG8_SCHED; PG8_LDA(At, 0, 0); PG8_STAGE(PG8_SA(1, 1), a1 + hstepA, voffA);
            PG8_WAIT_L(8); PG8_BAR; PG8_WAIT_L(0); PG8_MMA(0, 0, At, B0); PG8_BAR; PG8_SCHED;
            PG8_LDB(B1, 0, 1); PG8_STAGE(PG8_SB(0, 0), b2, voffB);
            PG8_BAR; PG8_WAIT_L(0); PG8_MMA(0, 1, At, B1); PG8_BAR;
            PG8_LDA(At, 0, 1); PG8_STAGE(PG8_SA(0, 0), a2, voffA);
            PG8_BAR; PG8_WAIT_L(0); PG8_MMA(1, 0, At, B0); PG8_BAR; PG8_SCHED;
            PG8_STAGE(PG8_SB(0, 1), b2 + hstep, voffB);
            PG8_WAIT_V(6); PG8_BAR; PG8_MMA(1, 1, At, B1); PG8_BAR;
            PG8_LDB(B0, 1, 0); PG8_SCHED; PG8_LDA(At, 1, 0); PG8_STAGE(PG8_SA(0, 1), a2 + hstepA, voffA);
            PG8_WAIT_L(8); PG8_BAR; PG8_WAIT_L(0); PG8_MMA(0, 0, At, B0); PG8_BAR; PG8_SCHED;
            PG8_LDB(B1, 1, 1); PG8_STAGE(PG8_SB(1, 0), b3, voffB);
            PG8_BAR; PG8_WAIT_L(0); PG8_MMA(0, 1, At, B1); PG8_BAR;
            PG8_LDA(At, 1, 1); PG8_STAGE(PG8_SA(1, 0), a3, voffA);
            PG8_BAR; PG8_WAIT_L(0); PG8_MMA(1, 0, At, B0); PG8_BAR; PG8_SCHED;
            PG8_STAGE(PG8_SB(1, 1), b3 + hstep, voffB);
            PG8_WAIT_V(6); PG8_BAR; PG8_MMA(1, 1, At, B1); PG8_BAR;
            }
        }
        if constexpr (ALIGN_EPI) { if (wr == 0) PG8_BAR; }
        if constexpr (!Epi::AFTER_DRAIN) { E(acc, cur, wr, wc, fr, fq); S.done(cur); }
        if (!has_next) break;
#pragma unroll
        for (int a = 0; a < 2; ++a)
#pragma unroll
            for (int b = 0; b < 2; ++b)
#pragma unroll
                for (int m = 0; m < 4; ++m)
#pragma unroll
                    for (int n = 0; n < 2; ++n) acc[a][b][m][n] = (f32x4){0.f, 0.f, 0.f, 0.f};
        cur = nxt; cA = nA; cB = nB; ++ui;
        if constexpr (ALIGN_EPI) { if (wr == 1) PG8_BAR; }
    }
    PG8_WAIT_V(0);
    if constexpr (!ALIGN_EPI) { if (wr == 0) PG8_BAR; }
    PG8_BAR;
    if constexpr (Epi::AFTER_DRAIN) { E.fused(acc, cur, wr, wc, fr, fq, lds, wid, lane); S.done(cur); }
#undef PG8_SA
#undef PG8_SB
#undef PG8_STAGE
#undef PG8_LDA
#undef PG8_LDB
#undef PG8_MMA
#undef PG8_WAIT_V
#undef PG8_WAIT_L
#undef PG8_BAR
#undef PG8_SCHED
}
}
constexpr int NB = 4, SEQ = 4096, DM = 2048, NL = 4, M = NB * SEQ;
constexpr int DIN = 3392, DINP = 3584;
constexpr int NH = 8, DQK = 192, QRANK = 512, KVRANK = 256;
constexpr int DFF = 5504, DFF2 = 11008;
constexpr float EPS = 1e-6f;
constexpr int PC_S5 = 0, PC_CQ = 512, PC_CKV = 1024, PC_HQ = 1280, PC_HF = 1792, PC_HI = 2304, PC_HG = 2816, PC_KR = 3328;
constexpr int NWAVES = 8, NTHR = 512;
constexpr int LDS_BYTES = 147456, RING_BYTES = 131072, CTRL_OFF = LDS_BYTES - 2048, MISC_OFF = CTRL_OFF + 320;

enum { I_X = 0, I_C, I_POS, I_WIN, I_LRE, I_LIM, I_LDT, I_BRE, I_BIM, I_CRE, I_CIM, I_S5D, I_WGLU, I_QN, I_WUQ, I_KVN, I_WUKV, I_LB, I_HGN, I_WOUT,
       I_MPRE, I_MPOST, I_FPRE, I_FPOST, I_WUP, I_CW, I_CB, I_WDN, I_WADA, I_BADA, N_IN };

constexpr size_t MiB = 1u << 20;
#ifndef MK_ONE_LAUNCH
#define MK_ONE_LAUNCH 1
#endif
constexpr size_t WS_CTL = 0, CTL_ZERO_BYTES = 1 * MiB;
constexpr int CW_BAR = 4096;
constexpr size_t WS_MODP = 1 * MiB;
constexpr size_t WS_MOD = 13 * MiB;
constexpr size_t WS_COS = 14 * MiB, WS_SIN = 16 * MiB;
constexpr size_t WS_LB = 18 * MiB;
constexpr size_t WS_RSTDQ = 18 * MiB + 65536, WS_RSTDKV = 18 * MiB + 2 * 65536;
constexpr size_t WS_W = 19 * MiB;
constexpr size_t WL_IN = 0, WL_UQ = WL_IN + (size_t)DINP * DM * 2, WL_GLU = WL_UQ + (size_t)1536 * 512 * 2  , WL_UKV = WL_GLU + (size_t)512 * 512 * 2,
                 WL_OUT = WL_UKV + (size_t)2048 * 256 * 2, WL_UP = WL_OUT + (size_t)DM * DM * 2, WL_DN = WL_UP + (size_t)DFF2 * DM * 2, WL_SIZE = WL_DN + (size_t)DM * DFF * 2;
static_assert(WL_SIZE == 93847552, "weight bytes per layer");
constexpr size_t WS_X = 378 * MiB;
constexpr size_t WS_H = 506 * MiB;
constexpr size_t WS_T1 = 570 * MiB;
constexpr size_t WS_T2 = 914 * MiB;
constexpr size_t WS_ACT = 1138 * MiB;
constexpr size_t WS_CAT = 1310 * MiB;
constexpr size_t WS_MISC = 1374 * MiB;
constexpr size_t WS_CQ = WS_MISC, WS_CKV = WS_MISC + 16 * MiB, WS_YG16 = WS_MISC + 24 * MiB, WS_DS5 = WS_MISC + 40 * MiB, WS_HP = WS_MISC + 44 * MiB, WS_BLAST = WS_MISC + 46 * MiB;
constexpr size_t WS_U16 = WS_T1, WS_HQ = WS_T1 + 16 * MiB, WS_LOGF = WS_T1 + 32 * MiB, WS_HV = WS_T1 + 64 * MiB, WS_HGT = WS_T1 + 80 * MiB;
constexpr size_t WS_SSQQ = WS_MISC + 47 * MiB, WS_SSQKV = WS_MISC + 47 * MiB + 512 * 1024;
constexpr size_t WS_DST = WS_T1 + 224 * MiB;
constexpr size_t WS_S5T = WS_T1 + 96 * MiB;
constexpr size_t WS_HALO = WS_T1 + 310 * MiB;
constexpr size_t WS_SPT = WS_ACT + 128 * MiB;
constexpr size_t WS_PW = 1510 * MiB;
constexpr size_t WS_BBAR = 1515 * MiB;
constexpr size_t WS_END = 1516 * MiB;
static_assert(WS_W + NL * WL_SIZE <= WS_X, "weights fit");

#define GAS __attribute__((address_space(1)))
#define LAS __attribute__((address_space(3)))
typedef unsigned short bf16;
typedef unsigned v4u __attribute__((ext_vector_type(4)));
typedef unsigned v2u __attribute__((ext_vector_type(2)));
typedef float f32x4 __attribute__((ext_vector_type(4)));
typedef GAS unsigned gu32;
#define RLX_AGENT __ATOMIC_RELAXED, __HIP_MEMORY_SCOPE_AGENT
#define LDS_WAIT() asm volatile("s_waitcnt lgkmcnt(0)" ::: "memory")
__device__ __forceinline__ unsigned f2bf(float f) { unsigned u = __builtin_bit_cast(unsigned, f); return (u + 0x7fffu + ((u >> 16) & 1u)) >> 16; }
__device__ __forceinline__ unsigned pk2(float lo, float hi) { return f2bf(lo) | (f2bf(hi) << 16); }
__device__ __forceinline__ float bf2f(unsigned short b) { return __builtin_bit_cast(float, ((unsigned)b) << 16); }
__device__ __forceinline__ float shx(float v, int o, int lane) { return __builtin_bit_cast(float, __builtin_amdgcn_ds_bpermute((lane ^ o) << 2, __builtin_bit_cast(int, v))); }
__device__ __forceinline__ float wave_sum(float v, int lane) {
#pragma unroll
    for (int o = 1; o < 64; o <<= 1) v += shx(v, o, lane);
    return v;
}
__device__ __forceinline__ float sigmoidf_(float x) { return 1.f / (1.f + __expf(-x)); }
__device__ __forceinline__ float siluf_(float x) { return x / (1.f + __expf(-x)); }
__device__ __forceinline__ float gelu_tanh(float x) { const float t = 0.7978845608028654f * (x + 0.044715f * x * x * x); return x / (1.f + __expf(-2.f * t)); }
#define XB_TMO      128
#define XB_XCNT(j)  (256  + 64 * (j))
#define XB_XSUB(j)  (1280 + 64 * (j))
#define XB_XGEN(j)  (2304 + 64 * (j))
#define XB_TOP      3328
#define XB_TOPGEN   3392
#define XCD_BAR_WORDS 3456
#define XB_SPIN_CAP (1u << 18)

__device__ __forceinline__ unsigned xb_ld(unsigned* p)              { return __hip_atomic_load(p, __ATOMIC_RELAXED, __HIP_MEMORY_SCOPE_AGENT); }
__device__ __forceinline__ unsigned xb_add(unsigned* p, unsigned v) { return __hip_atomic_fetch_add(p, v, __ATOMIC_RELAXED, __HIP_MEMORY_SCOPE_AGENT); }
__device__ __forceinline__ unsigned xb_xcc_id() { return (unsigned)__builtin_amdgcn_s_getreg((3 << 11) | 20) & 0xFu; }
#define XB_SPIN(cond, bar) do { unsigned _sp = 0; while (cond) { __builtin_amdgcn_s_sleep(1); \
    if ((++_sp & 255u) == 0u) { if (xb_ld(&(bar)[XB_TMO])) break; if (_sp > XB_SPIN_CAP) { atomicAdd(&(bar)[XB_TMO], 1u); break; } } } } while (0)

struct XcdBarrier {
    unsigned* bar; unsigned x;
    volatile LAS unsigned* st;
};

__device__ __forceinline__ XcdBarrier xcd_barrier_post(unsigned* bar, volatile LAS unsigned* st) {
    XcdBarrier b; b.bar = bar; b.x = xb_xcc_id(); b.st = st;
    if (threadIdx.x == 0) (void)xb_add(&bar[XB_XCNT(b.x)], 1u);
    return b;
}
__device__ __forceinline__ void xcd_barrier_complete(unsigned* bar, unsigned x, unsigned& nloc, unsigned& nx) {
    const unsigned G = gridDim.x * gridDim.y * gridDim.z;
    unsigned sum, cnt, mine, sp = 0u;
    for (;;) {
        sum = 0u; cnt = 0u; mine = 0u;
#pragma unroll
        for (unsigned j = 0; j < 16; ++j) { const unsigned c = xb_ld(&bar[XB_XCNT(j)]); sum += c; cnt += (c > 0u) ? 1u : 0u; mine = (j == x) ? c : mine; }
        if (sum == G) break;
        __builtin_amdgcn_s_sleep(1);
        if ((++sp & 255u) == 0u) { if (xb_ld(&bar[XB_TMO])) break; if (sp > XB_SPIN_CAP) { atomicAdd(&bar[XB_TMO], 1u); break; } }
    }
    nloc = mine > 0u ? mine : 1u; nx = cnt > 0u ? cnt : 1u;
}

__device__ __forceinline__ void xcd_barrier(const XcdBarrier& b) {
    asm volatile("s_waitcnt vmcnt(0)" ::: "memory");
    __syncthreads();
    if (threadIdx.x == 0) {
        unsigned* bar = b.bar;
        __builtin_amdgcn_s_waitcnt(0);
        unsigned nloc = b.st[0], nx = b.st[1];
        if (nloc == 0u) { xcd_barrier_complete(bar, b.x, nloc, nx); b.st[0] = nloc; b.st[1] = nx; }
        const unsigned old = xb_add(&bar[XB_XSUB(b.x)], 1u);
        const unsigned gen = old / nloc;
        if (old + 1u == (gen + 1u) * nloc) {
            __builtin_amdgcn_fence(__ATOMIC_RELEASE, "agent");
            asm volatile("s_waitcnt vmcnt(0)" ::: "memory");
            const unsigned og = xb_add(&bar[XB_TOP], 1u);
            const unsigned tg = og / nx;
            if (og + 1u == (tg + 1u) * nx) xb_add(&bar[XB_TOPGEN], 1u);
            else XB_SPIN(xb_ld(&bar[XB_TOPGEN]) == tg, bar);
            __builtin_amdgcn_fence(__ATOMIC_ACQUIRE, "agent");
            xb_add(&bar[XB_XGEN(b.x)], 1u);
            asm volatile("s_waitcnt vmcnt(0)" ::: "memory");
        } else {
            XB_SPIN(xb_ld(&bar[XB_XGEN(b.x)]) == gen, bar);
            __builtin_amdgcn_fence(__ATOMIC_ACQUIRE, "agent");
            asm volatile("s_waitcnt vmcnt(0)" ::: "memory");
        }
    }
    __syncthreads();
}
namespace att {
typedef short bf16x8 __attribute__((ext_vector_type(8)));
typedef short s16x4 __attribute__((ext_vector_type(4)));
typedef float f32x16 __attribute__((ext_vector_type(16)));
typedef float f32x4 __attribute__((ext_vector_type(4)));
typedef unsigned u32x4 __attribute__((ext_vector_type(4)));
constexpr int DQ = 192, DVV = 128, QBLK = 32, KVBLK = 64, QB = 256;
constexpr int SHM_V = KVBLK * DVV * 2, SHM_K = KVBLK * DQ * 2;
constexpr int LDS_V = 0, LDS_K = 3 * SHM_V, LDS_WS = LDS_K + 2 * SHM_K, LDS_OST = LDS_WS + 8 * 64 * 4, ATT_LDS = LDS_OST;
constexpr float SCALE = 0.07216878364870322f;
constexpr float QSCALE = SCALE * 1.4426950408889634f;
constexpr float THR2 = 8.f * 1.4426950408889634f;
#define SBAR() __builtin_amdgcn_sched_barrier(0)
__device__ __forceinline__ int v_st(int k, int c) { const int kk = (k & ~0xC) | ((k & 4) << 1) | ((k & 8) >> 1); return ((kk >> 3) * 4 + (c >> 5)) * 512 + ((kk & 7) * 32 + (c & 31)) * 2; }
__device__ __forceinline__ int v_rd_base(int lane) { return ((lane & 3) << 3) | (((lane >> 2) & 3) << 6) | (((lane >> 4) & 1) << 5) | (((lane >> 5) & 1) << 8); }
constexpr int v_rd_off(int d0, int ks, int half) { return d0 * 512 + ks * 4096 + half * 2048; }
__device__ __forceinline__ int crow(int r, int hi) { return (r & 3) + 8 * (r >> 2) + 4 * hi; }
__device__ __forceinline__ unsigned cvtpk(float lo, float hi) { typedef float f2_ __attribute__((ext_vector_type(2))); typedef __bf16 b2_ __attribute__((ext_vector_type(2))); const b2_ r = __builtin_convertvector((f2_){lo, hi}, b2_); return __builtin_bit_cast(unsigned, r); }
__device__ __forceinline__ int k_off(int row, int chunk  ) { return (chunk >> 3) * 8192 + row * 128 + ((((chunk & 7) ^ ((row >> 1) & 7))) << 4); }

__device__ __forceinline__ void mask_tile(f32x16& p0, f32x16& p1, int dq) {
    const float NEG = -__builtin_inff();
#pragma unroll
    for (int r = 0; r < 16; ++r) { const int c = (r & 3) + 8 * (r >> 2);
        if (dq - c < 0) p0[r] = NEG;
        if (dq - c - 32 < 0) p1[r] = NEG; }
}
__device__ __forceinline__ void partialSM(f32x16& p0, f32x16& p1, float& m_reg, float bs, float& alpha) {
    float pmax = p0[0];
#pragma unroll
    for (int r = 1; r < 16; ++r) pmax = fmaxf(pmax, p0[r]);
#pragma unroll
    for (int r = 0; r < 16; ++r) pmax = fmaxf(pmax, p1[r]);
    { auto rr = __builtin_amdgcn_permlane32_swap(__float_as_uint(pmax), __float_as_uint(pmax), false, false);
      pmax = fmaxf(__uint_as_float(rr[0]), __uint_as_float(rr[1])); }
    if (__builtin_expect(__all(pmax + bs - m_reg <= THR2), 1)) { alpha = 1.f; }
    else { const float mn = fmaxf(m_reg, pmax + bs); alpha = __builtin_amdgcn_exp2f(m_reg - mn); const float off = bs - mn; m_reg = mn;
#pragma unroll
        for (int r = 0; r < 16; ++r) { p0[r] += off; p1[r] += off; } }
#pragma unroll
    for (int r = 0; r < 16; ++r) p0[r] = __builtin_amdgcn_exp2f(p0[r]);
#pragma unroll
    for (int r = 0; r < 16; ++r) p1[r] = __builtin_amdgcn_exp2f(p1[r]);
}
__device__ __forceinline__ void finishSM(f32x16& p0, f32x16& p1, float alpha, float& l_reg, bf16x8& pa0, bf16x8& pa1, bf16x8& pa2, bf16x8& pa3) {
    float ps = 0;
#pragma unroll
    for (int r = 0; r < 16; ++r) ps += p0[r];
#pragma unroll
    for (int r = 0; r < 16; ++r) ps += p1[r];
    { auto rr = __builtin_amdgcn_permlane32_swap(__float_as_uint(ps), __float_as_uint(ps), false, false);
      ps = __uint_as_float(rr[0]) + __uint_as_float(rr[1]); }
    l_reg = l_reg * alpha + ps;
#define PK4(P, B_, OUT) do { unsigned a0 = cvtpk(P[B_+0], P[B_+1]), a1 = cvtpk(P[B_+2], P[B_+3]);                          \
        unsigned b0 = cvtpk(P[B_+4], P[B_+5]), b1 = cvtpk(P[B_+6], P[B_+7]);                                             \
        auto r0 = __builtin_amdgcn_permlane32_swap(a0, b0, false, false); auto r1 = __builtin_amdgcn_permlane32_swap(a1, b1, false, false); \
        u32x4 w = {r0[0], r1[0], r0[1], r1[1]}; OUT = *reinterpret_cast<bf16x8*>(&w); } while (0)
    PK4(p0, 0, pa0); PK4(p0, 8, pa1); PK4(p1, 0, pa2); PK4(p1, 8, pa3);
#undef PK4
}
__device__ __forceinline__ void qkt(f32x16& p0, f32x16& p1, const LAS unsigned char* lds, int kbuf, int r32, int hi, const bf16x8* qr, float init) {
#pragma unroll
    for (int r = 0; r < 16; ++r) { p0[r] = init; p1[r] = init; }
    const int e = hi ^ ((r32 >> 1) & 7);
    int kb[4];
#pragma unroll
    for (int j = 0; j < 4; ++j) kb[j] = (int)(uintptr_t)lds + kbuf + r32 * 128 + ((((j << 1) ^ e)) << 4);
#define KRD(dst, d0_, h_) asm volatile("ds_read_b128 %0, %1 offset:%2" : "=&v"(dst) : "v"(kb[(d0_) & 3]), "i"(((d0_) >> 2) * 8192 + (h_) * 4096) : "memory")
    bf16x8 ka[3][2];
    KRD(ka[0][0], 0, 0); KRD(ka[0][1], 0, 1); KRD(ka[1][0], 1, 0); KRD(ka[1][1], 1, 1);
#pragma unroll
    for (int d0 = 0; d0 < 12; ++d0) {
        if (d0 + 2 < 12) { KRD(ka[(d0 + 2) % 3][0], d0 + 2, 0); KRD(ka[(d0 + 2) % 3][1], d0 + 2, 1); asm volatile("s_waitcnt lgkmcnt(4)" ::: "memory"); }
        else if (d0 == 10) asm volatile("s_waitcnt lgkmcnt(2)" ::: "memory");
        else asm volatile("s_waitcnt lgkmcnt(0)" ::: "memory");
        SBAR();
        p0 = __builtin_amdgcn_mfma_f32_32x32x16_bf16(ka[d0 % 3][0], qr[d0], p0, 0, 0, 0);
        p1 = __builtin_amdgcn_mfma_f32_32x32x16_bf16(ka[d0 % 3][1], qr[d0], p1, 0, 0, 0);
        SBAR(); }
#undef KRD
}
__device__ __forceinline__ void pv_tile(f32x16* o, int vb0, bf16x8 pa0, bf16x8 pa1, bf16x8 pa2, bf16x8 pa3) {
#define TRRD(dst, off) asm volatile("ds_read_b64_tr_b16 %0, %1 offset:%2" : "=&v"(dst) : "v"(vb0), "i"(off) : "memory")
#define PV_D0(d0) do { s16x4 l0, l1, l2, l3, h0, h1, h2, h3; constexpr int b_ = v_rd_off(d0, 0, 0); \
        TRRD(l0, b_); TRRD(h0, b_ + 2048); TRRD(l1, b_ + 4096); TRRD(h1, b_ + 6144); TRRD(l2, b_ + 8192); TRRD(h2, b_ + 10240); TRRD(l3, b_ + 12288); TRRD(h3, b_ + 14336); \
        asm volatile("s_waitcnt lgkmcnt(0)" ::: "memory"); SBAR();   \
        o[d0] = __builtin_amdgcn_mfma_f32_32x32x16_bf16(pa0, (bf16x8){l0[0], l0[1], l0[2], l0[3], h0[0], h0[1], h0[2], h0[3]}, o[d0], 0, 0, 0);   \
        o[d0] = __builtin_amdgcn_mfma_f32_32x32x16_bf16(pa1, (bf16x8){l1[0], l1[1], l1[2], l1[3], h1[0], h1[1], h1[2], h1[3]}, o[d0], 0, 0, 0);   \
        o[d0] = __builtin_amdgcn_mfma_f32_32x32x16_bf16(pa2, (bf16x8){l2[0], l2[1], l2[2], l2[3], h2[0], h2[1], h2[2], h2[3]}, o[d0], 0, 0, 0);   \
        o[d0] = __builtin_amdgcn_mfma_f32_32x32x16_bf16(pa3, (bf16x8){l3[0], l3[1], l3[2], l3[3], h3[0], h3[1], h3[2], h3[3]}, o[d0], 0, 0, 0); } while (0)
    PV_D0(0); PV_D0(1); PV_D0(2); PV_D0(3);
#undef PV_D0
#undef TRRD
}
__device__ __forceinline__ void attn_block(const unsigned short* Q, const unsigned short* K, const unsigned short* V, unsigned short* O, int opitch, int qb, LAS unsigned char* lds) {
    int tid_ = threadIdx.x; asm volatile("" : "+v"(tid_));
    const int tid = tid_, wid = __builtin_amdgcn_readfirstlane(tid >> 6), lane = tid & 63, r32 = lane & 31, hi = lane >> 5;
    const int P0 = qb * QB, NT = (P0 + QB) / KVBLK;
    const int qlo = P0 + wid * QBLK, qpos = qlo + r32;
    LAS float* wsf = (LAS float*)(lds + LDS_WS) + wid * 64; LAS float* li_l = wsf; LAS float* al_l = wsf + 32;
    int voff[2], koff[3];
#pragma unroll
    for (int i = 0; i < 2; ++i) { const int P = (wid * 2 + i) * 1024 + lane * 16, sub = P >> 9, within = P & 511, kk = (sub >> 2) * 8 + (within >> 6);
        const int k = (kk & ~0xC) | ((kk & 4) << 1) | ((kk & 8) >> 1), c = (sub & 3) * 32 + ((within & 63) >> 1); voff[i] = k * DVV + c; }
#pragma unroll
    for (int i = 0; i < 3; ++i) { const int P = (wid * 3 + i) * 1024 + lane * 16, sblk = P >> 13, rem = P & 8191, row = rem >> 7, cc = ((rem & 127) >> 4) ^ ((row >> 1) & 7); koff[i] = row * DQ + sblk * 64 + cc * 8; }
    bf16x8 qr[12];
#pragma unroll
    for (int d0 = 0; d0 < 12; ++d0) qr[d0] = *(const bf16x8*)(Q + (size_t)(P0 + wid * QBLK + r32) * DQ + d0 * 16 + hi * 8);
#define SDMA(kb0, kbuf, vbuf) do { \
        _Pragma("unroll") for (int i = 0; i < 2; ++i) __builtin_amdgcn_global_load_lds((const unsigned*)(V + (size_t)(kb0) * DVV + voff[i]), (LAS unsigned*)(lds + LDS_V + (vbuf) * SHM_V + (wid * 2 + i) * 1024), 16, 0, 0); \
        _Pragma("unroll") for (int i = 0; i < 3; ++i) __builtin_amdgcn_global_load_lds((const unsigned*)(K + (size_t)(kb0) * DQ + koff[i]), (LAS unsigned*)(lds + LDS_K + (kbuf) * SHM_K + (wid * 3 + i) * 1024), 16, 0, 0); } while (0)
    __syncthreads();
    SDMA(0, 0, 0);
    asm volatile("s_waitcnt vmcnt(0)" ::: "memory"); __syncthreads();
    float m_reg = -1e30f, l_reg = 0.f; f32x16 o[4] = {};
    const int vbase = (int)(uintptr_t)(lds + LDS_V) + v_rd_base(lane);
    const bool late = wid >= 4;
    f32x16 p0, p1; float bs = 0.f; bool pend = false; int pt = 0;
#define SMPV() do { float alpha; bf16x8 pa0, pa1, pa2, pa3; \
        partialSM(p0, p1, m_reg, bs, alpha); finishSM(p0, p1, alpha, l_reg, pa0, pa1, pa2, pa3); \
        if (__any(alpha < 1.f)) { if (hi == 0) al_l[r32] = alpha; asm volatile("s_waitcnt lgkmcnt(0)" ::: "memory"); \
            _Pragma("unroll") for (int d_ = 0; d_ < 4; ++d_) _Pragma("unroll") for (int r = 0; r < 16; ++r) o[d_][r] *= al_l[crow(r, hi)]; } \
        pv_tile(o, vbase + (pt % 3) * SHM_V, pa0, pa1, pa2, pa3); pend = false; } while (0)
    for (int t = 0; t <= NT; ++t) {
        if (t + 1 < NT) SDMA((t + 1) * KVBLK, (t & 1) ^ 1, (t + 1) % 3);
        if (late && pend) SMPV();
        if (t < NT && t * KVBLK <= qlo + QBLK - 1) {
            bs = m_reg > -1e29f ? m_reg : 0.f;
            qkt(p0, p1, lds, LDS_K + (t & 1) * SHM_K, r32, hi, qr, -bs);
            if (t * KVBLK + KVBLK - 1 > qlo) mask_tile(p0, p1, qpos - t * KVBLK - 4 * hi);
            pend = true; pt = t; }
        if (!late && pend) SMPV();
        asm volatile("s_waitcnt vmcnt(0)" ::: "memory"); __syncthreads();
    }
#undef SMPV
    if (hi == 0) li_l[r32] = l_reg; asm volatile("s_waitcnt lgkmcnt(0)" ::: "memory");
    unsigned short* Ow = O + (size_t)(P0 + wid * QBLK) * opitch;
#pragma unroll
    for (int r = 0; r < 16; ++r) { const int orow = crow(r, hi); const float rl = __builtin_amdgcn_rcpf(li_l[orow]);
#pragma unroll
        for (int d0 = 0; d0 < 4; ++d0) { const float v = o[d0][r] * rl; const float vn = __builtin_bit_cast(float, __builtin_amdgcn_ds_bpermute((lane ^ 1) << 2, __builtin_bit_cast(int, v)));
            if ((r32 & 1) == 0) *(unsigned*)(Ow + (size_t)orow * opitch + d0 * 32 + r32) = cvtpk(v, vn); } }
#undef SDMA
}
#undef SBAR
}
struct Args { const void* in[N_IN]; float* out; unsigned char* ws; int ph_lo, ph_hi; };
struct Frame {
    LAS unsigned char* lds; unsigned char* ldsg;
    int tid, lane, wave, G, bid;
    unsigned char* ws;
    const void* const* in;
};
constexpr int PTAB_OFF = CTRL_OFF + 1024;
__device__ __forceinline__ const void* ldp(const Frame& F, int i) {
    const unsigned long long v = ((const LAS unsigned long long*)(F.lds + PTAB_OFF))[i];
    const unsigned lo = __builtin_amdgcn_readfirstlane((unsigned)v), hi = __builtin_amdgcn_readfirstlane((unsigned)(v >> 32));
    return (const void*)(const GAS void*)(((unsigned long long)hi << 32) | lo); }
#define INF(i) ((const float*)ldp(F, i))
__device__ __forceinline__ bf16* wt(const Frame& F, int l, size_t off) { return (bf16*)(F.ws + WS_W + (size_t)l * WL_SIZE + off); }

__device__ __forceinline__ void tr_item(const float* W, int ldw, int K, int k0, int sc, const float* kscale, bf16* dst  , LAS float* scr, int lane) {
    float v[64];
    const float* src = W + (size_t)k0 * ldw + (sc >= 0 ? sc : 0);
#pragma unroll
    for (int i = 0; i < 64; ++i) v[i] = sc >= 0 ? src[(size_t)i * ldw] : 0.f;
#pragma unroll
    for (int i = 0; i < 64; ++i) scr[i * 65 + lane] = v[i];
    LDS_WAIT(); asm volatile("" ::: "memory");
    const int c = lane & 7;
    f32x4 ks0 = (f32x4){1.f, 1.f, 1.f, 1.f}, ks1 = ks0;
    if (kscale) { ks0 = *(const f32x4*)(kscale + k0 + 8 * c); ks1 = *(const f32x4*)(kscale + k0 + 8 * c + 4); }
#pragma unroll
    for (int j = 0; j < 8; ++j) { const int n = (lane >> 3) + 8 * j; const LAS float* s = scr + (8 * c) * 65 + n;
        v4u o; o.x = pk2(s[0 * 65] * ks0.x, s[1 * 65] * ks0.y); o.y = pk2(s[2 * 65] * ks0.z, s[3 * 65] * ks0.w); o.z = pk2(s[4 * 65] * ks1.x, s[5 * 65] * ks1.y); o.w = pk2(s[6 * 65] * ks1.z, s[7 * 65] * ks1.w);
        *(v4u*)(dst + (size_t)n * K + k0 + 8 * c) = o; }
    LDS_WAIT(); asm volatile("" ::: "memory");
}
__device__ __forceinline__ int uq_srccol(int n) {
    if (n < 1024) return (n >> 7) * 192 + (n & 127);
    const int r = n - 1024, h = r >> 6, pos = r & 63, i = pos >> 3, e = pos & 7, f = 4 * i + (e & 3);
    return h * 192 + 128 + (e < 4 ? f : 32 + f);
}
__device__ __forceinline__ int win_srccol(int n) {
    if (n < 1280) return n;
    if (n < 3328) return n + 64;
    if (n < 3392) { const int pos = n - 3328, i = pos >> 3, e = pos & 7, f = 4 * i + (e & 3); return 1280 + (e < 4 ? f : 32 + f); }
    return -1;
}

namespace mx {
typedef short bf16x8 __attribute__((ext_vector_type(8)));
typedef float f32x16 __attribute__((ext_vector_type(16)));
__device__ __forceinline__ int crow(int r, int hi) { return (r & 3) + 8 * (r >> 2) + 4 * hi; }
__device__ __forceinline__ unsigned cvtpk(float lo, float hi) { typedef float f2_ __attribute__((ext_vector_type(2))); typedef __bf16 b2_ __attribute__((ext_vector_type(2))); const b2_ r = __builtin_convertvector((f2_){lo, hi}, b2_); return __builtin_bit_cast(unsigned, r); }
__device__ __forceinline__ bf16x8 pack8g(const float* p) { const f32x4 a = *(const f32x4*)p, b = *(const f32x4*)(p + 4); v4u w = {cvtpk(a.x, a.y), cvtpk(a.z, a.w), cvtpk(b.x, b.y), cvtpk(b.z, b.w)}; return *reinterpret_cast<bf16x8*>(&w); }
__device__ __forceinline__ bf16x8 pack8f(const float* v) { v4u w = {cvtpk(v[0], v[1]), cvtpk(v[2], v[3]), cvtpk(v[4], v[5]), cvtpk(v[6], v[7])}; return *reinterpret_cast<bf16x8*>(&w); }
#define MX_MFMA(a, b, c) __builtin_amdgcn_mfma_f32_32x32x16_bf16(a, b, c, 0, 0, 0)
__device__ __forceinline__ void acc_to_A(const f32x16& p, bf16x8& lo, bf16x8& hi) {
#define PK4(P, B_, OUT) do { unsigned a0 = cvtpk(P[B_+0], P[B_+1]), a1 = cvtpk(P[B_+2], P[B_+3]);                          \
        unsigned b0 = cvtpk(P[B_+4], P[B_+5]), b1 = cvtpk(P[B_+6], P[B_+7]);                                             \
        auto r0 = __builtin_amdgcn_permlane32_swap(a0, b0, false, false); auto r1 = __builtin_amdgcn_permlane32_swap(a1, b1, false, false); \
        v4u w = {r0[0], r1[0], r0[1], r1[1]}; OUT = *reinterpret_cast<bf16x8*>(&w); } while (0)
    PK4(p, 0, lo); PK4(p, 8, hi);
#undef PK4
}
}

constexpr size_t S5T_WIN = 0, S5T_KT = S5T_WIN + 128 * 1024 * 2, S5T_WOUT = S5T_KT + 65 * 256 * 2, S5T_L64 = S5T_WOUT + 1024 * 128 * 2, S5T_PW = S5T_L64 + 512, S5T_SIZE = S5T_PW + 65 * 64 * 8 + 256;
static_assert(S5T_SIZE % 16 == 0, "table alignment");
__device__ __forceinline__ void s5_tables_a(Frame& F) {
    const int gt = F.bid * NTHR + F.tid, NGT = F.G * NTHR;
    for (int i = gt; i < NL * 32 * 65 * 64; i += NGT) {
        const int p = i & 63, j = (i >> 6) % 65, lg = i / (65 * 64);
        const float lre = INF(I_LRE)[lg * 64 + p], lim = INF(I_LIM)[lg * 64 + p];
        const float dt = expf(INF(I_LDT)[lg]);
        const float er = expf(lre * dt * (float)j); float sn, cs; sincosf(lim * dt * (float)j, &sn, &cs);
        ((float2*)(F.ws + WS_PW))[i] = make_float2(er * cs, er * sn);
    }
    for (int i = gt; i < NL * 32 * 64 * 16; i += NGT) {
        const int lgp = i >> 4, lg = i >> 10;
        const float lre = INF(I_LRE)[lgp], lim = INF(I_LIM)[lgp];
        const float dt = expf(INF(I_LDT)[lg]);
        const float er = expf(lre * dt); float sn, cs; sincosf(lim * dt, &sn, &cs);
        const float nr = er * cs - 1.f, ni = er * sn, den = lre * lre + lim * lim;
        const float cr = (nr * lre + ni * lim) / den, ci = (ni * lre - nr * lim) / den;
        const float xr = INF(I_BRE)[i], xi = INF(I_BIM)[i];
        ((float2*)(F.ws + WS_BBAR))[i] = make_float2(cr * xr - ci * xi, cr * xi + ci * xr);
    }
}
__device__ __forceinline__ void s5_tables_b(Frame& F, int l, int gt, int NGT) {
    const float2* pwl = (const float2*)(F.ws + WS_PW) + (size_t)l * 32 * 65 * 64;
    const float2* bbl = (const float2*)(F.ws + WS_BBAR) + (size_t)l * 32 * 64 * 16;
    const float* crl = INF(I_CRE) + (size_t)l * 32 * 16 * 64; const float* cil = INF(I_CIM) + (size_t)l * 32 * 16 * 64;
    for (int i = gt; i < 32 * 128 * 128; i += NGT) {
        const int k0 = (i & 127) * 8, n = (i >> 7) & 127, g = i >> 14;
        const int p = n & 63, ri = n >> 6, s = k0 >> 4, c0 = k0 & 15;
        const float2 w = pwl[(g * 65 + 63 - s) * 64 + p]; const f32x4* bp = (const f32x4*)(bbl + (g * 64 + p) * 16 + c0); float o[8];
#pragma unroll
        for (int q = 0; q < 4; ++q) { const f32x4 b2 = bp[q];
            o[2 * q] = ri ? (w.x * b2.y + w.y * b2.x) : (w.x * b2.x - w.y * b2.y); o[2 * q + 1] = ri ? (w.x * b2.w + w.y * b2.z) : (w.x * b2.z - w.y * b2.w); }
        *(v4u*)((bf16*)(F.ws + WS_S5T + (size_t)(l * 32 + g) * S5T_SIZE + S5T_WIN) + n * 1024 + k0) = (v4u){pk2(o[0], o[1]), pk2(o[2], o[3]), pk2(o[4], o[5]), pk2(o[6], o[7])};
    }
    for (int i = gt; i < 32 * 1024 * 16; i += NGT) {
        const int k0 = (i & 15) * 8, n = (i >> 4) & 1023, g = i >> 14;
        const int p0 = k0 & 63, ri = k0 >> 6, t = n >> 4, c = n & 15;
        const f32x4* wp = (const f32x4*)(pwl + (g * 65 + t + 1) * 64 + p0); const f32x4* crp = (const f32x4*)(crl + (g * 16 + c) * 64 + p0); const f32x4* cip = (const f32x4*)(cil + (g * 16 + c) * 64 + p0);
        const f32x4 cr0 = crp[0], cr1 = crp[1], ci0 = cip[0], ci1 = cip[1]; const float cr[8] = {cr0[0], cr0[1], cr0[2], cr0[3], cr1[0], cr1[1], cr1[2], cr1[3]}, ci[8] = {ci0[0], ci0[1], ci0[2], ci0[3], ci1[0], ci1[1], ci1[2], ci1[3]};
        float o[8];
#pragma unroll
        for (int q = 0; q < 4; ++q) { const f32x4 w2 = wp[q];
            o[2 * q] = ri ? -(cr[2 * q] * w2.y + ci[2 * q] * w2.x) : (cr[2 * q] * w2.x - ci[2 * q] * w2.y);
            o[2 * q + 1] = ri ? -(cr[2 * q + 1] * w2.w + ci[2 * q + 1] * w2.z) : (cr[2 * q + 1] * w2.z - ci[2 * q + 1] * w2.w); }
        *(v4u*)((bf16*)(F.ws + WS_S5T + (size_t)(l * 32 + g) * S5T_SIZE + S5T_WOUT) + n * 128 + k0) = (v4u){pk2(o[0], o[1]), pk2(o[2], o[3]), pk2(o[4], o[5]), pk2(o[6], o[7])};
    }
    for (int i = gt; i < 32 * 64; i += NGT) { const int p = i & 63, g = i >> 6; const float2 w = pwl[(g * 65 + 64) * 64 + p];
        float* l64 = (float*)(F.ws + WS_S5T + (size_t)(l * 32 + g) * S5T_SIZE + S5T_L64); l64[p] = w.x; l64[64 + p] = w.y; }
    for (int i = gt; i < 32 * 65 * 16; i += NGT) {
        const int cc0 = (i & 3) * 4, c0 = ((i >> 2) & 3) * 4, li = (i >> 4) % 65, g = i / (65 * 16);
        float acc[4][4];
#pragma unroll
        for (int a = 0; a < 4; ++a)
#pragma unroll
            for (int b = 0; b < 4; ++b) acc[a][b] = 0.f;
        if (li > 0) {
            for (int p = 0; p < 64; ++p) {
                const float2 w = pwl[(g * 65 + li - 1) * 64 + p];
                float2 bv[4]; float cr[4], ci[4];
#pragma unroll
                for (int b = 0; b < 4; ++b) bv[b] = bbl[(g * 64 + p) * 16 + cc0 + b];
#pragma unroll
                for (int a = 0; a < 4; ++a) { cr[a] = crl[(g * 16 + c0 + a) * 64 + p]; ci[a] = cil[(g * 16 + c0 + a) * 64 + p]; }
#pragma unroll
                for (int a = 0; a < 4; ++a) { const float er = cr[a] * w.x - ci[a] * w.y, ei = cr[a] * w.y + ci[a] * w.x;
#pragma unroll
                    for (int b = 0; b < 4; ++b) acc[a][b] += er * bv[b].x - ei * bv[b].y; }
            }
        }
        bf16* kt = (bf16*)(F.ws + WS_S5T + (size_t)(l * 32 + g) * S5T_SIZE + S5T_KT) + li * 256;
#pragma unroll
        for (int a = 0; a < 4; ++a) *(v2u*)(kt + (c0 + a) * 16 + cc0) = (v2u){pk2(acc[a][0], acc[a][1]), pk2(acc[a][2], acc[a][3])};
    }
}
__device__ __forceinline__ void s5_step1_item(Frame& F, int l, int g, int rb, const bf16* u16, float* dS) {
    const int lane = F.lane, w = F.wave, c32 = lane & 31, hi = lane >> 5, cb = w & 3, kh = w >> 2;
    const int R = rb * 32 + c32, b = R >> 6, n = R & 63;
    const bf16* arow = u16 + ((size_t)b * SEQ + n * 64) * 512 + g * 16 + 8 * hi;
    const bf16* brow = (const bf16*)(F.ws + WS_S5T + (size_t)(l * 32 + g) * S5T_SIZE + S5T_WIN) + (size_t)(cb * 32 + c32) * 1024 + 8 * hi;
    mx::f32x16 acc = {};
#pragma unroll 8
    for (int s = kh * 32; s < kh * 32 + 32; ++s) {
        const mx::bf16x8 a = *(const mx::bf16x8*)(arow + (size_t)s * 512), bb = *(const mx::bf16x8*)(brow + s * 16);
        acc = MX_MFMA(a, bb, acc);
    }
    LAS float* red = (LAS float*)F.lds;
    __syncthreads();
    if (kh == 1) {
#pragma unroll
        for (int r = 0; r < 16; ++r) red[(cb * 16 + r) * 64 + lane] = acc[r]; }
    __syncthreads();
    if (kh == 0) {
#pragma unroll
        for (int r = 0; r < 16; ++r) { const float v = acc[r] + red[(cb * 16 + r) * 64 + lane];
            dS[((size_t)g * 256 + rb * 32 + mx::crow(r, hi)) * 128 + cb * 32 + c32] = v; } }
}
__device__ __forceinline__ void s5_step3_item(Frame& F, int l, int g, int rb, const bf16* u16, const float* dS, bf16* yg16) {
    const int lane = F.lane, w = F.wave, c32 = lane & 31, hi = lane >> 5;
    LAS unsigned char* Ul = F.lds;
    LAS unsigned char* Kl = F.lds + 32 * 2064;
    __syncthreads();
    for (int i = F.tid; i < 32 * 128; i += NTHR) {
        const int ch = i & 1, s = (i >> 1) & 63, r = i >> 7; const int R = rb * 32 + r, b = R >> 6, n = R & 63;
        *(LAS v4u*)(Ul + r * 2064 + s * 32 + ch * 16) = *(const v4u*)(u16 + ((size_t)b * SEQ + n * 64 + s) * 512 + g * 16 + ch * 8); }
    { const v4u* kt = (const v4u*)(F.ws + WS_S5T + (size_t)(l * 32 + g) * S5T_SIZE + S5T_KT);
      for (int i = F.tid; i < 65 * 32; i += NTHR) *(LAS v4u*)(Kl + i * 16) = kt[i]; }
    LAS unsigned char* Hl = Kl + 65 * 512;
    if (F.tid < 64) {
        const int p = F.tid, bq = rb >> 1, n0 = (rb & 1) * 32;
        const float* l64 = (const float*)(F.ws + WS_S5T + (size_t)(l * 32 + g) * S5T_SIZE + S5T_L64);
        const float lr = l64[p], li = l64[64 + p];
        const float* dp = dS + ((size_t)g * 256 + bq * 64) * 128 + p;
        float hr = 0.f, hi2 = 0.f;
        for (int nb = 0; nb < n0 + 32; nb += 16) {
            float dr[16], di[16];
#pragma unroll
            for (int j = 0; j < 16; ++j) { dr[j] = dp[(size_t)(nb + j) * 128]; di[j] = dp[(size_t)(nb + j) * 128 + 64]; }
#pragma unroll
            for (int j = 0; j < 16; ++j) { const int n = nb + j;
                if (n >= n0) { *(LAS bf16*)(Hl + (n - n0) * 272 + p * 2) = (bf16)f2bf(hr); *(LAS bf16*)(Hl + (n - n0) * 272 + 128 + p * 2) = (bf16)f2bf(hi2); }
                const float nr = lr * hr - li * hi2 + dr[j], ni = lr * hi2 + li * hr + di[j]; hr = nr; hi2 = ni; }
        }
    }
    __syncthreads();
    const bf16* wo = (const bf16*)(F.ws + WS_S5T + (size_t)(l * 32 + g) * S5T_SIZE + S5T_WOUT);
    mx::bf16x8 hf[8];
#pragma unroll
    for (int ks = 0; ks < 8; ++ks) hf[ks] = *(const LAS mx::bf16x8*)(Hl + c32 * 272 + ks * 32 + hi * 16);
    const float* Dv = INF(I_S5D) + l * 512 + g * 16;
#pragma unroll 1
    for (int jj = 0; jj < 4; ++jj) {
        const int j = (jj == 0) ? w : (jj == 1) ? 15 - w : (jj == 2) ? 16 + w : 31 - w;
        const int tcol = 2 * j + (c32 >> 4), ccol = c32 & 15;
        mx::f32x16 acc = {};
#pragma unroll
        for (int ks = 0; ks < 8; ++ks) { const mx::bf16x8 bb = *(const mx::bf16x8*)(wo + (size_t)(j * 32 + c32) * 128 + ks * 16 + 8 * hi); acc = MX_MFMA(bb, hf[ks], acc); }
        const LAS unsigned char* ab = Ul + c32 * 2064 + hi * 16;
        const LAS unsigned char* kb = Kl + (tcol + 1) * 512 + ccol * 32 + hi * 16;
        { mx::bf16x8 a = *(const LAS mx::bf16x8*)ab, bb = *(const LAS mx::bf16x8*)kb;
          const int ns = 2 * j + 2;
          for (int s = 0; s < ns; ++s) {
              const int sn = s + 1 < ns ? s + 1 : s;
              const mx::bf16x8 an = *(const LAS mx::bf16x8*)(ab + sn * 32), bn = *(const LAS mx::bf16x8*)(kb - sn * 512);
              acc = MX_MFMA(bb, a, acc); a = an; bb = bn; } }
        { const int Rr = rb * 32 + c32, b = Rr >> 6, nch = Rr & 63; const size_t tok0 = (size_t)b * SEQ + nch * 64 + 2 * j;
#pragma unroll
          for (int tk = 0; tk < 2; ++tk) {
              const bf16* up = u16 + (tok0 + tk) * 512 + g * 16 + 4 * hi; const float* dp = Dv + 4 * hi;
              unsigned pkx[2], pky[2];
#pragma unroll
              for (int kk = 0; kk < 2; ++kk) { const int k = 2 * tk + kk; const v2u uw = *(const v2u*)(up + 8 * kk); const f32x4 dv4 = *(const f32x4*)(dp + 8 * kk);
                  const float u0 = bf2f((unsigned short)uw.x), u1 = bf2f((unsigned short)(uw.x >> 16)), u2 = bf2f((unsigned short)uw.y), u3 = bf2f((unsigned short)(uw.y >> 16));
                  pkx[kk] = mx::cvtpk(gelu_tanh(acc[4 * k] + dv4[0] * u0), gelu_tanh(acc[4 * k + 1] + dv4[1] * u1));
                  pky[kk] = mx::cvtpk(gelu_tanh(acc[4 * k + 2] + dv4[2] * u2), gelu_tanh(acc[4 * k + 3] + dv4[3] * u3)); }
              auto rx = __builtin_amdgcn_permlane32_swap(pkx[0], pkx[1], false, false); auto ry = __builtin_amdgcn_permlane32_swap(pky[0], pky[1], false, false);
              *(v4u*)(yg16 + (tok0 + tk) * 512 + g * 16 + 8 * hi) = (v4u){rx[0], ry[0], rx[1], ry[1]}; } }
    }
}

__device__ __forceinline__ void hg_gate_loads(int h, const float* logf, size_t row0, int k, int seg, float (&g)[16]) {
#pragma unroll
    for (int j = 0; j < 16; ++j) g[j] = logf[(row0 + seg * 16 + j) * 512 + h * 128 + k];
}
__device__ __forceinline__ void hg_gate_scan(Frame& F, int k, int seg, const float (&g)[16], float (&bcum)[16], float (&kk)[16], float& bmid, float& blast) {
    LAS float* tot = (LAS float*)(F.lds + 120 * 1024);
    float run = 0.f;
#pragma unroll
    for (int j = 0; j < 16; ++j) { kk[j] = 1.f - __expf(g[j]); run += g[j]; bcum[j] = run; }
    tot[seg * 128 + k] = run;
    __syncthreads();
    float pre = 0.f;
    for (int s2 = 0; s2 < seg; ++s2) pre += tot[s2 * 128 + k];
#pragma unroll
    for (int j = 0; j < 16; ++j) bcum[j] += pre;
    if (seg == 1) tot[512 + k] = bcum[15];
    if (seg == 3) tot[640 + k] = bcum[15];
    __syncthreads();
    bmid = tot[512 + k]; blast = tot[640 + k];
}
__device__ __forceinline__ void hg_step1_item(Frame& F, int chunk  , const float* logf, const bf16* hv, bf16* dST, float* blastg) {
    const int bh = chunk >> 6, n = chunk & 63, b = bh >> 2, h = bh & 3;
    const size_t row0 = (size_t)b * SEQ + n * 64;
    const int k = F.tid & 127, seg = F.tid >> 7;
    LAS unsigned char* klT = F.lds;
    LAS unsigned char* vT = F.lds + 128 * 144;
    __syncthreads();
    float g[16], bc[16], kk[16], bmid, blast; bf16 vraw[16];
    hg_gate_loads(h, logf, row0, k, seg, g);
#pragma unroll
    for (int j = 0; j < 16; ++j) vraw[j] = hv[(row0 + seg * 16 + j) * 512 + h * 128 + k];
    hg_gate_scan(F, k, seg, g, bc, kk, bmid, blast);
    float tmp[16];
#pragma unroll
    for (int j = 0; j < 16; ++j) tmp[j] = kk[j] * __expf(blast - bc[j]);
    *(LAS mx::bf16x8*)(klT + k * 144 + seg * 32) = mx::pack8f(tmp); *(LAS mx::bf16x8*)(klT + k * 144 + seg * 32 + 16) = mx::pack8f(tmp + 8);
#pragma unroll
    for (int j = 0; j < 16; ++j) *(LAS bf16*)(vT + k * 144 + (seg * 16 + j) * 2) = vraw[j];
    if (seg == 0) blastg[(size_t)chunk * 128 + k] = blast;
    __syncthreads();
    const int lane = F.lane, w = F.wave, c32 = lane & 31, hi = lane >> 5, vb = w & 3, kb2 = w >> 2;
    mx::f32x16 a0 = {}, a1 = {};
#pragma unroll
    for (int ks = 0; ks < 4; ++ks) {
        const mx::bf16x8 av = *(const LAS mx::bf16x8*)(vT + (vb * 32 + c32) * 144 + ks * 32 + hi * 16);
        const mx::bf16x8 b0 = *(const LAS mx::bf16x8*)(klT + (kb2 * 64 + c32) * 144 + ks * 32 + hi * 16);
        const mx::bf16x8 b1 = *(const LAS mx::bf16x8*)(klT + (kb2 * 64 + 32 + c32) * 144 + ks * 32 + hi * 16);
        a0 = MX_MFMA(b0, av, a0); a1 = MX_MFMA(b1, av, a1);
    }
    bf16* dst = dST + (size_t)chunk * 16384 + (size_t)(vb * 32 + c32) * 128 + kb2 * 64 + 8 * hi;
#pragma unroll
    for (int q = 0; q < 4; q += 2) {
        { const unsigned ax = mx::cvtpk(a0[4 * q], a0[4 * q + 1]), ay = mx::cvtpk(a0[4 * q + 2], a0[4 * q + 3]), bx = mx::cvtpk(a0[4 * q + 4], a0[4 * q + 5]), by = mx::cvtpk(a0[4 * q + 6], a0[4 * q + 7]);
          auto rx = __builtin_amdgcn_permlane32_swap(ax, bx, false, false); auto ry = __builtin_amdgcn_permlane32_swap(ay, by, false, false);
          *(v4u*)(dst + 8 * q) = (v4u){rx[0], ry[0], rx[1], ry[1]}; }
        { const unsigned ax = mx::cvtpk(a1[4 * q], a1[4 * q + 1]), ay = mx::cvtpk(a1[4 * q + 2], a1[4 * q + 3]), bx = mx::cvtpk(a1[4 * q + 4], a1[4 * q + 5]), by = mx::cvtpk(a1[4 * q + 6], a1[4 * q + 7]);
          auto rx = __builtin_amdgcn_permlane32_swap(ax, bx, false, false); auto ry = __builtin_amdgcn_permlane32_swap(ay, by, false, false);
          *(v4u*)(dst + 32 + 8 * q) = (v4u){rx[0], ry[0], rx[1], ry[1]}; }
    }
}
__device__ __forceinline__ void hg_step2(Frame& F, const bf16* dST, const float* blastg, bf16* SpT) {
    typedef float f32x2 __attribute__((ext_vector_type(2)));
    const int gt = F.bid * NTHR + F.tid, NGT = F.G * NTHR;
    for (int i = gt; i < 16 * 8192; i += NGT) {
        const int k2 = (i & 63) * 2, bh = i >> 13, vk = (i & 8191) * 2;
        f32x2 S = (f32x2){0.f, 0.f};
        unsigned dA[16], dB[16]; f32x2 blA[16], blB[16];
#define H2_LOAD(d, bl, n0) do { _Pragma("unroll") for (int j = 0; j < 16; ++j) { const size_t ch = (size_t)bh * 64 + (n0) + j; d[j] = *(const unsigned*)(dST + ch * 16384 + vk); bl[j] = *(const f32x2*)(blastg + ch * 128 + k2); } } while (0)
#define H2_PROC(d, bl, n0) do { _Pragma("unroll") for (int j = 0; j < 16; ++j) { const size_t ch = (size_t)bh * 64 + (n0) + j; \
            *(unsigned*)(SpT + ch * 16384 + vk) = pk2(S.x, S.y); \
            S.x = __expf(bl[j].x) * S.x + bf2f((unsigned short)d[j]); S.y = __expf(bl[j].y) * S.y + bf2f((unsigned short)(d[j] >> 16)); } } while (0)
        H2_LOAD(dA, blA, 0); H2_LOAD(dB, blB, 16);
        H2_PROC(dA, blA, 0); H2_LOAD(dA, blA, 32);
        H2_PROC(dB, blB, 16); H2_LOAD(dB, blB, 48);
        H2_PROC(dA, blA, 32); H2_PROC(dB, blB, 48);
#undef H2_LOAD
#undef H2_PROC
    }
}
__device__ __forceinline__ void hg_step3_item(Frame& F, int l, int chunk, const float* logf, const bf16* hq, const bf16* hv, const bf16* hgt, const bf16* SpT, bf16* cat) {
    const int bh = chunk >> 6, n = chunk & 63, b = bh >> 2, h = bh & 3;
    const size_t row0 = (size_t)b * SEQ + n * 64;
    const int k = F.tid & 127, seg = F.tid >> 7;
    LAS unsigned char* qm = F.lds;
    LAS unsigned char* km = qm + 64 * 272;
    LAS unsigned char* vT = km + 64 * 272;
    LAS unsigned char* sp = vT + 128 * 144;
    LAS float* ot = (LAS float*)(sp + 128 * 272);
    LAS float* tot = (LAS float*)(F.lds + 120 * 1024);
    __syncthreads();
    float g[16], bc[16], kk[16], bmid, blast; bf16 qraw[16], vraw[16]; v4u spraw[4];
    hg_gate_loads(h, logf, row0, k, seg, g);
#pragma unroll
    for (int j = 0; j < 16; ++j) { qraw[j] = hq[(row0 + seg * 16 + j) * 512 + h * 128 + k]; vraw[j] = hv[(row0 + seg * 16 + j) * 512 + h * 128 + k]; }
    { const bf16* src = SpT + (size_t)chunk * 16384 + (F.tid >> 2) * 128 + (F.tid & 3) * 32;
#pragma unroll
      for (int q4 = 0; q4 < 4; ++q4) spraw[q4] = *(const v4u*)(src + q4 * 8); }
    hg_gate_scan(F, k, seg, g, bc, kk, bmid, blast);
#pragma unroll
    for (int j = 0; j < 16; ++j) { const int t = seg * 16 + j; const float qv = bf2f(qraw[j]);
        *(LAS bf16*)(qm + t * 272 + k * 2) = (bf16)f2bf(qv * __expf(bc[j] - bmid));
        *(LAS bf16*)(km + t * 272 + k * 2) = (bf16)f2bf(kk[j] * __expf(bmid - bc[j])); }
#pragma unroll
    for (int j = 0; j < 16; ++j) *(LAS bf16*)(vT + k * 144 + (seg * 16 + j) * 2) = vraw[j];
    {
      const int v = F.tid >> 2, k0 = (F.tid & 3) * 32;
#pragma unroll
      for (int q4 = 0; q4 < 4; ++q4) { const v4u raw = spraw[q4]; const unsigned rw[4] = {raw.x, raw.y, raw.z, raw.w}; float tmp[8];
#pragma unroll
          for (int e = 0; e < 8; ++e) tmp[e] = bf2f((unsigned short)(rw[e >> 1] >> ((e & 1) * 16))) * __expf(tot[512 + k0 + q4 * 8 + e]);
          *(LAS mx::bf16x8*)(sp + v * 272 + (k0 + q4 * 8) * 2) = mx::pack8f(tmp); } }
    __syncthreads();
    const int lane = F.lane, w = F.wave, c32 = lane & 31, hi = lane >> 5, tb = w & 1, vb = w >> 1;
    mx::f32x16 o = {};
#pragma unroll
    for (int ks = 0; ks < 8; ++ks) {
        const mx::bf16x8 a = *(const LAS mx::bf16x8*)(qm + (tb * 32 + c32) * 272 + ks * 32 + hi * 16);
        const mx::bf16x8 bb = *(const LAS mx::bf16x8*)(sp + (vb * 32 + c32) * 272 + ks * 32 + hi * 16);
        o = MX_MFMA(a, bb, o);
    }
    for (int sb = 0; sb <= tb; ++sb) {
        mx::f32x16 p = {};
#pragma unroll
        for (int ks = 0; ks < 8; ++ks) {
            const mx::bf16x8 a = *(const LAS mx::bf16x8*)(km + (sb * 32 + c32) * 272 + ks * 32 + hi * 16);
            const mx::bf16x8 bb = *(const LAS mx::bf16x8*)(qm + (tb * 32 + c32) * 272 + ks * 32 + hi * 16);
            p = MX_MFMA(a, bb, p);
        }
        if (sb == tb) {
#pragma unroll
            for (int r = 0; r < 16; ++r) if (mx::crow(r, hi) > c32) p[r] = 0.f; }
        mx::bf16x8 plo, phi; mx::acc_to_A(p, plo, phi);
        const mx::bf16x8 v0 = *(const LAS mx::bf16x8*)(vT + (vb * 32 + c32) * 144 + sb * 64 + hi * 16);
        const mx::bf16x8 v1 = *(const LAS mx::bf16x8*)(vT + (vb * 32 + c32) * 144 + sb * 64 + 32 + hi * 16);
        o = MX_MFMA(plo, v0, o); o = MX_MFMA(phi, v1, o);
    }
#pragma unroll
    for (int r = 0; r < 16; ++r) ot[(tb * 32 + mx::crow(r, hi)) * 132 + vb * 32 + c32] = o[r];
    __syncthreads();
    { const int t = F.tid >> 3, cg = F.tid & 7; float vals[16]; float ss = 0.f;
#pragma unroll
      for (int e = 0; e < 16; ++e) { vals[e] = ot[t * 132 + cg * 16 + e]; ss += vals[e] * vals[e]; }
      ss += shx(ss, 1, F.lane); ss += shx(ss, 2, F.lane); ss += shx(ss, 4, F.lane);
      const float r = 1.f / sqrtf(ss * (1.f / 128.f) + EPS);
      const bf16* gp = hgt + (row0 + t) * 512 + h * 128 + cg * 16; const float* gn = INF(I_HGN) + l * 128 + cg * 16;
      const v4u gw0 = *(const v4u*)gp, gw1 = *(const v4u*)(gp + 8); const unsigned gw[8] = {gw0.x, gw0.y, gw0.z, gw0.w, gw1.x, gw1.y, gw1.z, gw1.w};
#pragma unroll
      for (int e = 0; e < 16; ++e) vals[e] = vals[e] * r * gn[e] * bf2f((unsigned short)(gw[e >> 1] >> ((e & 1) * 16)));
      bf16* op = cat + (row0 + t) * DM + 1536 + h * 128 + cg * 16;
      *(mx::bf16x8*)op = mx::pack8f(vals); *(mx::bf16x8*)(op + 8) = mx::pack8f(vals + 8); }
}

__device__ __forceinline__ void phase_pre0(Frame& F) {
    LAS float* scr = (LAS float*)(F.lds + F.wave * 16640);
    const int gw = F.bid * NWAVES + F.wave, NGW = F.G * NWAVES;
    constexpr int IT_IN = 32 * (DINP / 64), IT_UQ = 8 * 24, IT_UKV = 4 * 32, IT_GLU = 8 * 8, IT_OUT = 32 * 32, IT_UP = 32 * (DFF2 / 64), IT_DN = (DFF / 64) * 32;
    constexpr int IT_L = IT_IN + IT_UQ + IT_UKV + IT_GLU + IT_OUT + IT_UP + IT_DN;
    for (int it = gw; it < NL * IT_L; it += NGW) {
        const int l = it / IT_L; int r = it % IT_L; const int ln = F.lane;
        if (r < IT_IN) { const int nb = r % (DINP / 64), kb = r / (DINP / 64); tr_item(INF(I_WIN) + (size_t)l * DM * DIN, DIN, DM, kb * 64, win_srccol(nb * 64 + ln), nullptr, wt(F, l, WL_IN) + (size_t)nb * 64 * DM, scr, ln); continue; } r -= IT_IN;
        if (r < IT_UQ) { const int nb = r % 24, kb = r / 24; tr_item(INF(I_WUQ) + (size_t)l * 512 * 1536, 1536, 512, kb * 64, uq_srccol(nb * 64 + ln), INF(I_QN) + l * 512, wt(F, l, WL_UQ) + (size_t)nb * 64 * 512, scr, ln); continue; } r -= IT_UQ;
        if (r < IT_UKV) { const int nb = r % 32, kb = r / 32; tr_item(INF(I_WUKV) + (size_t)l * 256 * 2048, 2048, 256, kb * 64, nb * 64 + ln, INF(I_KVN) + l * 256, wt(F, l, WL_UKV) + (size_t)nb * 64 * 256, scr, ln); continue; } r -= IT_UKV;
        if (r < IT_GLU) { const int nb = r % 8, kb = r / 8; tr_item(INF(I_WGLU) + (size_t)l * 512 * 512, 512, 512, kb * 64, nb * 64 + ln, nullptr, wt(F, l, WL_GLU) + (size_t)nb * 64 * 512, scr, ln); continue; } r -= IT_GLU;
        if (r < IT_OUT) { const int nb = r % 32, kb = r / 32; tr_item(INF(I_WOUT) + (size_t)l * DM * DM, DM, DM, kb * 64, nb * 64 + ln, nullptr, wt(F, l, WL_OUT) + (size_t)nb * 64 * DM, scr, ln); continue; } r -= IT_OUT;
        if (r < IT_UP) { const int nb = r % (DFF2 / 64), kb = r / (DFF2 / 64);
            tr_item(INF(I_WUP) + (size_t)l * DM * DFF2, DFF2, DM, kb * 64, ((nb & 3) < 2 ? (nb >> 2) * 128 + (nb & 3) * 64 : DFF + (nb >> 2) * 128 + ((nb & 3) - 2) * 64) + ln, nullptr, wt(F, l, WL_UP) + (size_t)nb * 64 * DM, scr, ln); continue; } r -= IT_UP;
        { const int nb = r % 32, kb = r / 32; tr_item(INF(I_WDN) + (size_t)l * DFF * DM, DM, DFF, kb * 64, nb * 64 + ln, nullptr, wt(F, l, WL_DN) + (size_t)nb * 64 * DFF, scr, ln); }
    }
    const float* c = INF(I_C);
    for (int it = gw; it < NL * 16 * 48; it += NGW) {
        const int jc = it % 48, kc = (it / 48) % 16, l = it / (48 * 16);
        const int j = jc * 256 + F.lane * 4;
        const float* w = INF(I_WADA) + ((size_t)l * DM + kc * 128) * 12288 + j;
#pragma unroll
        for (int q = 0; q < 8; ++q) { const int idx = q * 64 + F.lane, b = idx >> 7, k = idx & 127; const float cv = c[b * DM + kc * 128 + k]; scr[idx] = cv / (1.f + __expf(-cv)); }
        LDS_WAIT(); asm volatile("" ::: "memory");
        f32x4 acc[NB];
#pragma unroll
        for (int b = 0; b < NB; ++b) acc[b] = (f32x4){0.f, 0.f, 0.f, 0.f};
#pragma unroll 16
        for (int k = 0; k < 128; ++k) {
            const f32x4 wv = *(const f32x4*)(w + (size_t)k * 12288);
#pragma unroll
            for (int b = 0; b < NB; ++b) acc[b] += wv * scr[b * 128 + k];
        }
        float* mp = (float*)(F.ws + WS_MODP);
#pragma unroll
        for (int b = 0; b < NB; ++b) *(f32x4*)(mp + (((size_t)l * 16 + kc) * NB + b) * 12288 + j) = acc[b];
        LDS_WAIT(); asm volatile("" ::: "memory");
    }
    const int gt = F.bid * NTHR + F.tid, NGT = F.G * NTHR;
    const int* pos = (const int*)ldp(F, I_POS);
    for (int i = gt; i < M * 32; i += NGT) {
        const int tok = i >> 5, fi = i & 31;
        const float inv = exp2f(-(float)fi * 0.41524101186092033f);
        const float ang = (float)pos[tok] * inv; float sn, cs; sincosf(ang, &sn, &cs);
        ((float*)(F.ws + WS_COS))[i] = cs; ((float*)(F.ws + WS_SIN))[i] = sn;
    }
    s5_tables_a(F);
    for (int j = gt; j < 512; j += NGT) {
        float lg[NL], mx = -1e30f;
#pragma unroll
        for (int l = 0; l < NL; ++l) { lg[l] = INF(I_LB)[l * 512 + j]; mx = fmaxf(mx, lg[l]); }
        float s = 0.f;
#pragma unroll
        for (int l = 0; l < NL; ++l) { lg[l] = expf(lg[l] - mx); s += lg[l]; }
        float cum = 0.f;
#pragma unroll
        for (int l = 0; l < NL; ++l) { if (l > 0) cum += lg[l] / s; ((float*)(F.ws + WS_LB))[l * 512 + j] = cum; }
    }
}
__device__ __forceinline__ void phase_pre1(Frame& F) {
    const int gt = F.bid * NTHR + F.tid, NGT = F.G * NTHR;
    const float* mp = (const float*)(F.ws + WS_MODP); float* mod = (float*)(F.ws + WS_MOD);
    for (int i = gt; i < NL * NB * 12288; i += NGT) {
        const int j = i % 12288, b = (i / 12288) % NB, l = i / (12288 * NB);
        float s = INF(I_BADA)[l * 12288 + j];
        for (int kc = 0; kc < 16; ++kc) s += mp[(((size_t)l * 16 + kc) * NB + b) * 12288 + j];
        mod[i] = s;
    }
}
__device__ __forceinline__ float bflo(unsigned u) { return __builtin_bit_cast(float, u << 16); }
__device__ __forceinline__ float bfhi(unsigned u) { return __builtin_bit_cast(float, u & 0xffff0000u); }
__device__ __forceinline__ void phase_resnorm(Frame& F, const float* xin32, const bf16* xin16, const bf16* y, const float* gpost, const float* gate  ,
                                              bf16* xout16, float* xout32, const float* gpre, const float* sc, const float* sh, bf16* hout) {
    const int gw = F.bid * NWAVES + F.wave, NGW = F.G * NWAVES, RW = (M + NGW - 1) / NGW;
    int curb = -1; f32x4 pa[8], pg[8], ps[8];
    const int rend = (gw * RW + RW) < M ? (gw * RW + RW) : M;
    for (int row = gw * RW; row < rend; ++row) {
        const int b = row / SEQ;
        if (b != curb) { curb = b;
#pragma unroll
            for (int j = 0; j < 8; ++j) { const int ci = 128 * (j >> 1) + 2 * F.lane + (j & 1);
                if (y) pa[j] = ((const f32x4*)gpost)[ci] * ((const f32x4*)(gate + (size_t)b * 12288))[ci];
                if (hout) { pg[j] = ((const f32x4*)gpre)[ci] * (((const f32x4*)(sc + (size_t)b * 12288))[ci] + 1.f); ps[j] = ((const f32x4*)(sh + (size_t)b * 12288))[ci]; } } }
        f32x4 v[8];
        if (xin32) { const f32x4* xr = (const f32x4*)(xin32 + (size_t)row * DM) + 2 * F.lane;
#pragma unroll
            for (int j = 0; j < 4; ++j) { v[2 * j] = xr[128 * j]; v[2 * j + 1] = xr[128 * j + 1]; }
        } else { const v4u* xr = (const v4u*)(xin16 + (size_t)row * DM) + F.lane;
#pragma unroll
            for (int j = 0; j < 4; ++j) { const v4u w = xr[64 * j]; v[2 * j] = (f32x4){bflo(w.x), bfhi(w.x), bflo(w.y), bfhi(w.y)}; v[2 * j + 1] = (f32x4){bflo(w.z), bfhi(w.z), bflo(w.w), bfhi(w.w)}; }
        }
        if (y) {
            f32x4 yv[8]; float ss = 0.f;
            const v4u* yr = (const v4u*)(y + (size_t)row * DM) + F.lane;
#pragma unroll
            for (int j = 0; j < 4; ++j) { const v4u w = yr[64 * j]; yv[2 * j] = (f32x4){bflo(w.x), bfhi(w.x), bflo(w.y), bfhi(w.y)}; yv[2 * j + 1] = (f32x4){bflo(w.z), bfhi(w.z), bflo(w.w), bfhi(w.w)}; }
#pragma unroll
            for (int j = 0; j < 8; ++j) ss += (yv[j].x * yv[j].x + yv[j].y * yv[j].y) + (yv[j].z * yv[j].z + yv[j].w * yv[j].w);
            const float r = 1.f / sqrtf(wave_sum(ss, F.lane) * (1.f / DM) + EPS);
#pragma unroll
            for (int j = 0; j < 8; ++j) v[j] += pa[j] * (yv[j] * r);
            if (xout16) { v4u* xo = (v4u*)(xout16 + (size_t)row * DM) + F.lane;
#pragma unroll
                for (int j = 0; j < 4; ++j) xo[64 * j] = (v4u){pk2(v[2 * j].x, v[2 * j].y), pk2(v[2 * j].z, v[2 * j].w), pk2(v[2 * j + 1].x, v[2 * j + 1].y), pk2(v[2 * j + 1].z, v[2 * j + 1].w)};
            } else { f32x4* xo = (f32x4*)(xout32 + (size_t)row * DM) + 2 * F.lane;
#pragma unroll
                for (int j = 0; j < 4; ++j) { xo[128 * j] = v[2 * j]; xo[128 * j + 1] = v[2 * j + 1]; }
            }
        }
        if (hout) {
            float ss = 0.f;
#pragma unroll
            for (int j = 0; j < 8; ++j) ss += (v[j].x * v[j].x + v[j].y * v[j].y) + (v[j].z * v[j].z + v[j].w * v[j].w);
            const float r = 1.f / sqrtf(wave_sum(ss, F.lane) * (1.f / DM) + EPS);
            v4u* ho = (v4u*)(hout + (size_t)row * DM) + F.lane;
#pragma unroll
            for (int j = 0; j < 4; ++j) { const f32x4 h0 = v[2 * j] * r * pg[2 * j] + ps[2 * j], h1 = v[2 * j + 1] * r * pg[2 * j + 1] + ps[2 * j + 1];
                ho[64 * j] = (v4u){pk2(h0.x, h0.y), pk2(h0.z, h0.w), pk2(h1.x, h1.y), pk2(h1.z, h1.w)}; }
        }
    }
}

__device__ __forceinline__ void phase_mix1(Frame& F, int l) {
    for (int it = F.bid; it < 256; it += F.G) s5_step1_item(F, l, it >> 3, it & 7, (const bf16*)(F.ws + WS_U16), (float*)(F.ws + WS_DS5));
    for (int it = F.bid; it < 1024; it += F.G) hg_step1_item(F, it, (const float*)(F.ws + WS_LOGF), (const bf16*)(F.ws + WS_HV), (bf16*)(F.ws + WS_DST), (float*)(F.ws + WS_BLAST));
}
__device__ __forceinline__ void phase_s5out(Frame& F, int l) {
    for (int it = F.bid; it < 256; it += F.G) s5_step3_item(F, l, it >> 3, it & 7, (const bf16*)(F.ws + WS_U16), (const float*)(F.ws + WS_DS5), (bf16*)(F.ws + WS_YG16));
}
__device__ __forceinline__ void phase_hgout(Frame& F, int l) {
    for (int it = F.bid; it < 1024; it += F.G) hg_step3_item(F, l, it, (const float*)(F.ws + WS_LOGF), (const bf16*)(F.ws + WS_HQ), (const bf16*)(F.ws + WS_HV), (const bf16*)(F.ws + WS_HGT), (const bf16*)(F.ws + WS_SPT), (bf16*)(F.ws + WS_CAT));
}
__device__ __forceinline__ void phase_attn(Frame& F) {
    const bf16* qo = (const bf16*)(F.ws + WS_ACT); const bf16* ko = (const bf16*)(F.ws + WS_ACT + 48 * MiB); const bf16* vo = (const bf16*)(F.ws + WS_ACT + 96 * MiB);
    bf16* cat = (bf16*)(F.ws + WS_CAT);
    const int vcu = (F.G % 8 == 0) ? (F.bid % 8) * (F.G / 8) + F.bid / 8 : F.bid;
    for (int it = vcu; it < NB * NH * 8; it += F.G) {
        const int bh = it >> 3, x = it & 7, b = bh / NH, h = bh % NH;
        for (int pass = 0; pass < 2; ++pass)
            att::attn_block(qo + (size_t)bh * SEQ * DQK, ko + (size_t)bh * SEQ * DQK, vo + (size_t)bh * SEQ * 128, cat + (size_t)b * SEQ * DM + 512 + h * 128, DM, pass ? x : 15 - x, F.lds);
    }
}
__device__ __forceinline__ void fixup_panel(Frame& F, int l, int pm) {
    const float* halo = (const float*)(F.ws + WS_HALO); bf16* act = (bf16*)(F.ws + WS_ACT);
    const float* cw = INF(I_CW) + (size_t)l * 3 * DFF2; const float* cb = INF(I_CB) + (size_t)l * DFF2;
    for (int c = F.tid * 4; c < DFF; c += NTHR * 4) {
        const f32x4 wg0 = *(const f32x4*)(cw + c), wg1 = *(const f32x4*)(cw + DFF2 + c), wg2 = *(const f32x4*)(cw + 2 * DFF2 + c), bg = *(const f32x4*)(cb + c);
        const f32x4 wv0 = *(const f32x4*)(cw + DFF + c), wv1 = *(const f32x4*)(cw + DFF2 + DFF + c), wv2 = *(const f32x4*)(cw + 2 * DFF2 + DFF + c), bv = *(const f32x4*)(cb + DFF + c);
        f32x4 hg[2][4], hv[2][4];
#pragma unroll
        for (int q = 0; q < 2; ++q) { const int blk = pm * 2 + q; const bool first = ((blk * 128) & (SEQ - 1)) == 0; const int pb = first ? blk : blk - 1;
            const float* r0 = halo + (size_t)(blk * 4) * DFF2 + c; const float* rp = halo + (size_t)(pb * 4 + 2) * DFF2 + c;
            hg[q][0] = *(const f32x4*)r0; hv[q][0] = *(const f32x4*)(r0 + DFF); hg[q][1] = *(const f32x4*)(r0 + DFF2); hv[q][1] = *(const f32x4*)(r0 + DFF2 + DFF);
            hg[q][2] = *(const f32x4*)rp; hv[q][2] = *(const f32x4*)(rp + DFF); hg[q][3] = *(const f32x4*)(rp + DFF2); hv[q][3] = *(const f32x4*)(rp + DFF2 + DFF); }
#pragma unroll
        for (int q = 0; q < 2; ++q) { const int blk = pm * 2 + q; const bool first = ((blk * 128) & (SEQ - 1)) == 0;
            const f32x4 z4 = (f32x4){0.f, 0.f, 0.f, 0.f};
            const f32x4 gm1 = first ? z4 : hg[q][3], gm2 = first ? z4 : hg[q][2], vm1 = first ? z4 : hv[q][3], vm2 = first ? z4 : hv[q][2];
            { const f32x4 cg = bg + wg0 * gm2 + wg1 * gm1 + wg2 * hg[q][0], cv = bv + wv0 * vm2 + wv1 * vm1 + wv2 * hv[q][0];
              *(v2u*)(act + (size_t)(blk * 128) * DFF + c) = (v2u){pk2(gelu_tanh(cg.x) * cv.x, gelu_tanh(cg.y) * cv.y), pk2(gelu_tanh(cg.z) * cv.z, gelu_tanh(cg.w) * cv.w)}; }
            { const f32x4 cg = bg + wg0 * gm1 + wg1 * hg[q][0] + wg2 * hg[q][1], cv = bv + wv0 * vm1 + wv1 * hv[q][0] + wv2 * hv[q][1];
              *(v2u*)(act + (size_t)(blk * 128 + 1) * DFF + c) = (v2u){pk2(gelu_tanh(cg.x) * cv.x, gelu_tanh(cg.y) * cv.y), pk2(gelu_tanh(cg.z) * cv.z, gelu_tanh(cg.w) * cv.w)}; }
        }
    }
}

constexpr int PH_PER_LAYER = 10, PH_LAYER0 = 2, PH_FINAL = PH_LAYER0 + NL * PH_PER_LAYER, N_PHASES = PH_FINAL + 1;
__global__ void __launch_bounds__(NTHR, 2) skel_fwd(Args args) {
    extern __shared__ __attribute__((aligned(16))) unsigned char lds[];
    Frame F;
    F.lds = (LAS unsigned char*)lds; F.ldsg = lds;
    F.tid = threadIdx.x; F.lane = F.tid & 63; F.wave = __builtin_amdgcn_readfirstlane(F.tid >> 6);
    F.G = gridDim.x; F.bid = blockIdx.x; F.ws = args.ws; F.in = nullptr;
    const int lo = args.ph_lo, hi = args.ph_hi;
    for (int u = F.tid; u < (LDS_BYTES - CTRL_OFF) / 4; u += NTHR) ((LAS unsigned*)(F.lds + CTRL_OFF))[u] = 0u;
    if (F.tid == 0) { LAS unsigned long long* pt = (LAS unsigned long long*)(F.lds + PTAB_OFF);
#pragma unroll
        for (int i = 0; i < N_IN; ++i) pt[i] = (unsigned long long)args.in[i];
        pt[N_IN] = (unsigned long long)args.ws; }
    __syncthreads();
    XcdBarrier bar; bar.bar = (unsigned*)(F.ws + WS_CTL) + CW_BAR; bar.x = 0; bar.st = nullptr;
    if (hi - lo > 1) bar = xcd_barrier_post((unsigned*)(F.ws + WS_CTL) + CW_BAR, (volatile LAS unsigned*)(F.lds + MISC_OFF) + 8);
#define SEAM(k) do { if (IN(k) && IN((k) + 1)) xcd_barrier(bar); } while (0)
#define IN(k) (lo <= (k) && (k) < hi)
#define REFRESH() do { int t_ = threadIdx.x; asm volatile("" : "+v"(t_)); F.tid = t_; F.lane = t_ & 63; F.wave = __builtin_amdgcn_readfirstlane(t_ >> 6); \
    F.ws = (unsigned char*)ldp(F, N_IN); } while (0)
    if (IN(0)) phase_pre0(F);
    SEAM(0);
    if (IN(1)) { phase_pre1(F); if (F.G != 256) for (int l = 0; l < NL; ++l) s5_tables_b(F, l, F.bid * NTHR + F.tid, F.G * NTHR); }
    SEAM(1);
#define mod ((const float*)(F.ws + WS_MOD))
#define X ((bf16*)(F.ws + WS_X))
#define H ((bf16*)(F.ws + WS_H))
#define T2f ((const bf16*)(F.ws + WS_T2))
#define modl (mod + (size_t)l * NB * 12288)
    for (int l = 0; l < NL; ++l) {
        const int base = PH_LAYER0 + l * PH_PER_LAYER;
        if (IN(base + 0)) { REFRESH();
            if (l == 0) phase_resnorm(F, INF(I_X), nullptr, nullptr, nullptr, nullptr, nullptr, nullptr, INF(I_MPRE), modl + 2048, modl + 0, H);
            else phase_resnorm(F, nullptr, X, T2f, INF(I_FPOST) + (l - 1) * DM, mod + (size_t)(l - 1) * NB * 12288 + 10240, X, nullptr, INF(I_MPRE) + l * DM, modl + 2048, modl + 0, H);
        }
        SEAM(base + 0);
        if (IN(base + 1)) { REFRESH();
            pg8::Gemm g{H, wt(F, l, WL_IN), M, DINP, DM}; pg8::StaticOrder S; S.init(M, DINP, F.G, F.bid);
            pg8::EpiProj E{(bf16*)(F.ws + WS_U16), (bf16*)(F.ws + WS_CQ), (bf16*)(F.ws + WS_CKV), (bf16*)(F.ws + WS_HQ), (bf16*)(F.ws + WS_HV), (bf16*)(F.ws + WS_HGT), (bf16*)(F.ws + WS_ACT + 48 * MiB),
                           (float*)(F.ws + WS_LOGF), (float*)(F.ws + WS_SSQQ), (float*)(F.ws + WS_SSQKV), (const float*)(F.ws + WS_LB) + l * 512, (const float*)(F.ws + WS_COS), (const float*)(F.ws + WS_SIN)};
            pg8::gemm_phase<pg8::EpiProj, pg8::StaticOrder, true, true>(F.lds, g, S, E);
            if (F.G == 256 && F.bid >= 128) { REFRESH(); s5_tables_b(F, l, (F.bid - 128) * NTHR + F.tid, 128 * NTHR); }
        }
        SEAM(base + 1);
        if (IN(base + 2)) { REFRESH(); phase_mix1(F, l); }
        SEAM(base + 2);
        if (IN(base + 3)) { REFRESH();
            { pg8::Gemm g{(const bf16*)(F.ws + WS_CKV), wt(F, l, WL_UKV), M, 2048, 256}; pg8::StaticOrder S; S.init(M, 2048, F.G, F.bid);
              pg8::EpiKV E{(bf16*)(F.ws + WS_ACT + 48 * MiB), (bf16*)(F.ws + WS_ACT + 96 * MiB), (const float*)(F.ws + WS_SSQKV)};
              pg8::gemm_phase<pg8::EpiKV, pg8::StaticOrder, true, true>(F.lds, g, S, E); }
            REFRESH();
            hg_step2(F, (const bf16*)(F.ws + WS_DST), (const float*)(F.ws + WS_BLAST), (bf16*)(F.ws + WS_SPT));
            REFRESH();
            phase_s5out(F, l);
        }
        SEAM(base + 3);
        if (IN(base + 4)) { REFRESH();
            { pg8::Gemm g{(const bf16*)(F.ws + WS_CQ), wt(F, l, WL_UQ), M, 2048, 512, (const bf16*)(F.ws + WS_YG16), 6}; pg8::StaticOrder S; S.init(M, 2048, F.G, F.bid);
              pg8::EpiQGlu E{pg8::EpiQ{(bf16*)(F.ws + WS_ACT), (const float*)(F.ws + WS_SSQQ), (const float*)(F.ws + WS_COS), (const float*)(F.ws + WS_SIN)},
                             pg8::EpiGlu{(const bf16*)(F.ws + WS_YG16), 512, (bf16*)(F.ws + WS_CAT), DM}};
              pg8::gemm_phase<pg8::EpiQGlu, pg8::StaticOrder, true, true>(F.lds, g, S, E); }
            REFRESH();
            phase_hgout(F, l); }
        SEAM(base + 4);
        if (IN(base + 5)) { REFRESH(); phase_attn(F); }
        SEAM(base + 5);
        if (IN(base + 6)) { REFRESH();
            pg8::Gemm g{(const bf16*)(F.ws + WS_CAT), wt(F, l, WL_OUT), M, DM, DM}; pg8::StaticOrder S; S.init(M, DM, F.G, F.bid);
            pg8::EpiBf16<0> E{(bf16*)(F.ws + WS_T2), DM, nullptr, 0, 0, 1.f};
            pg8::gemm_phase<pg8::EpiBf16<0>, pg8::StaticOrder, true, true>(F.lds, g, S, E);
        }
        SEAM(base + 6);
        if (IN(base + 7)) { REFRESH(); phase_resnorm(F, l == 0 ? INF(I_X) : (const float*)nullptr, X, T2f, INF(I_MPOST) + l * DM, modl + 4096, X, nullptr, INF(I_FPRE) + l * DM, modl + 8192, modl + 6144, H); }
        SEAM(base + 7);
        if (IN(base + 8)) { REFRESH();
            pg8::Gemm g{H, wt(F, l, WL_UP), M, DFF2, DM}; pg8::StaticOrder S; S.init(M, DFF2, F.G, F.bid);
            pg8::EpiUp E{(bf16*)(F.ws + WS_ACT), (float*)(F.ws + WS_HALO), INF(I_CW) + (size_t)l * 3 * DFF2, INF(I_CB) + (size_t)l * DFF2};
            pg8::gemm_phase<pg8::EpiUp, pg8::StaticOrder, true, true>(F.lds, g, S, E);
        }
        SEAM(base + 8);
        if (IN(base + 9)) { REFRESH();
            { pg8::StaticOrder S0; S0.init(M, DM, F.G, F.bid, 4); pg8::Unit u0; int last = -1;
              for (int i = 0; S0.next(i, u0); ++i) if (u0.pm != last) { fixup_panel(F, l, u0.pm); last = u0.pm; } }
            asm volatile("s_waitcnt vmcnt(0)" ::: "memory"); __syncthreads();
            REFRESH();
            pg8::Gemm g{(const bf16*)(F.ws + WS_ACT), wt(F, l, WL_DN), M, DM, DFF}; pg8::StaticOrder S; S.init(M, DM, F.G, F.bid, 4);
            pg8::EpiBf16<0> E{(bf16*)(F.ws + WS_T2), DM, nullptr, 0, 0, 1.f};
            pg8::gemm_phase<pg8::EpiBf16<0>, pg8::StaticOrder, true, true>(F.lds, g, S, E);
        }
        SEAM(base + 9);
    }
    if (IN(PH_FINAL)) { REFRESH(); phase_resnorm(F, nullptr, X, T2f, INF(I_FPOST) + (NL - 1) * DM, mod + (size_t)(NL - 1) * NB * 12288 + 10240, nullptr, args.out, nullptr, nullptr, nullptr, nullptr); }
#undef mod
#undef X
#undef H
#undef T2f
#undef modl
#undef IN
}

extern "C" void kernel_launch(void* const* d_in, const int* in_sizes, int n_in, void* d_out, int out_size, void* d_ws, size_t ws_size, hipStream_t stream) {
    static int grid = 0;
    if (grid == 0) {
        if (n_in != N_IN || in_sizes[0] != M * DM || out_size != M * DM || ws_size < WS_END) { fprintf(stderr, "kernel_launch: shape/workspace mismatch (n_in %d, in0 %d, out %d, ws %zu < %zu)\n", n_in, n_in > 0 ? in_sizes[0] : -1, out_size, ws_size, (size_t)WS_END); grid = -1; return; }
        int dev = 0, cus = 0;
        if (hipGetDevice(&dev) != hipSuccess || hipDeviceGetAttribute(&cus, hipDeviceAttributeMultiprocessorCount, dev) != hipSuccess) { grid = -1; return; }
        if (hipFuncSetAttribute((const void*)skel_fwd, hipFuncAttributeMaxDynamicSharedMemorySize, LDS_BYTES) != hipSuccess) { fprintf(stderr, "kernel_launch: hipFuncSetAttribute failed\n"); grid = -1; return; }
        (void)hipGetLastError();
        grid = cus;
    }
    if (grid < 0) return;
    Args a{};
    for (int i = 0; i < N_IN; ++i) a.in[i] = d_in[i];
    a.out = (float*)d_out; a.ws = (unsigned char*)d_ws;
    if (hipMemsetAsync((char*)d_ws + WS_CTL, 0, CTL_ZERO_BYTES, stream) != hipSuccess) { fprintf(stderr, "kernel_launch: memset failed\n"); return; }
#if MK_ONE_LAUNCH
    a.ph_lo = 0; a.ph_hi = N_PHASES;
    hipLaunchKernelGGL(skel_fwd, dim3(grid), dim3(NTHR), LDS_BYTES, stream, a);
#else
    for (int p = 0; p < N_PHASES; ++p) {
        a.ph_lo = p; a.ph_hi = p + 1;
        hipLaunchKernelGGL(skel_fwd, dim3(grid), dim3(NTHR), LDS_BYTES, stream, a);
    }
#endif
}
```
